# Optimizing an MI355X kernel written in HIP

```python
import jax, jax.numpy as jnp
from jax import lax
import numpy as np

D_MODEL = 1024
BATCH = 8
SEQ = 2048
DEPTH = 2

N_A = DEPTH // 2
N_B = DEPTH - N_A
RET_HEADS = 4
RET_QK_DIM = D_MODEL // RET_HEADS
RET_V_DIM = 2 * D_MODEL // RET_HEADS
RET_CHUNK = 128
ROPE_BASE = 10000.0
RET_IN_WIDTH = 2 * RET_HEADS * RET_QK_DIM + 2 * RET_HEADS * RET_V_DIM
FOX_HEADS = 16
FOX_HEAD_DIM = D_MODEL // FOX_HEADS
Q_BLOCK = 128
FORGET_BIAS_CENTER = 2.0
D_FF = 4 * D_MODEL
EPS = 1e-6
MAX_POS_OFFSET = 4096

kernel_name = "yoco_retention_forgetting_attention_adaln"


def rms_norm(x, gain):
    xf = x.astype(jnp.float32)
    y = xf * lax.rsqrt(jnp.mean(xf * xf, axis=-1, keepdims=True) + EPS)
    return (y * gain.astype(jnp.float32)).astype(x.dtype)


def ada_modulate(x, gain, shift, scale):
    return rms_norm(x, gain) * (1 + scale[:, None, :]) + shift[:, None, :]


def rotary(x, positions):
    half = x.shape[-1] // 2
    inv_freq = ROPE_BASE ** (-jnp.arange(half, dtype=jnp.float32) / half)
    ang = positions.astype(jnp.float32)[..., None] * inv_freq
    cos = jnp.cos(ang)[:, :, None, :]
    sin = jnp.sin(ang)[:, :, None, :]
    xf = x.astype(jnp.float32)
    x1, x2 = xf[..., :half], xf[..., half:]
    out = jnp.concatenate([x1 * cos - x2 * sin, x1 * sin + x2 * cos], axis=-1)
    return out.astype(x.dtype)


def retention(q, k, v, gammas):
    B, S, H, Dk = q.shape
    Dv = v.shape[-1]
    C = RET_CHUNK
    NC = S // C
    dt = q.dtype
    k = k * (Dk ** -0.5)
    qc = q.reshape(B, NC, C, H, Dk).transpose(1, 0, 3, 2, 4)
    kc = k.reshape(B, NC, C, H, Dk).transpose(1, 0, 3, 2, 4)
    vc = v.reshape(B, NC, C, H, Dv).transpose(1, 0, 3, 2, 4)
    log_g = jnp.log(gammas.astype(jnp.float32))
    idx = jnp.arange(C, dtype=jnp.float32)
    rel = idx[:, None] - idx[None, :]
    intra_decay = jnp.where(rel >= 0, jnp.exp(log_g[:, None, None] * jnp.maximum(rel, 0.0)), 0.0)
    q_decay = jnp.exp(log_g[:, None] * (idx + 1.0))
    k_decay = jnp.exp(log_g[:, None] * (C - 1.0 - idx))
    chunk_decay = jnp.exp(log_g * C)
    scores = jnp.einsum('nbhqd,nbhkd->nbhqk', qc, kc) * intra_decay
    intra = jnp.einsum('nbhqk,nbhkv->nbhqv', scores.astype(dt), vc).astype(jnp.float32)

    def step(state, inp):
        q_i, k_i, v_i = inp
        cross = jnp.einsum('bhqd,bhdv->bhqv', q_i.astype(jnp.float32), state) * q_decay[None, :, :, None]
        upd = jnp.einsum('bhkd,bhkv->bhdv', (k_i.astype(jnp.float32) * k_decay[None, :, :, None]),
                         v_i.astype(jnp.float32))
        return state * chunk_decay[None, :, None, None] + upd, cross

    state0 = jnp.zeros((B, H, Dk, Dv), jnp.float32)
    _, cross = lax.scan(step, state0, (qc, kc, vc))
    out = intra + cross
    return out.transpose(1, 0, 3, 2, 4).reshape(B, S, H, Dv).astype(dt)


def retention_mixer(h, positions, w_in, norm_gain, w_out, gammas):
    B, S, _ = h.shape
    proj = h @ w_in
    qk_w = RET_HEADS * RET_QK_DIM
    v_w = RET_HEADS * RET_V_DIM
    q, k, v, g = jnp.split(proj, [qk_w, 2 * qk_w, 2 * qk_w + v_w], axis=-1)
    q = rotary(q.reshape(B, S, RET_HEADS, RET_QK_DIM), positions)
    k = rotary(k.reshape(B, S, RET_HEADS, RET_QK_DIM), positions)
    v = v.reshape(B, S, RET_HEADS, RET_V_DIM)
    y = retention(q, k, v, gammas)
    y = rms_norm(y, norm_gain).reshape(B, S, v_w)
    return (jax.nn.silu(g) * y) @ w_out


def shared_kv(x, c_act, kv_norm_gain, kv_w_ada, kv_b_ada, kv_w, forget_bias, k_norm_gain):
    B, S, D = x.shape
    shift, scale = jnp.split(c_act @ kv_w_ada + kv_b_ada, 2, axis=-1)
    h = ada_modulate(x, kv_norm_gain, shift, scale)
    kvf = h @ kv_w
    k, v, f = jnp.split(kvf, [D, 2 * D], axis=-1)
    k = rms_norm(k.reshape(B, S, FOX_HEADS, FOX_HEAD_DIM), k_norm_gain)
    v = v.reshape(B, S, FOX_HEADS, FOX_HEAD_DIM)
    log_f = jax.nn.log_sigmoid(f.astype(jnp.float32) + forget_bias.astype(jnp.float32))
    f_cum = jnp.cumsum(log_f, axis=1)
    return k, v, f_cum


def forgetting_attention(q, k, v, f_cum):
    B, S, H, Dh = q.shape
    NB = S // Q_BLOCK
    scale = Dh ** -0.5
    k_pos = jnp.arange(S)
    fk = f_cum.transpose(0, 2, 1)
    qb = q.reshape(B, NB, Q_BLOCK, H, Dh).transpose(1, 0, 3, 2, 4)
    fq = fk.reshape(B, H, NB, Q_BLOCK).transpose(2, 0, 1, 3)

    def block(args):
        q_blk, fq_blk, blk = args
        logits = jnp.einsum('bhqd,bkhd->bhqk', q_blk, k).astype(jnp.float32) * scale
        logits = logits + fq_blk[..., None] - fk[:, :, None, :]
        q_pos = blk * Q_BLOCK + jnp.arange(Q_BLOCK)
        causal = k_pos[None, :] <= q_pos[:, None]
        logits = jnp.where(causal, logits, -jnp.inf)
        p = jax.nn.softmax(logits, axis=-1).astype(v.dtype)
        return jnp.einsum('bhqk,bkhd->bqhd', p, v)

    out = lax.map(block, (qb, fq, jnp.arange(NB)))
    return out.transpose(1, 0, 2, 3, 4).reshape(B, S, H, Dh)


def fox_mixer(h, k, v, f_cum, w_in, q_norm_gain, w_out):
    B, S, D = h.shape
    q, og = jnp.split(h @ w_in, 2, axis=-1)
    q = rms_norm(q.reshape(B, S, FOX_HEADS, FOX_HEAD_DIM), q_norm_gain)
    y = forgetting_attention(q, k, v, f_cum).reshape(B, S, D)
    return (jax.nn.sigmoid(og) * y) @ w_out


def sq_relu_mlp(h, w1, w2):
    return jnp.square(jax.nn.relu(h @ w1)) @ w2


def setup_inputs(seed: int = 0) -> dict:
    key = jax.random.key(seed)
    ks = jax.random.split(key, 24)
    f32 = jnp.float32
    D = D_MODEL

    def w(k, shape, fan_in, s=1.0):
        return jax.random.normal(k, shape, f32) * (s * fan_in ** -0.5)

    def gain(k, shape):
        return 1.0 + 0.02 * jax.random.normal(k, shape, f32)

    x = jax.random.normal(ks[0], (BATCH, SEQ, D), f32)
    c = jax.random.normal(ks[1], (BATCH, D), f32)
    offset = jax.random.randint(ks[2], (BATCH, 1), 0, MAX_POS_OFFSET, dtype=jnp.int32)
    positions = offset + jnp.arange(SEQ, dtype=jnp.int32)[None, :]
    return {
        "x": x,
        "c": c,
        "positions": positions,
        "norm_mix_gain": gain(ks[3], (DEPTH, D)),
        "norm_mlp_gain": gain(ks[4], (DEPTH, D)),
        "w_ada": w(ks[5], (DEPTH, D, 6 * D), D, 0.5),
        "b_ada": 0.02 * jax.random.normal(ks[6], (DEPTH, 6 * D), f32),
        "w_mlp_in": w(ks[7], (DEPTH, D, D_FF), D),
        "w_mlp_out": w(ks[8], (DEPTH, D_FF, D), D_FF),
        "ret_w_in": w(ks[9], (N_A, D, RET_IN_WIDTH), D),
        "ret_norm_gain": gain(ks[10], (N_A, RET_HEADS, RET_V_DIM)),
        "ret_w_out": w(ks[11], (N_A, RET_HEADS * RET_V_DIM, D), RET_HEADS * RET_V_DIM),
        "kv_norm_gain": gain(ks[12], (D,)),
        "kv_w_ada": w(ks[13], (D, 2 * D), D, 0.5),
        "kv_b_ada": 0.02 * jax.random.normal(ks[14], (2 * D,), f32),
        "kv_w": w(ks[15], (D, 2 * D + FOX_HEADS), D),
        "forget_bias": FORGET_BIAS_CENTER + 0.1 * jax.random.normal(ks[16], (FOX_HEADS,), f32),
        "k_norm_gain": gain(ks[17], (FOX_HEAD_DIM,)),
        "fox_w_in": w(ks[18], (N_B, D, 2 * D), D),
        "q_norm_gain": gain(ks[19], (N_B, FOX_HEAD_DIM)),
        "fox_w_out": w(ks[20], (N_B, D, D), D),
    }


def reference(x, c, positions, norm_mix_gain, norm_mlp_gain, w_ada, b_ada, w_mlp_in, w_mlp_out,
              ret_w_in, ret_norm_gain, ret_w_out, kv_norm_gain, kv_w_ada, kv_b_ada, kv_w,
              forget_bias, k_norm_gain, fox_w_in, q_norm_gain, fox_w_out):
    c_act = jax.nn.silu(c)
    gammas = 1.0 - jnp.power(2.0, -5.0 - jnp.arange(RET_HEADS, dtype=jnp.float32))
    k_sh = v_sh = f_sh = None
    for layer in range(DEPTH):
        if layer == N_A:
            k_sh, v_sh, f_sh = shared_kv(x, c_act, kv_norm_gain, kv_w_ada, kv_b_ada, kv_w,
                                         forget_bias, k_norm_gain)
        ada = c_act @ w_ada[layer] + b_ada[layer]
        sh1, sc1, g1, sh2, sc2, g2 = jnp.split(ada, 6, axis=-1)
        h = ada_modulate(x, norm_mix_gain[layer], sh1, sc1)
        if layer < N_A:
            mix = retention_mixer(h, positions, ret_w_in[layer], ret_norm_gain[layer],
                                  ret_w_out[layer], gammas)
        else:
            j = layer - N_A
            mix = fox_mixer(h, k_sh, v_sh, f_sh, fox_w_in[j], q_norm_gain[j], fox_w_out[j])
        x = x + g1[:, None, :] * mix
        h = ada_modulate(x, norm_mlp_gain[layer], sh2, sc2)
        x = x + g2[:, None, :] * sq_relu_mlp(h, w_mlp_in[layer], w_mlp_out[layer])
    return x
```

```cpp
#include <hip/hip_runtime.h>
#include <hip/hip_cooperative_groups.h>
#include <cstdio>
#include <cstdint>
namespace cg = cooperative_groups;

namespace pg8 {
#define PG8_LAS __attribute__((address_space(3)))
typedef unsigned short bf16_t;
typedef short bf16x8 __attribute__((ext_vector_type(8)));
typedef float f32x4 __attribute__((ext_vector_type(4)));
typedef unsigned u32x4 __attribute__((ext_vector_type(4)));
constexpr int BM = 256, BK = 64, HALF = 128, HTB = HALF * BK * 2  , STAGE_BYTES = 8 * HTB, NXCD = 8, WGM = 8;

__host__ __device__ __forceinline__ int lds_byte(int r, int c) { const int st = (r >> 4) * 2 + (c >> 5), rr = r & 15, cc = c & 31, ob = rr * 64 + cc * 2; return st * 1024 + (ob ^ (((ob >> 9) & 1) << 5)); }
__host__ __device__ __forceinline__ void stage_rc(int b, int& R, int& C) { const int st = b / 1024, sb = b % 1024, swz = sb ^ (((sb >> 9) & 1) << 5); R = (st >> 1) * 16 + swz / 64; C = (st & 1) * 32 + (swz % 64) / 2; }
__host__ __device__ __forceinline__ int perm32(int rho) { const int n = rho >> 4, i = rho & 15; return 8 * (i >> 2) + 4 * n + (i & 3); }

struct Unit { int pm, pn; };
struct Gemm { const bf16_t* A; const bf16_t* Bt; int M, N, K; };

struct StaticOrder {
    int nM, nN, nwg, G, c;
    __host__ __device__ void init(int M, int N, int G_, int c_) { nM = M / BM; nN = N / BM; nwg = nM * nN; G = G_; c = c_; }
    __host__ __device__ bool next(int i, Unit& u) const {
        const long L = (long)i * G + c; if (L >= nwg) return false;
        int wgid = (int)L; { const int q = nwg / NXCD, r = nwg % NXCD, xcd = wgid % NXCD, off = wgid / NXCD; wgid = (xcd < r ? xcd * (q + 1) : r * (q + 1) + (xcd - r) * q) + off; }
        const int nig = WGM * nN, gid = wgid / nig, fm = gid * WGM, gsz = (nM - fm) < WGM ? (nM - fm) : WGM;
        u.pm = fm + ((wgid % nig) % gsz); u.pn = (wgid % nig) / gsz; return true;
    }
    __device__ __forceinline__ void a_ready(const Unit&) const {}
    __device__ __forceinline__ void done(const Unit&) const {}
};

typedef float f32x2 __attribute__((ext_vector_type(2)));
typedef __bf16 bf16x2_t __attribute__((ext_vector_type(2)));
__device__ __forceinline__ unsigned cvt_pk_bf16(float lo, float hi) { const f32x2 v = {lo, hi}; const bf16x2_t b = __builtin_convertvector(v, bf16x2_t); return __builtin_bit_cast(unsigned, b); }
typedef unsigned u32x2 __attribute__((ext_vector_type(2)));
__device__ __forceinline__ u32x4 pack8(f32x4 v0, f32x4 v1) { u32x4 w; w.x = cvt_pk_bf16(v0[0], v0[1]); w.y = cvt_pk_bf16(v0[2], v0[3]); w.z = cvt_pk_bf16(v1[0], v1[1]); w.w = cvt_pk_bf16(v1[2], v1[3]); return w; }
__device__ __forceinline__ float fast_sigmoid(float v) { return __builtin_amdgcn_rcpf(1.f + __expf(-v)); }

struct EpiRetIn {
    static constexpr bool PERM = true, AFTER_DRAIN = false, KHOOK = false;
    bf16_t *Q, *Kr, *V, *G; const float* tab;
    __device__ __forceinline__ void operator()(const f32x4 (&acc)[2][2][4][2], const Unit& u, int wr, int wc, int fr, int fq) const {
        const int row0 = u.pm * BM + wr * 64 + fr, cw = wc * 32 + 8 * fq;
        if (u.pn < 8) {
            const bool isk = u.pn >= 4; bf16_t* base = (isk ? Kr : Q) + (u.pn & 3) * 256 + cw; const float sc = isk ? 0.0625f : 1.f;
#pragma unroll
            for (int ab = 0; ab < 4; ++ab) {
                const int ai = ab >> 1;
                f32x4 tt[2][4];
#pragma unroll
                for (int mm = 0; mm < 2; ++mm) { const f32x4* tp = (const f32x4*)(tab + ((size_t)(row0 + ai * HALF + (2 * (ab & 1) + mm) * 16) * 128 + cw) * 2);
                    tt[mm][0] = tp[0]; tt[mm][1] = tp[1]; tt[mm][2] = tp[2]; tt[mm][3] = tp[3]; }
#pragma unroll
                for (int mm = 0; mm < 2; ++mm) {
                    const int m = 2 * (ab & 1) + mm;
                    const int row = row0 + ai * HALF + m * 16;
                    const f32x4 t0 = tt[mm][0], t1 = tt[mm][1], t2 = tt[mm][2], t3 = tt[mm][3];
                    const f32x4 xa = acc[ai][0][m][0] * sc, xb = acc[ai][0][m][1] * sc, ya = acc[ai][1][m][0] * sc, yb = acc[ai][1][m][1] * sc;
                    f32x4 o1a, o1b, o2a, o2b;
                    o1a[0] = xa[0] * t0[0] - ya[0] * t0[1]; o2a[0] = xa[0] * t0[1] + ya[0] * t0[0];
                    o1a[1] = xa[1] * t0[2] - ya[1] * t0[3]; o2a[1] = xa[1] * t0[3] + ya[1] * t0[2];
                    o1a[2] = xa[2] * t1[0] - ya[2] * t1[1]; o2a[2] = xa[2] * t1[1] + ya[2] * t1[0];
                    o1a[3] = xa[3] * t1[2] - ya[3] * t1[3]; o2a[3] = xa[3] * t1[3] + ya[3] * t1[2];
                    o1b[0] = xb[0] * t2[0] - yb[0] * t2[1]; o2b[0] = xb[0] * t2[1] + yb[0] * t2[0];
                    o1b[1] = xb[1] * t2[2] - yb[1] * t2[3]; o2b[1] = xb[1] * t2[3] + yb[1] * t2[2];
                    o1b[2] = xb[2] * t3[0] - yb[2] * t3[1]; o2b[2] = xb[2] * t3[1] + yb[2] * t3[0];
                    o1b[3] = xb[3] * t3[2] - yb[3] * t3[3]; o2b[3] = xb[3] * t3[3] + yb[3] * t3[2];
                    if (isk) { bf16_t* rp = base + (size_t)row * 1024;
                        *(u32x4*)(rp) = pack8(o1a, o1b); *(u32x4*)(rp + 128) = pack8(o2a, o2b); }
                    else {
                        bf16_t* rp = Q + ((size_t)((row >> 11) * 4 + (u.pn & 3)) * 64 + ((row >> 5) & 63)) * 8192 + (cw >> 4) * 512 + ((cw >> 3) & 1) * 256 + (row & 31) * 8;
                        *(u32x4*)(rp) = pack8(o1a, o1b); *(u32x4*)(rp + 8 * 512) = pack8(o2a, o2b); }
                }
                asm volatile("" ::: "memory");
            }
        } else if (u.pn < 16) {
            const int ct = u.pn - 8, hd = ct >> 1;
            const float lg = log2f(1.f - exp2f(-5.f - (float)hd));
#pragma unroll
            for (int ai = 0; ai < 2; ++ai)
#pragma unroll
                for (int m = 0; m < 4; ++m) {
                    const int row = row0 + ai * HALF + m * 16, tok = row & 127;
                    const float kd = exp2f((float)(127 - tok) * lg);
#pragma unroll
                    for (int bj = 0; bj < 2; ++bj) {
                        const int c0 = ct * 256 + bj * HALF + cw;
                        bf16_t* rp = V + ((((size_t)((row >> 11) * 4 + hd) * 8 + ((c0 >> 6) & 7)) * 16 + ((row >> 7) & 15)) * 8 + ((c0 >> 3) & 7)) * 1024 + tok * 8;
                        *(u32x4*)rp = pack8(acc[ai][bj][m][0] * kd, acc[ai][bj][m][1] * kd);
                    }
                }
        } else {
            const bool isg = true; bf16_t* base = G + (u.pn - 16) * 256 + cw;
#pragma unroll
            for (int ai = 0; ai < 2; ++ai)
#pragma unroll
                for (int m = 0; m < 4; ++m) {
                    bf16_t* rp = base + (size_t)(row0 + ai * HALF + m * 16) * 2048;
#pragma unroll
                    for (int bj = 0; bj < 2; ++bj) {
                        f32x4 v0 = acc[ai][bj][m][0], v1 = acc[ai][bj][m][1];
                        if (isg) {
#pragma unroll
                            for (int j = 0; j < 4; ++j) { v0[j] = v0[j] * fast_sigmoid(v0[j]); v1[j] = v1[j] * fast_sigmoid(v1[j]); }
                        }
                        *(u32x4*)(rp + bj * HALF) = pack8(v0, v1);
                    }
                }
        }
    }
};

template <bool HOOK, int NOUT, bool RIN16, bool ROUT16> struct EpiRes {
    static constexpr bool PERM = true, AFTER_DRAIN = false, KHOOK = HOOK;
    const void* resid; void* out; const float* gate; int gate_ld; const PG8_LAS float* rtab;
    bf16_t* hout[2]; const float* hgain[2]; const float* hscale[2]; float* ssq2;
    __device__ __forceinline__ void khook(f32x4 (&acc)[2][2][4][2], int seg, int wr, int fr) const {
#pragma unroll
        for (int ai = 0; ai < 2; ++ai)
#pragma unroll
            for (int m = 0; m < 4; ++m) {
                const int r = ai * HALF + wr * 64 + m * 16 + fr;
                const float f = rtab[r * 4 + seg] / rtab[r * 4 + seg + 1];
#pragma unroll
                for (int bj = 0; bj < 2; ++bj)
#pragma unroll
                    for (int n = 0; n < 2; ++n) acc[ai][bj][m][n] = acc[ai][bj][m][n] * f;
            }
    }
    __device__ __forceinline__ void operator()(const f32x4 (&acc)[2][2][4][2], const Unit& u, int wr, int wc, int fr, int fq) const {
        const int b = u.pm >> 3, col0 = u.pn * BM + wc * 32 + 8 * fq;
        f32x4 gv[2][2]; f32x4 gs[NOUT > 0 ? NOUT : 1][2][2];
#pragma unroll
        for (int bj = 0; bj < 2; ++bj)
#pragma unroll
            for (int n = 0; n < 2; ++n) { const int c = col0 + bj * HALF + 4 * n;
                gv[bj][n] = *(const f32x4*)(gate + (size_t)b * gate_ld + c);
#pragma unroll
                for (int i = 0; i < NOUT; ++i) gs[i][bj][n] = *(const f32x4*)(hgain[i] + c) * (*(const f32x4*)(hscale[i] + (size_t)b * gate_ld + c) + 1.f); }
#pragma unroll
        for (int ai = 0; ai < 2; ++ai) {
            constexpr int MB = (RIN16 && NOUT == 0) ? 4 : 2;
#pragma unroll
            for (int mb = 0; mb < 4; mb += MB) {
                u32x4 raw[MB][2][RIN16 ? 1 : 2];
#pragma unroll
                for (int mm = 0; mm < MB; ++mm) {
                    const size_t off = (size_t)(u.pm * BM + ai * HALF + wr * 64 + (mb + mm) * 16 + fr) * 1024 + col0;
#pragma unroll
                    for (int bj = 0; bj < 2; ++bj) {
                        if (RIN16) raw[mm][bj][0] = *(const u32x4*)((const bf16_t*)resid + off + bj * HALF);
                        else { raw[mm][bj][0] = *(const u32x4*)((const float*)resid + off + bj * HALF); raw[mm][bj][RIN16 ? 0 : 1] = *(const u32x4*)((const float*)resid + off + bj * HALF + 4); }
                    }
                }
#pragma unroll
                for (int mm = 0; mm < MB; ++mm) {
                    const int m = mb + mm;
                    const int rl = ai * HALF + wr * 64 + m * 16 + fr;
                    float rs = 1.f; if (HOOK) rs = rtab[rl * 4 + 3];
                    const size_t off = (size_t)(u.pm * BM + rl) * 1024 + col0;
                    float ss = 0.f;
#pragma unroll
                    for (int bj = 0; bj < 2; ++bj) {
                        f32x4 r[2];
                        if (RIN16) { const u32x4 rw = raw[mm][bj][0];
                            r[0] = (f32x4){__uint_as_float(rw.x << 16), __uint_as_float(rw.x & 0xffff0000u), __uint_as_float(rw.y << 16), __uint_as_float(rw.y & 0xffff0000u)};
                            r[1] = (f32x4){__uint_as_float(rw.z << 16), __uint_as_float(rw.z & 0xffff0000u), __uint_as_float(rw.w << 16), __uint_as_float(rw.w & 0xffff0000u)}; }
                        else { r[0] = __builtin_bit_cast(f32x4, raw[mm][bj][0]); r[1] = __builtin_bit_cast(f32x4, raw[mm][bj][RIN16 ? 0 : 1]); }
                        f32x4 o[2];
#pragma unroll
                        for (int n = 0; n < 2; ++n) {
                            o[n] = r[n] + gv[bj][n] * (acc[ai][bj][m][n] * rs);
                            if (!ROUT16) *(f32x4*)((float*)out + off + bj * HALF + 4 * n) = o[n];
                            if (NOUT > 0) ss += (o[n][0] * o[n][0] + o[n][1] * o[n][1]) + (o[n][2] * o[n][2] + o[n][3] * o[n][3]);
                        }
                        if (ROUT16) *(u32x4*)((bf16_t*)out + off + bj * HALF) = pack8(o[0], o[1]);
#pragma unroll
                        for (int i = 0; i < NOUT; ++i) *(u32x4*)(hout[i] + off + bj * HALF) = pack8(o[0] * gs[i][bj][0], o[1] * gs[i][bj][1]);
                    }
                    if (NOUT > 0) { ss += __shfl_xor(ss, 16); ss += __shfl_xor(ss, 32);
                        if (fq == 0) ssq2[(size_t)(u.pm * BM + rl) * 16 + u.pn * 4 + wc] = ss; }
                }
                asm volatile("" ::: "memory");
            }
        }
    }
};

__device__ __forceinline__ void wave_rstd(const float* ssq2, PG8_LAS float* scr, int pm, int wr, int lane) {
#pragma unroll
    for (int t = 0; t < 2; ++t) { const int e = lane + 64 * t; const size_t row = (size_t)pm * BM + HALF * t + 64 * wr + lane;
        const f32x4* p = (const f32x4*)(ssq2 + row * 16); const f32x4 a = p[0], b = p[1], c = p[2], d = p[3];
        const float s = ((a[0] + a[1]) + (a[2] + a[3])) + ((b[0] + b[1]) + (b[2] + b[3])) + ((c[0] + c[1]) + (c[2] + c[3])) + ((d[0] + d[1]) + (d[2] + d[3]));
        scr[e] = rsqrtf(s * (1.f / 1024.f) + 1e-6f); }
    asm volatile("s_waitcnt lgkmcnt(0)" ::: "memory");
}

struct EpiSqRelu {
    static constexpr bool PERM = true, AFTER_DRAIN = false, KHOOK = false;
    bf16_t* O; const float* ssq2; const float* bias2; PG8_LAS float* scr0;
    __device__ __forceinline__ void operator()(const f32x4 (&acc)[2][2][4][2], const Unit& u, int wr, int wc, int fr, int fq) const {
        const int row0 = u.pm * BM + wr * 64 + fr, col0 = u.pn * BM + wc * 32 + 8 * fq;
        PG8_LAS float* scr = scr0 + (wr * 4 + wc) * 128;
        wave_rstd(ssq2, scr, u.pm, wr, fq * 16 + fr);
        f32x4 bv[2][2];
#pragma unroll
        for (int bj = 0; bj < 2; ++bj)
#pragma unroll
            for (int n = 0; n < 2; ++n) bv[bj][n] = *(const f32x4*)(bias2 + (size_t)(u.pm >> 3) * 4096 + col0 + bj * HALF + 4 * n);
#pragma unroll
        for (int ai = 0; ai < 2; ++ai)
#pragma unroll
            for (int m = 0; m < 4; ++m) {
                bf16_t* rp = O + (size_t)(row0 + ai * HALF + m * 16) * 4096 + col0;
                const float rstd = scr[ai * 64 + m * 16 + fr];
#pragma unroll
                for (int bj = 0; bj < 2; ++bj) {
                    f32x4 v0 = acc[ai][bj][m][0] * rstd + bv[bj][0], v1 = acc[ai][bj][m][1] * rstd + bv[bj][1];
#pragma unroll
                    for (int j = 0; j < 4; ++j) { const float a = fmaxf(v0[j], 0.f), c = fmaxf(v1[j], 0.f); v0[j] = a * a; v1[j] = c * c; }
                    *(u32x4*)(rp + bj * HALF) = pack8(v0, v1);
                }
            }
    }
};

template <int MODE1> struct EpiHeads {
    static constexpr bool PERM = true, AFTER_DRAIN = false, KHOOK = false;
    bf16_t *O0, *O1; const float* gain; float scale0; float* logf; const float* fbias;
    const float* ssq2; const float* bias2; int bias_ld; PG8_LAS float* scr0;
    __device__ __forceinline__ void operator()(const f32x4 (&acc0)[2][2][4][2], const Unit& u, int wr, int wc, int fr, int fq) const {
        const int row0 = u.pm * BM + wr * 64 + fr;
        PG8_LAS float* scr = scr0 + (wr * 4 + wc) * 128;
        wave_rstd(ssq2, scr, u.pm, wr, fq * 16 + fr);
        f32x4 acc[2][2][4][2];
        { f32x4 bv[2][2];
#pragma unroll
          for (int bj = 0; bj < 2; ++bj)
#pragma unroll
              for (int n = 0; n < 2; ++n) bv[bj][n] = *(const f32x4*)(bias2 + (size_t)(u.pm >> 3) * bias_ld + u.pn * BM + bj * HALF + wc * 32 + 8 * fq + 4 * n);
#pragma unroll
          for (int ai = 0; ai < 2; ++ai)
#pragma unroll
              for (int m = 0; m < 4; ++m) { const float rstd = scr[ai * 64 + m * 16 + fr];
#pragma unroll
                  for (int bj = 0; bj < 2; ++bj)
#pragma unroll
                      for (int n = 0; n < 2; ++n) acc[ai][bj][m][n] = acc0[ai][bj][m][n] * rstd + bv[bj][n]; } }
        if (u.pn < 4) {
            f32x4 gk[2][2];
#pragma unroll
            for (int bj = 0; bj < 2; ++bj)
#pragma unroll
                for (int n = 0; n < 2; ++n) gk[bj][n] = *(const f32x4*)(gain + 32 * bj + 8 * fq + 4 * n) * scale0;
#pragma unroll
            for (int ai = 0; ai < 2; ++ai)
#pragma unroll
                for (int m = 0; m < 4; ++m) {
                    float ss = 0.f;
#pragma unroll
                    for (int bj = 0; bj < 2; ++bj)
#pragma unroll
                        for (int n = 0; n < 2; ++n) { const f32x4 x = acc[ai][bj][m][n]; ss += (x[0] * x[0] + x[1] * x[1]) + (x[2] * x[2] + x[3] * x[3]); }
                    ss += __shfl_xor(ss, 16); ss += __shfl_xor(ss, 32);
                    const float rstd = rsqrtf(ss * (1.f / 64.f) + 1e-6f);
                    bf16_t* rp = O0 + (size_t)(row0 + ai * HALF + m * 16) * 1024 + u.pn * 256 + wc * 64 + 8 * fq;
#pragma unroll
                    for (int bj = 0; bj < 2; ++bj) *(u32x4*)(rp + 32 * bj) = pack8(acc[ai][bj][m][0] * rstd * gk[bj][0], acc[ai][bj][m][1] * rstd * gk[bj][1]);
                }
        } else if (u.pn < 8) {
#pragma unroll
            for (int ai = 0; ai < 2; ++ai)
#pragma unroll
                for (int m = 0; m < 4; ++m) {
                    bf16_t* rp = O1 + (size_t)(row0 + ai * HALF + m * 16) * 1024 + (u.pn - 4) * 256 + wc * 64 + 8 * fq;
#pragma unroll
                    for (int bj = 0; bj < 2; ++bj) {
                        f32x4 v0 = acc[ai][bj][m][0], v1 = acc[ai][bj][m][1];
                        if (MODE1 == 1) {
#pragma unroll
                            for (int j = 0; j < 4; ++j) { v0[j] = fast_sigmoid(v0[j]); v1[j] = fast_sigmoid(v1[j]); }
                        }
                        *(u32x4*)(rp + 32 * bj) = pack8(v0, v1);
                    }
                }
        } else {
            if (wc == 0 && fq < 2) {
                const f32x4 b0 = *(const f32x4*)(fbias + 8 * fq), b1 = *(const f32x4*)(fbias + 8 * fq + 4);
#pragma unroll
                for (int ai = 0; ai < 2; ++ai)
#pragma unroll
                    for (int m = 0; m < 4; ++m) {
                        f32x4 z0 = acc[ai][0][m][0] + b0, z1 = acc[ai][0][m][1] + b1;
#pragma unroll
                        for (int j = 0; j < 4; ++j) { z0[j] = fminf(z0[j], 0.f) - log1pf(__expf(-fabsf(z0[j]))); z1[j] = fminf(z1[j], 0.f) - log1pf(__expf(-fabsf(z1[j]))); }
                        float* lp = logf + (size_t)(row0 + ai * HALF + m * 16) * 16 + 8 * fq;
                        *(f32x4*)lp = z0; *(f32x4*)(lp + 4) = z1;
                    }
            }
        }
    }
};

struct OneUnit {
    Unit u;
    __device__ __forceinline__ bool next(int i, Unit& o) const { if (i) return false; o = u; return true; }
    __device__ __forceinline__ void a_ready(const Unit&) const {}
    __device__ __forceinline__ void done(const Unit&) const {}
};
template <class Epi, class Sched, bool ALIGN_EPI = false, bool SP2 = false>
__device__ __forceinline__ void gemm_phase(PG8_LAS unsigned char* lds, const Gemm g, const Sched& S, const Epi& E, const int tid) {
    const int wid = __builtin_amdgcn_readfirstlane(tid >> 6), lane = tid & 63, wr = wid >> 2, wc = wid & 3, fr = lane & 15, fq = lane >> 4;
    const int K = g.K, nt = K / BK;
    unsigned voffA[2], voffB[2];
#pragma unroll
    for (int i = 0; i < 2; ++i) { int R, C; stage_rc(tid * 16 + i * 8192, R, C); const int Rb = Epi::PERM ? ((R & ~31) + perm32(R & 31)) : R;
        voffA[i] = (unsigned)(R * K + C) * 2u; voffB[i] = (unsigned)(Rb * K + C) * 2u; }
    const size_t kstep = (size_t)(BK * 2);
    const size_t hstep = (size_t)HALF * K * 2;
    const size_t tstep = 2 * hstep;
    const unsigned ldsw = (unsigned)wid * 1024u;
    const int aoff = lds_byte(wr * 64 + fr, fq * 8), boff = lds_byte(wc * 32 + fr, fq * 8);
#define PG8_SA(b, h) (((b) * 2 + (h)) * HTB)
#define PG8_SB(b, h) ((4 + (b) * 2 + (h)) * HTB)
#define PG8_STAGE(bufoff, gbase, voff) do { _Pragma("unroll") for (int _i = 0; _i < 2; ++_i) \
        __builtin_amdgcn_global_load_lds((const unsigned*)((const char*)(gbase) + (voff)[_i]), (PG8_LAS unsigned*)(lds + (bufoff) + ldsw + _i * 8192), 16, 0, 0); } while (0)
#define PG8_LDA(dst, b, h) do { _Pragma("unroll") for (int m = 0; m < 4; ++m) _Pragma("unroll") for (int k = 0; k < 2; ++k) dst[m][k] = *(const PG8_LAS bf16x8*)(lds + PG8_SA(b, h) + aoff + m * 2048 + k * 1024); } while (0)
#define PG8_LDB(dst, b, h) do { _Pragma("unroll") for (int n = 0; n < 2; ++n) _Pragma("unroll") for (int k = 0; k < 2; ++k) dst[n][k] = *(const PG8_LAS bf16x8*)(lds + PG8_SB(b, h) + boff + n * 2048 + k * 1024); } while (0)
#define PG8_MMA(ai, bj, At, Bt) do { __builtin_amdgcn_s_setprio(1); _Pragma("unroll") for (int m = 0; m < 4; ++m) _Pragma("unroll") for (int n = 0; n < 2; ++n) _Pragma("unroll") for (int k = 0; k < 2; ++k) \
        acc[ai][bj][m][n] = __builtin_amdgcn_mfma_f32_16x16x32_bf16(Bt[n][k], At[m][k], acc[ai][bj][m][n], 0, 0, 0); __builtin_amdgcn_s_setprio(0); } while (0)
#define PG8_WAIT_V(n) asm volatile("s_waitcnt vmcnt(" #n ")" ::: "memory")
#define PG8_WAIT_L(n) asm volatile("s_waitcnt lgkmcnt(" #n ")" ::: "memory")
#define PG8_BAR __builtin_amdgcn_s_barrier()
#define PG8_SCHED __builtin_amdgcn_sched_barrier(0)
    Unit cur, nxt; int ui = 0;
    if (!S.next(0, cur)) return;
    f32x4 acc[2][2][4][2];
#pragma unroll
    for (int a = 0; a < 2; ++a)
#pragma unroll
        for (int b = 0; b < 2; ++b)
#pragma unroll
            for (int m = 0; m < 4; ++m)
#pragma unroll
                for (int n = 0; n < 2; ++n) acc[a][b][m][n] = (f32x4){0.f, 0.f, 0.f, 0.f};
    bf16x8 At[4][2], B0[2][2], B1[2][2];
    const char* cA = (const char*)g.A + (size_t)cur.pm * tstep; const char* cB = (const char*)g.Bt + (size_t)cur.pn * tstep;
    S.a_ready(cur);
    if constexpr (SP2) {
        PG8_STAGE(PG8_SB(0, 0), cB, voffB); PG8_STAGE(PG8_SB(0, 1), cB + hstep, voffB); PG8_STAGE(PG8_SA(0, 0), cA, voffA); PG8_STAGE(PG8_SA(0, 1), cA + hstep, voffA);
        if (wr == 1) PG8_BAR;
        PG8_WAIT_V(2); PG8_BAR;
        PG8_STAGE(PG8_SB(1, 0), cB + kstep, voffB); PG8_STAGE(PG8_SA(1, 0), cA + kstep, voffA); PG8_STAGE(PG8_SB(1, 1), cB + hstep + kstep, voffB);
        PG8_WAIT_V(6); PG8_BAR;
    } else {
        PG8_STAGE(PG8_SB(0, 0), cB, voffB); PG8_STAGE(PG8_SA(0, 0), cA, voffA); PG8_STAGE(PG8_SB(0, 1), cB + hstep, voffB); PG8_STAGE(PG8_SA(0, 1), cA + hstep, voffA);
        if (wr == 1) PG8_BAR;
        PG8_WAIT_V(4); PG8_BAR;
        PG8_STAGE(PG8_SB(1, 0), cB + kstep, voffB); PG8_STAGE(PG8_SA(1, 0), cA + kstep, voffA); PG8_STAGE(PG8_SB(1, 1), cB + hstep + kstep, voffB);
        PG8_WAIT_V(6); PG8_BAR;
    }
    for (;;) {
        const bool has_next = S.next(ui + 1, nxt);
        const char* nA = has_next ? (const char*)g.A + (size_t)nxt.pm * tstep : cA; const char* nB = has_next ? (const char*)g.Bt + (size_t)nxt.pn * tstep : cB;
        for (int t = 0; t < nt; t += 2) {
            const bool last = (t == nt - 2);
            const char* a1 = cA + (size_t)(t + 1) * kstep;
            const char* a2 = last ? nA : cA + (size_t)(t + 2) * kstep; const char* b2 = last ? nB : cB + (size_t)(t + 2) * kstep;
            const char* a3 = a2 + kstep; const char* b3 = b2 + kstep;
            if (last && has_next) S.a_ready(nxt);
            if constexpr (SP2) {
            PG8_LDB(B0, 0, 0); PG8_LDB(B1, 0, 1); PG8_SCHED; PG8_LDA(At, 0, 0); PG8_STAGE(PG8_SA(1, 1), a1 + hstep, voffA);
            PG8_WAIT_V(8); PG8_WAIT_L(0); PG8_BAR; PG8_MMA(0, 0, At, B0); PG8_MMA(0, 1, At, B1); PG8_BAR; PG8_SCHED;
            PG8_LDA(At, 0, 1); PG8_STAGE(PG8_SB(0, 0), b2, voffB); PG8_STAGE(PG8_SB(0, 1), b2 + hstep, voffB); PG8_STAGE(PG8_SA(0, 0), a2, voffA);
            PG8_WAIT_V(8); PG8_WAIT_L(0); PG8_BAR; PG8_MMA(1, 0, At, B0); PG8_MMA(1, 1, At, B1); PG8_BAR; PG8_SCHED;
            PG8_LDB(B0, 1, 0); PG8_LDB(B1, 1, 1); PG8_SCHED; PG8_LDA(At, 1, 0); PG8_STAGE(PG8_SA(0, 1), a2 + hstep, voffA);
            PG8_WAIT_V(8); PG8_WAIT_L(0); PG8_BAR; PG8_MMA(0, 0, At, B0); PG8_MMA(0, 1, At, B1); PG8_BAR; PG8_SCHED;
            PG8_LDA(At, 1, 1); PG8_STAGE(PG8_SB(1, 0), b3, voffB); PG8_STAGE(PG8_SB(1, 1), b3 + hstep, voffB); PG8_STAGE(PG8_SA(1, 0), a3, voffA);
            PG8_WAIT_V(8); PG8_WAIT_L(0); PG8_BAR; PG8_MMA(1, 0, At, B0); PG8_MMA(1, 1, At, B1); PG8_BAR; PG8_SCHED;
            if constexpr (Epi::KHOOK) { if ((((t + 2) & 7) == 0) && (t + 2 < nt)) E.khook(acc, ((t + 2) >> 3) - 1, wr, fr); }
            } else {
            PG8_LDB(B0, 0, 0); PG8_SCHED; PG8_LDA(At, 0, 0); PG8_STAGE(PG8_SA(1, 1), a1 + hstep, voffA);
            PG8_WAIT_L(8); PG8_BAR; PG8_WAIT_L(0); PG8_MMA(0, 0, At, B0); PG8_BAR; PG8_SCHED;
            PG8_LDB(B1, 0, 1); PG8_STAGE(PG8_SB(0, 0), b2, voffB);
            PG8_BAR; PG8_WAIT_L(0); PG8_MMA(0, 1, At, B1); PG8_BAR;
            PG8_LDA(At, 0, 1); PG8_STAGE(PG8_SA(0, 0), a2, voffA);
            PG8_BAR; PG8_WAIT_L(0); PG8_MMA(1, 0, At, B0); PG8_BAR; PG8_SCHED;
            PG8_STAGE(PG8_SB(0, 1), b2 + hstep, voffB);
            PG8_WAIT_V(6); PG8_BAR; PG8_MMA(1, 1, At, B1); PG8_BAR;
            PG8_LDB(B0, 1, 0); PG8_SCHED; PG8_LDA(At, 1, 0); PG8_STAGE(PG8_SA(0, 1), a2 + hstep, voffA);
            PG8_WAIT_L(8); PG8_BAR; PG8_WAIT_L(0); PG8_MMA(0, 0, At, B0); PG8_BAR; PG8_SCHED;
            PG8_LDB(B1, 1, 1); PG8_STAGE(PG8_SB(1, 0), b3, voffB);
            PG8_BAR; PG8_WAIT_L(0); PG8_MMA(0, 1, At, B1); PG8_BAR;
            PG8_LDA(At, 1, 1); PG8_STAGE(PG8_SA(1, 0), a3, voffA);
            PG8_BAR; PG8_WAIT_L(0); PG8_MMA(1, 0, At, B0); PG8_BAR; PG8_SCHED;
            PG8_STAGE(PG8_SB(1, 1), b3 + hstep, voffB);
            PG8_WAIT_V(6); PG8_BAR; PG8_MMA(1, 1, At, B1); PG8_BAR;
            }
        }
        if constexpr (ALIGN_EPI) { if (wr == 0) PG8_BAR; }
        if constexpr (!Epi::AFTER_DRAIN) { E(acc, cur, wr, wc, fr, fq); S.done(cur); }
        if (!has_next) break;
#pragma unroll
        for (int a = 0; a < 2; ++a)
#pragma unroll
            for (int b = 0; b < 2; ++b)
#pragma unroll
                for (int m = 0; m < 4; ++m)
#pragma unroll
                    for (int n = 0; n < 2; ++n) acc[a][b][m][n] = (f32x4){0.f, 0.f, 0.f, 0.f};
        cur = nxt; cA = nA; cB = nB; ++ui;
        if constexpr (ALIGN_EPI) { if (wr == 1) PG8_BAR; }
    }
    PG8_WAIT_V(0);
    if constexpr (!ALIGN_EPI) { if (wr == 0) PG8_BAR; }
    PG8_BAR;
    if constexpr (Epi::AFTER_DRAIN) { E.fused(acc, cur, wr, wc, fr, fq, lds, wid, lane); S.done(cur); }
#undef PG8_SA
#undef PG8_SB
#undef PG8_STAGE
#undef PG8_LDA
#undef PG8_LDB
#undef PG8_MMA
#undef PG8_WAIT_V
#undef PG8_WAIT_L
#undef PG8_BAR
#undef PG8_SCHED
}
}

using pg8::bf16_t; using pg8::bf16x8; using pg8::f32x4; using pg8::u32x4; using pg8::u32x2; using pg8::cvt_pk_bf16;
#define LAS __attribute__((address_space(3)))
typedef float f32x16 __attribute__((ext_vector_type(16)));
typedef short s16x4 __attribute__((ext_vector_type(4)));

constexpr int BATCH = 8, SEQ = 2048, D = 1024, M = BATCH * SEQ, FF = 4096;
constexpr int RH = 4, RDK = 256, RDV = 512, RVW = RH * RDV, RIN = 6144, RC = 128, NCH = SEQ / RC;
constexpr int FH = 16, FD = 64;
constexpr int ADA_LD = 14336;
constexpr float EPS = 1e-6f;
constexpr float LOG2E = 1.4426950408889634f;
constexpr float QSCALE = 0.125f * LOG2E;

constexpr size_t MiB = 1u << 20;
constexpr size_t WS_ADA = 1 * MiB, WS_LOGF = 2 * MiB, WS_SSQ = 4 * MiB;
constexpr size_t WS_SSQ2 = 3 * MiB;
constexpr size_t WS_BIAS2 = 1 * MiB + 512 * 1024;
constexpr size_t B2_MLP0 = 0, B2_MLP1 = 8 * 4096, B2_KV = 16 * 4096, B2_FOX = 16 * 4096 + 8 * 2304;
constexpr size_t WS_WRIN = 8 * MiB, WS_WROUT = 20 * MiB, WS_WM1_0 = 24 * MiB;
constexpr size_t WS_TAB = 32 * MiB;
constexpr size_t WS_HKV = 8 * MiB;
constexpr size_t WS_WM2_0 = 48 * MiB, WS_WM1_1 = 56 * MiB, WS_WM2_1 = 64 * MiB, WS_WKV = 72 * MiB, WS_WFIN = 77 * MiB, WS_WFOUT = 81 * MiB;
constexpr size_t WS_HN = 83 * MiB;
constexpr size_t WS_BIG = 115 * MiB;
constexpr size_t WS_END = 243 * MiB;

constexpr int LDS_BYTES = 155648;
constexpr int RING_BYTES = 131072;
constexpr int RTAB_OFF = 132096;
constexpr int WSCR_OFF = 136192;
constexpr int XBST_OFF = LDS_BYTES - 64;
constexpr size_t WS_CTL = 0, CTL_ZERO_BYTES = 16384;

__device__ __forceinline__ float bf2f(unsigned b) { return __uint_as_float(b << 16); }
__device__ __forceinline__ unsigned f2bf(float f) { unsigned u = __float_as_uint(f); return (u + 0x7fffu + ((u >> 16) & 1u)) >> 16; }
__device__ __forceinline__ unsigned pk2(float lo, float hi) { return f2bf(lo) | (f2bf(hi) << 16); }
__device__ __forceinline__ float wave_sum(float v) {
#pragma unroll
    for (int o = 1; o < 64; o <<= 1) v += __shfl_xor(v, o);
    return v;
}
#define LDS_WAIT() asm volatile("s_waitcnt lgkmcnt(0)" ::: "memory")

struct Args {
    const float* x; const float* c; const int* pos;
    const float *nmg, *nlg, *w_ada, *b_ada, *w_mlp_in, *w_mlp_out, *ret_w_in, *ret_ng, *ret_w_out, *kv_ng, *kv_w_ada, *kv_b_ada, *kv_w, *fbias, *k_ng, *fox_w_in, *q_ng, *fox_w_out;
    float* out; unsigned char* ws;
};

__device__ __forceinline__ int perm_row(int n) { return (n & ~255) + 128 * ((n >> 5) & 1) + 32 * ((n >> 6) & 3) + (n & 31); }
struct TDesc { const float* W; int ldw, K, nblk; bf16_t* WT; int permute, r; };
__device__ __forceinline__ void transpose_load(const TDesc& d, f32x4 (&wv)[16], int lane) {
    const int kb = d.r / d.nblk, nb = d.r % d.nblk;
    const float* wp = d.W + (size_t)(64 * kb + (lane >> 4)) * d.ldw + 64 * nb + 4 * (lane & 15);
#pragma unroll
    for (int i = 0; i < 16; ++i) wv[i] = *(const f32x4*)(wp + (size_t)(4 * i) * d.ldw);
}
__device__ __forceinline__ void transpose_to_lds(const f32x4 (&wv)[16], LAS float* scr, int lane) {
#pragma unroll
    for (int i = 0; i < 16; ++i) { LAS float* sp = scr + (4 * i + (lane >> 4)) * 65 + 4 * (lane & 15); sp[0] = wv[i][0]; sp[1] = wv[i][1]; sp[2] = wv[i][2]; sp[3] = wv[i][3]; }
    LDS_WAIT(); asm volatile("" ::: "memory");
}
__device__ __forceinline__ void transpose_store(const TDesc& d, LAS float* scr, int lane) {
    const int kb = d.r / d.nblk, nb = d.r % d.nblk, k0 = 64 * kb, n0 = 64 * nb;
    const int c = lane & 7;
#pragma unroll
    for (int j = 0; j < 8; ++j) { const int n = (lane >> 3) + 8 * j; const LAS float* s = scr + (8 * c) * 65 + n;
        u32x4 o; o.x = pk2(s[0 * 65], s[1 * 65]); o.y = pk2(s[2 * 65], s[3 * 65]); o.z = pk2(s[4 * 65], s[5 * 65]); o.w = pk2(s[6 * 65], s[7 * 65]);
        const int r = d.permute ? perm_row(n0 + n) : n0 + n;
        *(u32x4*)(d.WT + (size_t)r * d.K + k0 + 8 * c) = o; }
    LDS_WAIT(); asm volatile("" ::: "memory");
}

__device__ __forceinline__ void phase0(const Args& a, LAS unsigned char* lds, int tid, int lane, int wave) {
    unsigned char* ws = a.ws;
    const int G = gridDim.x, bx = blockIdx.x;
    LAS float* cact = (LAS float*)lds;
    LAS float* red = (LAS float*)(lds + 32768);
    float* ADA = (float*)(ws + WS_ADA);
    for (int it = bx; it < ADA_LD / 64; it += G) {
        __syncthreads();
        for (int i = tid; i < BATCH * D; i += 512) { const int b = i >> 10, k = i & 1023; const float v = a.c[i]; cact[k * 8 + b] = v * pg8::fast_sigmoid(v); }
        __syncthreads();
        const int n0 = it * 64;
        const float* W; const float* bias; int ldw, nn;
        if (n0 < 6144) { W = a.w_ada; bias = a.b_ada; ldw = 6144; nn = n0; }
        else if (n0 < 12288) { W = a.w_ada + (size_t)D * 6144; bias = a.b_ada + 6144; ldw = 6144; nn = n0 - 6144; }
        else { W = a.kv_w_ada; bias = a.kv_b_ada; ldw = 2048; nn = n0 - 12288; }
        float acc[8];
#pragma unroll
        for (int b = 0; b < 8; ++b) acc[b] = 0.f;
        const float* wp = W + (size_t)(wave * 128) * ldw + nn + lane;
        for (int kb = 0; kb < 128; kb += 16) {
            float wv[16];
#pragma unroll
            for (int i = 0; i < 16; ++i) wv[i] = wp[(size_t)(kb + i) * ldw];
            __builtin_amdgcn_sched_barrier(0);
#pragma unroll
            for (int i = 0; i < 16; ++i) {
                const float w = wv[i];
                const f32x4 c0 = *(const LAS f32x4*)(cact + (wave * 128 + kb + i) * 8), c1 = *(const LAS f32x4*)(cact + (wave * 128 + kb + i) * 8 + 4);
                acc[0] += c0[0] * w; acc[1] += c0[1] * w; acc[2] += c0[2] * w; acc[3] += c0[3] * w;
                acc[4] += c1[0] * w; acc[5] += c1[1] * w; acc[6] += c1[2] * w; acc[7] += c1[3] * w;
            }
            __builtin_amdgcn_sched_barrier(0);
        }
#pragma unroll
        for (int b = 0; b < 8; ++b) red[(wave * 8 + b) * 64 + lane] = acc[b];
        __syncthreads();
        { const int b = tid >> 6; float s = bias[nn + lane];
#pragma unroll
          for (int w = 0; w < 8; ++w) s += red[(w * 8 + b) * 64 + lane];
          ADA[(size_t)b * ADA_LD + n0 + lane] = s; }
    }
    __syncthreads();
    {
        LAS float* scr = (LAS float*)(lds + wave * 16640);
        const int gw = bx * 8 + wave, NGW = G * 8;
        constexpr int I0 = 16 * 96, I1 = 32 * 16, I2 = 16 * 64, I3 = 64 * 16, I4 = 16 * 32, I5 = 16 * 32, I6 = 16 * 16;
        constexpr int NITEMS = I0 + I1 + 2 * I2 + 2 * I3 + I4 + I5 + I6;
        auto desc = [&](int it) -> TDesc {
            int r = it;
            if (r < I0) return TDesc{a.ret_w_in, RIN, D, 96, (bf16_t*)(ws + WS_WRIN), 0, r}; r -= I0;
            if (r < I1) return TDesc{a.ret_w_out, D, RVW, 16, (bf16_t*)(ws + WS_WROUT), 0, r}; r -= I1;
            if (r < I2) return TDesc{a.w_mlp_in, FF, D, 64, (bf16_t*)(ws + WS_WM1_0), 0, r}; r -= I2;
            if (r < I2) return TDesc{a.w_mlp_in + (size_t)D * FF, FF, D, 64, (bf16_t*)(ws + WS_WM1_1), 0, r}; r -= I2;
            if (r < I3) return TDesc{a.w_mlp_out, D, FF, 16, (bf16_t*)(ws + WS_WM2_0), 0, r}; r -= I3;
            if (r < I3) return TDesc{a.w_mlp_out + (size_t)FF * D, D, FF, 16, (bf16_t*)(ws + WS_WM2_1), 0, r}; r -= I3;
            if (r < I4) return TDesc{a.kv_w, 2 * D + FH, D, 32, (bf16_t*)(ws + WS_WKV), 1, r}; r -= I4;
            if (r < I5) return TDesc{a.fox_w_in, 2 * D, D, 32, (bf16_t*)(ws + WS_WFIN), 1, r}; r -= I5;
            return TDesc{a.fox_w_out, D, D, 16, (bf16_t*)(ws + WS_WFOUT), 0, r};
        };
        f32x4 wv[16];
        int it = gw;
        TDesc cur{}; if (it < NITEMS) { cur = desc(it); transpose_load(cur, wv, lane); }
        while (it < NITEMS) {
            transpose_to_lds(wv, scr, lane);
            const int nx = it + NGW; TDesc nd{};
            if (nx < NITEMS) { nd = desc(nx); transpose_load(nd, wv, lane); }
            transpose_store(cur, scr, lane);
            cur = nd; it = nx;
        }
    }
    const int gt = bx * 512 + tid, NT = G * 512;
    {
        bf16_t* wkv = (bf16_t*)(ws + WS_WKV) + (size_t)2048 * D;
        for (int i = gt; i < 256 * (D / 8); i += NT) {
            const int row = i >> 7, c8 = i & 127; u32x4 o = (u32x4){0u, 0u, 0u, 0u};
            if (row < FH) { float v[8];
#pragma unroll
                for (int e = 0; e < 8; ++e) v[e] = a.kv_w[(size_t)(8 * c8 + e) * (2 * D + FH) + 2 * D + row];
                o.x = pk2(v[0], v[1]); o.y = pk2(v[2], v[3]); o.z = pk2(v[4], v[5]); o.w = pk2(v[6], v[7]); }
            *(u32x4*)(wkv + (size_t)row * D + 8 * c8) = o;
        }
    }
    {
        float* tab = (float*)(ws + WS_TAB);
        const int i = gt & 127;
        double invf = 1.0; { const double r = 0.93057204092969897;
            for (int k = 0; k < i; ++k) invf *= r; }
        for (int idx0 = gt; idx0 < M * 128; idx0 += 16 * NT) {
            int pv[16];
#pragma unroll
            for (int k = 0; k < 16; ++k) { const int idx = idx0 + k * NT; pv[k] = (idx < M * 128) ? a.pos[idx >> 7] : 0; }
#pragma unroll
            for (int k = 0; k < 16; ++k) { const int idx = idx0 + k * NT;
                if (idx < M * 128) {
                    double rev = (double)pv[k] * invf * 0.15915494309189535; rev -= floor(rev);
                    const float rf = (float)rev;
                    *(pg8::f32x2*)(tab + (size_t)idx * 2) = (pg8::f32x2){__builtin_amdgcn_cosf(rf), __builtin_amdgcn_sinf(rf)}; } }
        }
    }
}

__device__ __forceinline__ void norm_rows(const float* xs, const float* gain, const float* shift, const float* scale, bf16_t* out, int lane, int wave) {
    const int gw = blockIdx.x * 8 + wave, NGW = gridDim.x * 8;
    const int per = (M + NGW - 1) / NGW, r0 = gw * per, r1 = (r0 + per < M) ? r0 + per : M;
    if (r0 >= r1) return;
    f32x4 gs[4], sh[4]; int bcur = -1;
    f32x4 vn[4];
    { const f32x4* xr = (const f32x4*)(xs + (size_t)r0 * D) + lane;
#pragma unroll
      for (int j = 0; j < 4; ++j) vn[j] = xr[64 * j]; }
    for (int row = r0; row < r1; ++row) {
        f32x4 v[4];
#pragma unroll
        for (int j = 0; j < 4; ++j) v[j] = vn[j];
        if (row + 1 < r1) { const f32x4* xr = (const f32x4*)(xs + (size_t)(row + 1) * D) + lane;
#pragma unroll
            for (int j = 0; j < 4; ++j) vn[j] = xr[64 * j]; }
        const int b = row >> 11;
        if (b != bcur) { bcur = b;
#pragma unroll
            for (int j = 0; j < 4; ++j) { const int col = 4 * lane + 256 * j;
                gs[j] = *(const f32x4*)(gain + col) * (*(const f32x4*)(scale + (size_t)b * ADA_LD + col) + 1.f); sh[j] = *(const f32x4*)(shift + (size_t)b * ADA_LD + col); } }
        float ss = 0.f;
#pragma unroll
        for (int j = 0; j < 4; ++j) ss += (v[j][0] * v[j][0] + v[j][1] * v[j][1]) + (v[j][2] * v[j][2] + v[j][3] * v[j][3]);
        const float rstd = rsqrtf(wave_sum(ss) * (1.f / D) + EPS);
#pragma unroll
        for (int j = 0; j < 4; ++j) {
            const f32x4 o = v[j] * rstd * gs[j] + sh[j];
            u32x2 w; w.x = cvt_pk_bf16(o[0], o[1]); w.y = cvt_pk_bf16(o[2], o[3]);
            *(u32x2*)(out + (size_t)row * D + 4 * lane + 256 * j) = w;
        }
    }
}

__device__ __forceinline__ void bias2_rows(const bf16_t* Wt, int nrows, const float* shift  , float* out, int out_ld, int lane, int wave) {
    const int gw = blockIdx.x * 8 + wave, NGW = gridDim.x * 8;
    if (gw >= nrows) return;
    float sh[8][16];
#pragma unroll
    for (int b = 0; b < 8; ++b)
#pragma unroll
        for (int q = 0; q < 4; ++q) { const f32x4 v = *(const f32x4*)(shift + (size_t)b * ADA_LD + 16 * lane + 4 * q); sh[b][4 * q] = v[0]; sh[b][4 * q + 1] = v[1]; sh[b][4 * q + 2] = v[2]; sh[b][4 * q + 3] = v[3]; }
    u32x4 n0 = *(const u32x4*)(Wt + (size_t)gw * D + 16 * lane), n1 = *(const u32x4*)(Wt + (size_t)gw * D + 16 * lane + 8);
    for (int r = gw; r < nrows; r += NGW) {
        const u32x4 w0 = n0, w1 = n1;
        if (r + NGW < nrows) { n0 = *(const u32x4*)(Wt + (size_t)(r + NGW) * D + 16 * lane); n1 = *(const u32x4*)(Wt + (size_t)(r + NGW) * D + 16 * lane + 8); }
        const unsigned ww[8] = {w0.x, w0.y, w0.z, w0.w, w1.x, w1.y, w1.z, w1.w};
        float wf[16];
#pragma unroll
        for (int i = 0; i < 8; ++i) { wf[2 * i] = bf2f(ww[i] & 0xffffu); wf[2 * i + 1] = bf2f(ww[i] >> 16); }
        float res = 0.f;
#pragma unroll
        for (int b = 0; b < 8; ++b) { float s = 0.f;
#pragma unroll
            for (int i = 0; i < 16; ++i) s += sh[b][i] * wf[i];
            s = wave_sum(s); if (lane == b) res = s; }
        if (lane < 8) out[(size_t)lane * out_ld + r] = res;
    }
}

__device__ __forceinline__ void logf_rows(const bf16_t* HKV, const bf16_t* Wf, const float* ssq2, const float* bias, int bias_ld, const float* fbias, float* logf, LAS unsigned char* lds, int tid, int lane, int w) {
    const int r32 = lane & 31, hh = lane >> 5;
    LAS float* part = (LAS float*)lds;
    for (int rt = blockIdx.x; rt < M / 64; rt += gridDim.x) {
        const size_t row0 = (size_t)rt * 64;
        f32x16 acc[2];
#pragma unroll
        for (int i = 0; i < 16; ++i) { acc[0][i] = 0.f; acc[1][i] = 0.f; }
        const bf16_t* ap = HKV + (row0 + r32) * 1024 + 128 * w + 8 * hh;
        const bf16_t* bp = Wf + (size_t)r32 * 1024 + 128 * w + 8 * hh;
#pragma unroll
        for (int ks = 0; ks < 8; ++ks) { const bf16x8 bf = *(const bf16x8*)(bp + 16 * ks);
#pragma unroll
            for (int rb = 0; rb < 2; ++rb) { const bf16x8 af = *(const bf16x8*)(ap + (size_t)rb * 32 * 1024 + 16 * ks); acc[rb] = __builtin_amdgcn_mfma_f32_32x32x16_bf16(af, bf, acc[rb], 0, 0, 0); } }
        __syncthreads();
        if (r32 < 16) {
#pragma unroll
            for (int rb = 0; rb < 2; ++rb)
#pragma unroll
                for (int i = 0; i < 16; ++i) part[(w * 64 + 32 * rb + (i & 3) + 8 * (i >> 2) + 4 * hh) * 16 + r32] = acc[rb][i];
        }
        __syncthreads();
        for (int o = tid; o < 1024; o += 512) {
            const int row = o >> 4, hd = o & 15;
            float s = 0.f;
#pragma unroll
            for (int ww = 0; ww < 8; ++ww) s += part[(ww * 64 + row) * 16 + hd];
            const f32x4* sp = (const f32x4*)(ssq2 + (row0 + row) * 16); const f32x4 a = sp[0], b = sp[1], c = sp[2], d = sp[3];
            const float q = ((a[0] + a[1]) + (a[2] + a[3])) + ((b[0] + b[1]) + (b[2] + b[3])) + ((c[0] + c[1]) + (c[2] + c[3])) + ((d[0] + d[1]) + (d[2] + d[3]));
            const float z = s * rsqrtf(q * (1.f / 1024.f) + EPS) + bias[(row0 >> 11) * bias_ld + hd] + fbias[hd];
            logf[(row0 + row) * 16 + hd] = fminf(z, 0.f) - log1pf(__expf(-fabsf(z)));
        }
    }
    __syncthreads();
}

#ifndef RET_PREF_K
#define RET_PREF_K 1
#endif
namespace ret {
constexpr int KP = 528, VP = 272, PP = 272, RP = 528;
constexpr int L_KC = 0, L_VT = 128 * KP, L_PS = L_VT + 64 * VP, L_RB = L_PS + 128 * PP, L_DEC = L_RB + 64 * RP, L_END = L_DEC + 1024;
static_assert(L_END <= XBST_OFF, "retention LDS");
__device__ __forceinline__ s16x4 tr_read(const LAS unsigned char* p) { return __builtin_bit_cast(s16x4, __builtin_amdgcn_ds_read_tr16_b64_v4i16((LAS s16x4*)p)); }

template <int CTRL, int RMASK> __device__ __forceinline__ float dpp_add(float v) { return v + __int_as_float(__builtin_amdgcn_update_dpp(0, __float_as_int(v), CTRL, RMASK, 0xf, true)); }
__device__ __forceinline__ float half_sum_hi(float v) { v = dpp_add<0x111, 0xf>(v); v = dpp_add<0x112, 0xf>(v); v = dpp_add<0x114, 0xf>(v); v = dpp_add<0x118, 0xf>(v); return dpp_add<0x142, 0xa>(v); }

__device__ __forceinline__ void unit(const bf16_t* Q, const bf16_t* Kr, const bf16_t* V, bf16_t* G, float* SSQ, const float* rgain, int b, int h, int vs, LAS unsigned char* lds, int tid, int lane, int w, bool dry = false) {
    const int r32 = lane & 31, hh = lane >> 5, rb = w & 3, cx = w >> 2;
    const float gam = 1.f - exp2f(-5.f - (float)h), lg = log2f(gam), gC = exp2f(128.f * lg);
    LAS float* kd = (LAS float*)(lds + L_DEC);
    LAS float* rs1 = (LAS float*)(lds + L_DEC + 512);
    __syncthreads();
    if (tid < 128) { kd[tid] = exp2f((float)(127 - tid) * lg); rs1[tid] = exp2f((float)(tid - 127) * lg); }
    f32x16 racc[2];
#pragma unroll
    for (int i = 0; i < 16; ++i) { racc[0][i] = 0.f; racc[1][i] = 0.f; }
    const int col = h * RDV + vs * 64 + cx * 32 + r32;
    const float gn = rgain[col];
    const int trrow = 8 * (lane >> 5) + ((lane & 15) >> 2), trcol = 16 * ((lane >> 4) & 1) + 4 * (lane & 3);
    const size_t row0 = (size_t)b * SEQ;
    const bf16_t* kg = Kr + (row0 + (tid >> 5)) * 1024 + h * RDK + 8 * (tid & 31);
    const bf16_t* vg = V + ((size_t)((b * 4 + h) * 8 + vs) * 16) * 8192 + (size_t)(tid >> 7) * 1024 + (tid & 127) * 8;
    const bf16_t* qg = Q + ((size_t)(b * 4 + h) * 64 + rb) * 8192 + hh * 256 + r32 * 8;
    u32x4 kreg[8], vreg[2]; bf16x8 qf[16];
#pragma unroll
    for (int i = 0; i < 8; ++i) kreg[i] = *(const u32x4*)(kg + (size_t)(16 * i) * 1024);
#pragma unroll
    for (int i = 0; i < 2; ++i) vreg[i] = *(const u32x4*)(vg + (size_t)(4 * i) * 1024);
#pragma unroll
    for (int ks = 0; ks < 16; ++ks) qf[ks] = *(const bf16x8*)(qg + 512 * ks);
    for (int ch = 0; ch < NCH; ++ch) {
        const size_t rowbase = row0 + (size_t)ch * RC;
        const bool more = ch + 1 < NCH;
        __syncthreads();
#if !RET_PREF_K
        if (ch > 0) {
#pragma unroll
            for (int i = 0; i < 8; ++i) kreg[i] = *(const u32x4*)(kg + (size_t)(ch * RC + 16 * i) * 1024);
#pragma unroll
            for (int i = 0; i < 2; ++i) vreg[i] = *(const u32x4*)(vg + (size_t)(ch * RC + 64 * i) * RVW);
        }
#endif
#pragma unroll
        for (int i = 0; i < 8; ++i) *(LAS u32x4*)(lds + L_KC + ((tid >> 5) + 16 * i) * KP + 16 * (tid & 31)) = kreg[i];
#pragma unroll
        for (int i = 0; i < 2; ++i) { const int tok = tid & 127, c8 = (tid >> 7) + 4 * i;
            const unsigned wv[4] = {vreg[i].x, vreg[i].y, vreg[i].z, vreg[i].w};
#pragma unroll
            for (int e = 0; e < 4; ++e) {
                *(LAS unsigned short*)(lds + L_VT + (8 * c8 + 2 * e) * VP + tok * 2) = (unsigned short)(wv[e] & 0xffffu);
                *(LAS unsigned short*)(lds + L_VT + (8 * c8 + 2 * e + 1) * VP + tok * 2) = (unsigned short)(wv[e] >> 16);
            } }
#pragma unroll
        for (int vt = 0; vt < 2; ++vt) {
#pragma unroll
            for (int i = 0; i < 16; ++i) racc[vt][i] *= gC;
#pragma unroll
            for (int g = 0; g < 4; ++g) { u32x2 o; o.x = cvt_pk_bf16(racc[vt][4 * g], racc[vt][4 * g + 1]); o.y = cvt_pk_bf16(racc[vt][4 * g + 2], racc[vt][4 * g + 3]);
                *(LAS u32x2*)(lds + L_RB + (32 * vt + r32) * RP + (32 * w + 8 * g + 4 * hh) * 2) = o; }
        }
#if RET_PREF_K
        if (more) {
#pragma unroll
            for (int i = 0; i < 8; ++i) kreg[i] = *(const u32x4*)(kg + (size_t)((ch + 1) * RC + 16 * i) * 1024);
#pragma unroll
            for (int i = 0; i < 2; ++i) vreg[i] = *(const u32x4*)(vg + (size_t)(ch + 1) * 8192 + (size_t)(4 * i) * 1024);
        }
#endif
        __syncthreads();
        __builtin_amdgcn_sched_barrier(0);
#pragma unroll
        for (int t = 0; t < 2; ++t) {
            const int cb = 2 * cx + t;
            if (cb <= rb) {
                f32x16 s;
#pragma unroll
                for (int i = 0; i < 16; ++i) s[i] = 0.f;
                const LAS unsigned char* kp = lds + L_KC + (32 * cb + r32) * KP + 16 * hh;
#pragma unroll
                for (int ks = 0; ks < 16; ++ks) { const bf16x8 kf = *(const LAS bf16x8*)(kp + 32 * ks); s = __builtin_amdgcn_mfma_f32_32x32x16_bf16(kf, qf[ks], s, 0, 0, 0); }
                if (cb == rb) {
#pragma unroll
                    for (int i = 0; i < 16; ++i) { const int key = (i & 3) + 8 * (i >> 2) + 4 * hh; if (key > r32) s[i] = 0.f; }
                }
#pragma unroll
                for (int g = 0; g < 4; ++g) { u32x2 o; o.x = cvt_pk_bf16(s[4 * g], s[4 * g + 1]); o.y = cvt_pk_bf16(s[4 * g + 2], s[4 * g + 3]);
                    *(LAS u32x2*)(lds + L_PS + (32 * rb + r32) * PP + (32 * cb + 8 * g + 4 * hh) * 2) = o; }
            }
        }
        __syncthreads();
        f32x16 o;
#pragma unroll
        for (int i = 0; i < 16; ++i) o[i] = 0.f;
        { const LAS unsigned char* rp = lds + L_RB + (32 * cx + r32) * RP + 16 * hh;
#pragma unroll
          for (int ks = 0; ks < 16; ++ks) { const bf16x8 rf = *(const LAS bf16x8*)(rp + 32 * ks); o = __builtin_amdgcn_mfma_f32_32x32x16_bf16(qf[ks], rf, o, 0, 0, 0); } }
        __builtin_amdgcn_sched_barrier(0);
        if (more) {
#pragma unroll
            for (int ks = 0; ks < 16; ++ks) qf[ks] = *(const bf16x8*)(qg + (size_t)(ch + 1) * 4 * 8192 + 512 * ks);
        }
        __builtin_amdgcn_sched_barrier(0);
        { const LAS unsigned char* pp = lds + L_PS + (32 * rb + r32) * PP + 16 * hh;
          const LAS unsigned char* vp = lds + L_VT + (32 * cx + r32) * VP + 16 * hh;
          const int nks = 2 * (rb + 1);
          for (int ks = 0; ks < nks; ++ks) { const bf16x8 pf = *(const LAS bf16x8*)(pp + 32 * ks), vf = *(const LAS bf16x8*)(vp + 32 * ks); o = __builtin_amdgcn_mfma_f32_32x32x16_bf16(pf, vf, o, 0, 0, 0); } }
#pragma unroll
        for (int ks = 0; ks < 8; ++ks) {
            const LAS unsigned char* kt = lds + L_KC + (16 * ks + trrow) * KP + (32 * w + trcol) * 2;
            const s16x4 lo = tr_read(kt), hi = tr_read(kt + 4 * KP);
            const bf16x8 af = (bf16x8){lo[0], lo[1], lo[2], lo[3], hi[0], hi[1], hi[2], hi[3]};
#pragma unroll
            for (int vt = 0; vt < 2; ++vt) { const bf16x8 vf = *(const LAS bf16x8*)(lds + L_VT + (32 * vt + r32) * VP + (16 * ks + 8 * hh) * 2);
                racc[vt] = __builtin_amdgcn_mfma_f32_32x32x16_bf16(af, vf, racc[vt], 0, 0, 0); }
        }
#pragma unroll
        for (int gb = 0; gb < 2; ++gb) {
            unsigned gz[8];
#pragma unroll
            for (int i = 0; i < 8; ++i) gz[i] = (unsigned)G[(rowbase + 32 * rb + (i & 3) + 8 * (2 * gb + (i >> 2)) + 4 * hh) * RVW + col];
#pragma unroll
            for (int g2 = 0; g2 < 2; ++g2) {
                const int g = 2 * gb + g2;
                const f32x4 rs = *(const LAS f32x4*)(rs1 + 32 * rb + 8 * g + 4 * hh);
#pragma unroll
                for (int j = 0; j < 4; ++j) {
                    const int q = 32 * rb + 8 * g + 4 * hh + j;
                    const float y = o[4 * g + j] * rs[j];
                    const float sq = half_sum_hi(y * y);
                    if (r32 == 31 && !dry) SSQ[(rowbase + q) * 64 + h * 16 + vs * 2 + cx] = sq;
                    const bf16_t ov = (bf16_t)f2bf(y * bf2f(gz[4 * g2 + j]) * gn);
                    if (!dry) G[(rowbase + q) * RVW + col] = ov;
                }
            }
        }
    }
}
}

namespace fox {
constexpr int TP = 144;
constexpr int L_K = 0, L_V = 2 * 128 * TP, L_KB = 4 * 128 * TP, L_WS = L_KB + SEQ * 4, L_SC = L_WS + 8 * 32 * 4, L_END = L_SC + 96;
__device__ __forceinline__ int crow(int r, int hi) { return (r & 3) + 8 * (r >> 2) + 4 * hi; }

__device__ __forceinline__ void prep(const float* logf, int b, int h, LAS unsigned char* lds, int tid, int lane, int w) {
    const size_t rowbase = (size_t)b * SEQ;
    LAS float* kb2 = (LAS float*)(lds + L_KB);
    LAS float* wsum = (LAS float*)(lds + L_SC);
    __syncthreads();
    float a[4];
#pragma unroll
    for (int i = 0; i < 4; ++i) a[i] = logf[(rowbase + 4 * tid + i) * 16 + h];
    a[1] += a[0]; a[2] += a[1]; a[3] += a[2];
    float x = a[3];
#pragma unroll
    for (int off = 1; off < 64; off <<= 1) { const float t = __shfl_up(x, off); if (lane >= off) x += t; }
    if (lane == 63) wsum[w] = x;
    __syncthreads();
    float pre = 0.f;
    for (int i = 0; i < w; ++i) pre += wsum[i];
    const float ex = pre + x - a[3];
    *(LAS f32x4*)(kb2 + 4 * tid) = (f32x4){-LOG2E * (ex + a[0]), -LOG2E * (ex + a[1]), -LOG2E * (ex + a[2]), -LOG2E * (ex + a[3])};
    __syncthreads();
}

__device__ __forceinline__ void unit(bf16_t* QY, const bf16_t* K, const bf16_t* V, const bf16_t* OG, float qk_bound, int b, int h, int qb, LAS unsigned char* lds, int tid, int lane, int w, bool dry = false) {
    const int r32 = lane & 31, hh = lane >> 5;
    const size_t rowbase = (size_t)b * SEQ; const int q0 = qb * 256;
    LAS float* kb2 = (LAS float*)(lds + L_KB);
    LAS float* wsf = (LAS float*)(lds + L_WS) + w * 32;
    LAS unsigned* flags = (LAS unsigned*)(lds + L_SC + 32);
    __syncthreads();
    bf16x8 qr[4];
    { const bf16_t* qp = QY + (rowbase + q0 + 32 * w + r32) * 1024 + h * FD + 8 * hh;
#pragma unroll
      for (int ks = 0; ks < 4; ++ks) qr[ks] = *(const bf16x8*)(qp + 16 * ks); }
    const int NT = 4 * (qb + 1), NP = NT / 2;
    const int srow = tid >> 3, sc8 = tid & 7;
    const bf16_t* kg = K + (rowbase + srow) * 1024 + h * FD + 8 * sc8;
    const bf16_t* vg = V + (rowbase + srow) * 1024 + h * FD + 8 * sc8;
    u32x4 kreg[2], vreg[2];
#pragma unroll
    for (int i = 0; i < 2; ++i) { kreg[i] = *(const u32x4*)(kg + (size_t)((NP - 1) * 128 + 64 * i) * 1024); vreg[i] = *(const u32x4*)(vg + (size_t)((NP - 1) * 128 + 64 * i) * 1024); }
#pragma unroll
    for (int i = 0; i < 2; ++i) { *(LAS u32x4*)(lds + L_K + (srow + 64 * i) * TP + 16 * sc8) = kreg[i]; *(LAS u32x4*)(lds + L_V + (srow + 64 * i) * TP + 16 * sc8) = vreg[i]; }
    __syncthreads();
    float m_run = -INFINITY, l_run = 0.f;
    f32x16 o[2];
#pragma unroll
    for (int i = 0; i < 16; ++i) { o[0][i] = 0.f; o[1][i] = 0.f; }
    const int qmin = q0 + 32 * w, query = qmin + r32;
    const int trrow = 4 * (lane >> 5) + ((lane & 15) >> 2), trcol = 16 * ((lane >> 4) & 1) + 4 * (lane & 3);
    bool wdone = false;
    int buf = 0;
#define FOX_TILE(t, kbuf, vbuf) do { \
        if (!wdone && 64 * t <= qmin + 31) { \
            f32x16 p[2]; \
_Pragma("unroll") \
            for (int half = 0; half < 2; ++half) { \
_Pragma("unroll") \
                for (int g = 0; g < 4; ++g) { const f32x4 kb = *(const LAS f32x4*)(kb2 + 64 * t + 32 * half + 8 * g + 4 * hh); \
                    p[half][4 * g] = kb[0]; p[half][4 * g + 1] = kb[1]; p[half][4 * g + 2] = kb[2]; p[half][4 * g + 3] = kb[3]; } \
_Pragma("unroll") \
                for (int ks = 0; ks < 4; ++ks) { const bf16x8 kf = *(const LAS bf16x8*)(kbuf + (32 * half + r32) * TP + (16 * ks + 8 * hh) * 2); \
                    p[half] = __builtin_amdgcn_mfma_f32_32x32x16_bf16(kf, qr[ks], p[half], 0, 0, 0); } \
            } \
            if (64 * t + 63 > qmin) { \
_Pragma("unroll") \
                for (int half = 0; half < 2; ++half) \
_Pragma("unroll") \
                    for (int i = 0; i < 16; ++i) { const int key = 64 * t + 32 * half + crow(i, hh); if (key > query) p[half][i] = -INFINITY; } \
            } \
            float mx = __builtin_fmaxf(__builtin_fmaxf(p[0][0], p[0][1]), p[1][0]); \
_Pragma("unroll") \
            for (int i = 2; i < 16; i += 2) mx = __builtin_fmaxf(__builtin_fmaxf(mx, p[0][i]), p[0][i + 1]); \
_Pragma("unroll") \
            for (int i = 1; i < 15; i += 2) mx = __builtin_fmaxf(__builtin_fmaxf(mx, p[1][i]), p[1][i + 1]); \
            mx = __builtin_fmaxf(mx, p[1][15]); \
            mx = fmaxf(mx, __shfl_xor(mx, 32)); \
            const float m_new = fmaxf(m_run, mx); \
            const float alpha = __builtin_amdgcn_exp2f(m_run - m_new); \
            const bool resc = __any(m_new > m_run); \
            m_run = m_new; \
            float ls = 0.f; \
_Pragma("unroll") \
            for (int half = 0; half < 2; ++half) \
_Pragma("unroll") \
                for (int i = 0; i < 16; ++i) { p[half][i] = __builtin_amdgcn_exp2f(p[half][i] - m_new); ls += p[half][i]; } \
            ls += __shfl_xor(ls, 32); \
            l_run = l_run * alpha + ls; \
            if (resc) { \
                if (hh == 0) wsf[r32] = alpha; \
                LDS_WAIT(); asm volatile("" ::: "memory"); \
_Pragma("unroll") \
                for (int g = 0; g < 4; ++g) { const f32x4 al = *(const LAS f32x4*)(wsf + 8 * g + 4 * hh); \
_Pragma("unroll") \
                    for (int j = 0; j < 4; ++j) { o[0][4 * g + j] *= al[j]; o[1][4 * g + j] *= al[j]; } } \
            } \
 \
_Pragma("unroll") \
            for (int half = 0; half < 2; ++half) \
_Pragma("unroll") \
                for (int s = 0; s < 2; ++s) { \
                    u32x4 pw; pw.x = cvt_pk_bf16(p[half][8 * s], p[half][8 * s + 1]); pw.y = cvt_pk_bf16(p[half][8 * s + 2], p[half][8 * s + 3]); \
                    pw.z = cvt_pk_bf16(p[half][8 * s + 4], p[half][8 * s + 5]); pw.w = cvt_pk_bf16(p[half][8 * s + 6], p[half][8 * s + 7]); \
                    const bf16x8 pf = __builtin_bit_cast(bf16x8, pw); \
                    const int kbase = 32 * half + 16 * s; \
_Pragma("unroll") \
                    for (int dt = 0; dt < 2; ++dt) { \
                        const LAS unsigned char* vp = vbuf + (kbase + trrow) * TP + (32 * dt + trcol) * 2; \
                        const s16x4 lo = ret::tr_read(vp), hi = ret::tr_read(vp + 8 * TP); \
                        const bf16x8 vf = (bf16x8){lo[0], lo[1], lo[2], lo[3], hi[0], hi[1], hi[2], hi[3]}; \
                        o[dt] = __builtin_amdgcn_mfma_f32_32x32x16_bf16(pf, vf, o[dt], 0, 0, 0); \
                    } \
                } \
 \
            if (t > 0) { const float nxt = kb2[64 * t - 1] + qk_bound + 64.f; \
                if (__all(nxt < m_run)) wdone = true; } \
        } \
    } while (0)
    for (int tp = NP - 1; tp >= 0; --tp, buf ^= 1) {
        if (tp > 0) {
#pragma unroll
            for (int i = 0; i < 2; ++i) { kreg[i] = *(const u32x4*)(kg + (size_t)((tp - 1) * 128 + 64 * i) * 1024); vreg[i] = *(const u32x4*)(vg + (size_t)((tp - 1) * 128 + 64 * i) * 1024); } }
        { const LAS unsigned char* kb1 = lds + L_K + (buf * 128 + 64) * TP; const LAS unsigned char* vb1 = lds + L_V + (buf * 128 + 64) * TP;
          const int t1 = 2 * tp + 1; FOX_TILE(t1, kb1, vb1); }
        { const LAS unsigned char* kb0 = lds + L_K + (buf * 128) * TP; const LAS unsigned char* vb0 = lds + L_V + (buf * 128) * TP;
          const int t0 = 2 * tp; FOX_TILE(t0, kb0, vb0); }
        if (lane == 0) flags[(tp & 1) * 8 + w] = wdone ? 1u : 0u;
        if (tp > 0) {
#pragma unroll
            for (int i = 0; i < 2; ++i) { *(LAS u32x4*)(lds + L_K + ((buf ^ 1) * 128 + srow + 64 * i) * TP + 16 * sc8) = kreg[i]; *(LAS u32x4*)(lds + L_V + ((buf ^ 1) * 128 + srow + 64 * i) * TP + 16 * sc8) = vreg[i]; } }
        __syncthreads();
        { const u32x4 f0 = *(const LAS u32x4*)(flags + (tp & 1) * 8), f1 = *(const LAS u32x4*)(flags + (tp & 1) * 8 + 4);
          if ((f0.x & f0.y & f0.z & f0.w & f1.x & f1.y & f1.z & f1.w) != 0u) break; }
    }
#undef FOX_TILE
    if (hh == 0) wsf[r32] = 1.f / l_run;
    LDS_WAIT(); asm volatile("" ::: "memory");
    unsigned ogv[2][16];
#pragma unroll
    for (int i = 0; i < 16; ++i)
#pragma unroll
        for (int dt = 0; dt < 2; ++dt) ogv[dt][i] = (unsigned)OG[(rowbase + q0 + 32 * w + (i & 3) + 8 * (i >> 2) + 4 * hh) * 1024 + h * FD + 32 * dt + r32];
#pragma unroll
    for (int g = 0; g < 4; ++g) { const f32x4 rl = *(const LAS f32x4*)(wsf + 8 * g + 4 * hh);
#pragma unroll
        for (int j = 0; j < 4; ++j) {
            const size_t row = rowbase + q0 + 32 * w + 8 * g + 4 * hh + j;
#pragma unroll
            for (int dt = 0; dt < 2; ++dt) { const size_t off = row * 1024 + h * FD + 32 * dt + r32;
                const bf16_t yv = (bf16_t)f2bf(o[dt][4 * g + j] * rl[j] * bf2f(ogv[dt][4 * g + j])); if (!dry) QY[off] = yv; }
        } }
}
}

#define XB_TMO      128
#define XB_XCNT(j)  (256  + 64 * (j))
#define XB_XSUB(j)  (1280 + 64 * (j))
#define XB_XGEN(j)  (2304 + 64 * (j))
#define XB_TOP      3328
#define XB_TOPGEN   3392
#define XCD_BAR_WORDS 3456
#define XB_SPIN_CAP (1u << 18)

__device__ __forceinline__ unsigned xb_ld(unsigned* p)              { return __hip_atomic_load(p, __ATOMIC_RELAXED, __HIP_MEMORY_SCOPE_AGENT); }
__device__ __forceinline__ unsigned xb_add(unsigned* p, unsigned v) { return __hip_atomic_fetch_add(p, v, __ATOMIC_RELAXED, __HIP_MEMORY_SCOPE_AGENT); }
__device__ __forceinline__ unsigned xb_xcc_id() { return (unsigned)__builtin_amdgcn_s_getreg((3 << 11) | 20) & 0xFu; }
#define XB_SPIN(cond, bar) do { unsigned _sp = 0; while (cond) { __builtin_amdgcn_s_sleep(1); \
    if ((++_sp & 255u) == 0u) { if (xb_ld(&(bar)[XB_TMO])) break; if (_sp > XB_SPIN_CAP) { atomicAdd(&(bar)[XB_TMO], 1u); break; } } } } while (0)

struct XcdBarrier {
    unsigned* bar; unsigned x;
    volatile LAS unsigned* st;
};

__device__ __forceinline__ XcdBarrier xcd_barrier_post(unsigned* bar, volatile LAS unsigned* st) {
    XcdBarrier b; b.bar = bar; b.x = xb_xcc_id(); b.st = st;
    if (threadIdx.x == 0) (void)xb_add(&bar[XB_XCNT(b.x)], 1u);
    return b;
}
__device__ __forceinline__ void xcd_barrier_complete(unsigned* bar, unsigned x, unsigned& nloc, unsigned& nx) {
    const unsigned G = gridDim.x * gridDim.y * gridDim.z;
    unsigned sum, cnt, mine, sp = 0u;
    for (;;) {
        sum = 0u; cnt = 0u; mine = 0u;
#pragma unroll
        for (unsigned j = 0; j < 16; ++j) { const unsigned c = xb_ld(&bar[XB_XCNT(j)]); sum += c; cnt += (c > 0u) ? 1u : 0u; mine = (j == x) ? c : mine; }
        if (sum == G) break;
        __builtin_amdgcn_s_sleep(1);
        if ((++sp & 255u) == 0u) { if (xb_ld(&bar[XB_TMO])) break; if (sp > XB_SPIN_CAP) { atomicAdd(&bar[XB_TMO], 1u); break; } }
    }
    nloc = mine > 0u ? mine : 1u; nx = cnt > 0u ? cnt : 1u;
}

__device__ __forceinline__ void xcd_barrier(const XcdBarrier& b) {
    asm volatile("s_waitcnt vmcnt(0)" ::: "memory");
    __syncthreads();
    if (threadIdx.x == 0) {
        unsigned* bar = b.bar;
        __builtin_amdgcn_s_waitcnt(0);
        unsigned nloc = b.st[0], nx = b.st[1];
        if (nloc == 0u) { xcd_barrier_complete(bar, b.x, nloc, nx); b.st[0] = nloc; b.st[1] = nx; }
        const unsigned old = xb_add(&bar[XB_XSUB(b.x)], 1u);
        const unsigned gen = old / nloc;
        if (old + 1u == (gen + 1u) * nloc) {
            __builtin_amdgcn_fence(__ATOMIC_RELEASE, "agent");
            asm volatile("s_waitcnt vmcnt(0)" ::: "memory");
            const unsigned og = xb_add(&bar[XB_TOP], 1u);
            const unsigned tg = og / nx;
            if (og + 1u == (tg + 1u) * nx) xb_add(&bar[XB_TOPGEN], 1u);
            else XB_SPIN(xb_ld(&bar[XB_TOPGEN]) == tg, bar);
            __builtin_amdgcn_fence(__ATOMIC_ACQUIRE, "agent");
            xb_add(&bar[XB_XGEN(b.x)], 1u);
            asm volatile("s_waitcnt vmcnt(0)" ::: "memory");
        } else {
            XB_SPIN(xb_ld(&bar[XB_XGEN(b.x)]) == gen, bar);
            __builtin_amdgcn_fence(__ATOMIC_ACQUIRE, "agent");
            asm volatile("s_waitcnt vmcnt(0)" ::: "memory");
        }
    }
    __syncthreads();
}

__global__ void __launch_bounds__(512, 2) yoco_fwd(Args a) {
    extern __shared__ __attribute__((aligned(16))) unsigned char lds_raw[];
    LAS unsigned char* lds = (LAS unsigned char*)lds_raw;
    cg::grid_group grid = cg::this_grid();
    int tid = threadIdx.x, lane = tid & 63, wave = __builtin_amdgcn_readfirstlane(tid >> 6);
#define FENCE() do { asm volatile("" : "+v"(tid)); lane = tid & 63; wave = __builtin_amdgcn_readfirstlane(tid >> 6); } while (0)
#define GSYNC_CG() do { if (G > (1 << 20)) grid.sync(); xcd_barrier(xbar); FENCE(); } while (0)
#define GSYNC() do { xcd_barrier(xbar); FENCE(); } while (0)
    const int G = gridDim.x, bx = blockIdx.x;
    const int vcu = (G % 8 == 0) ? (bx % 8) * (G / 8) + bx / 8 : bx;
    unsigned char* ws = a.ws;
    volatile LAS unsigned* bst = (volatile LAS unsigned*)(lds + XBST_OFF);
    if (tid < 2) bst[tid] = 0u;
    __syncthreads();
    const XcdBarrier xbar = xcd_barrier_post((unsigned*)(ws + WS_CTL), bst);
    float* ADA = (float*)(ws + WS_ADA);
    float* LOGF = (float*)(ws + WS_LOGF);
    float* SSQ = (float*)(ws + WS_SSQ);
    bf16_t* HN = (bf16_t*)(ws + WS_HN);
    bf16_t* HKV = (bf16_t*)(ws + WS_HKV);
    bf16_t* BIG = (bf16_t*)(ws + WS_BIG);
    bf16_t* RQ = (bf16_t*)a.out;
    bf16_t* RK = RQ + (size_t)M * 1024;
    bf16_t* RV = BIG;
    bf16_t* RG = BIG + (size_t)M * 2048;
    bf16_t* HID = BIG;
    bf16_t* KSH = BIG, *VSH = BIG + (size_t)M * 1024, *QY = BIG + (size_t)2 * M * 1024, *OG = BIG + (size_t)3 * M * 1024;
    const float* A0 = ADA, *A1 = ADA + 6144, *AKV = ADA + 12288;
    float* SSQ2 = (float*)(ws + WS_SSQ2);
    bf16_t* XB = (bf16_t*)a.out;
    bf16_t* XB2 = HKV;
    LAS float* wscr = (LAS float*)(lds + WSCR_OFF);

#ifndef EXTRA_P0
#define EXTRA_P0 0
#endif
    for (int rep = EXTRA_P0; rep >= 0; --rep) { phase0(a, lds, tid, lane, wave); __syncthreads(); }
    GSYNC_CG();
    norm_rows(a.x, a.nmg, A0, A0 + 1024, HN, lane, wave);
    { float* B2 = (float*)(ws + WS_BIAS2);
      bias2_rows((const bf16_t*)(ws + WS_WM1_0), FF, A0 + 3072, B2 + B2_MLP0, FF, lane, wave);
      bias2_rows((const bf16_t*)(ws + WS_WM1_1), FF, A1 + 3072, B2 + B2_MLP1, FF, lane, wave);
      bias2_rows((const bf16_t*)(ws + WS_WKV), 2 * D + 256, AKV, B2 + B2_KV, 2 * D + 256, lane, wave);
      bias2_rows((const bf16_t*)(ws + WS_WFIN), 2 * D, A1, B2 + B2_FOX, 2 * D, lane, wave); }
    GSYNC();
    { pg8::Gemm g{HN, (const bf16_t*)(ws + WS_WRIN), M, RIN, D}; pg8::StaticOrder S; S.init(M, RIN, G, bx);
      pg8::EpiRetIn E{RQ, RK, RV, RG, (const float*)(ws + WS_TAB)};
      pg8::gemm_phase<pg8::EpiRetIn, pg8::StaticOrder, true, true>(lds, g, S, E, tid); }
    GSYNC();
#ifndef EXTRA_P3
#define EXTRA_P3 0
#endif
    for (int rep = EXTRA_P3; rep >= 0; --rep)
    for (int u = vcu; u < BATCH * RH * 8; u += G) ret::unit(RQ, RK, RV, RG, SSQ, a.ret_ng, u >> 5, (u >> 3) & 3, u & 7, lds, tid, lane, wave, rep > 0 && G < 100000);
    GSYNC();
    { pg8::Gemm g{RG, (const bf16_t*)(ws + WS_WROUT), M, D, RVW}; pg8::StaticOrder S; S.init(M, D, G, bx);
      LAS float* rtab = (LAS float*)(lds + RTAB_OFF);
      pg8::Unit u;
      for (int i = 0; S.next(i, u); ++i) {
          __syncthreads();
          { const int r = tid >> 1, h0 = (tid & 1) * 2; const float* sp = SSQ + ((size_t)(u.pm * 256 + r) * 4 + h0) * 16;
#pragma unroll
            for (int hh = 0; hh < 2; ++hh) { float s = 0.f;
#pragma unroll
                for (int k = 0; k < 4; ++k) { const f32x4 v = *(const f32x4*)(sp + hh * 16 + 4 * k); s += (v[0] + v[1]) + (v[2] + v[3]); }
                rtab[r * 4 + h0 + hh] = rsqrtf(s * (1.f / RDV) + EPS); } }
          __syncthreads();
          pg8::OneUnit S1{u}; pg8::EpiRes<true, 1, false, true> E{a.x, XB, A0 + 2048, ADA_LD, rtab, {HN, nullptr}, {a.nlg, nullptr}, {A0 + 4096, nullptr}, SSQ2};
          pg8::gemm_phase<pg8::EpiRes<true, 1, false, true>, pg8::OneUnit, false, true>(lds, g, S1, E, tid);
      } }
    GSYNC();
#if defined(STOP_AFTER) && STOP_AFTER == 4
    return;
#endif
#ifndef EXTRA_P6
#define EXTRA_P6 0
#endif
#ifndef EXTRA_NORM
#define EXTRA_NORM 0
#endif
#ifndef EXTRA_SYNC
#define EXTRA_SYNC 0
#endif
#define MLP_IN(WM1, B2OFF) do { \
    { pg8::Gemm g{HN, (const bf16_t*)(ws + (WM1)), M, FF, D}; pg8::StaticOrder S; S.init(M, FF, G, bx); pg8::EpiSqRelu E{HID, SSQ2, (const float*)(ws + WS_BIAS2) + (B2OFF), wscr}; \
      pg8::gemm_phase<pg8::EpiSqRelu, pg8::StaticOrder, true, true>(lds, g, S, E, tid); } \
    GSYNC(); } while (0)
    MLP_IN(WS_WM1_0, B2_MLP0);
    { pg8::Gemm g{HID, (const bf16_t*)(ws + WS_WM2_0), M, D, FF}; pg8::StaticOrder S; S.init(M, D, G, bx);
      pg8::EpiRes<false, 2, true, true> E{XB, XB, A0 + 5120, ADA_LD, nullptr, {HKV, HN}, {a.kv_ng, a.nmg + D}, {AKV + 1024, A1 + 1024}, SSQ2};
      pg8::gemm_phase<pg8::EpiRes<false, 2, true, true>, pg8::StaticOrder, true, true>(lds, g, S, E, tid); }
    GSYNC();
#if defined(STOP_AFTER) && STOP_AFTER == 7
    return;
#endif
    logf_rows(HKV, (const bf16_t*)(ws + WS_WKV) + (size_t)2048 * D, SSQ2, (const float*)(ws + WS_BIAS2) + B2_KV + 2048, 2 * D + 256, a.fbias, LOGF, lds, tid, lane, wave);
    { pg8::Gemm g{HKV, (const bf16_t*)(ws + WS_WKV), M, 2 * D, D}; pg8::StaticOrder S; S.init(M, 2 * D, G, bx);
      pg8::EpiHeads<0> E{KSH, VSH, a.k_ng, 1.f, LOGF, a.fbias, SSQ2, (const float*)(ws + WS_BIAS2) + B2_KV, 2 * D + 256, wscr};
      pg8::gemm_phase<pg8::EpiHeads<0>, pg8::StaticOrder, true, true>(lds, g, S, E, tid); }
    FENCE();
    { pg8::Gemm g{HN, (const bf16_t*)(ws + WS_WFIN), M, 2 * D, D}; pg8::StaticOrder S; S.init(M, 2 * D, G, bx);
      pg8::EpiHeads<1> E{QY, OG, a.q_ng, QSCALE, nullptr, nullptr, SSQ2, (const float*)(ws + WS_BIAS2) + B2_FOX, 2 * D, wscr};
      pg8::gemm_phase<pg8::EpiHeads<1>, pg8::StaticOrder, true, true>(lds, g, S, E, tid); }
    GSYNC();
#ifndef SKIP_ATTN
#ifndef EXTRA_P10
#define EXTRA_P10 0
#endif
    float qk_bound;
    { float gq = fabsf(a.q_ng[lane]), gk = fabsf(a.k_ng[lane]);
#pragma unroll
      for (int o = 1; o < 64; o <<= 1) { gq = fmaxf(gq, __shfl_xor(gq, o)); gk = fmaxf(gk, __shfl_xor(gk, o)); }
      qk_bound = 64.f * gq * gk * QSCALE * 1.02f; }
    for (int rep = EXTRA_P10; rep >= 0; --rep)
    for (int it = vcu; it < 256; it += G) {
        const int bh = it >> 1;
        fox::prep(LOGF, bh >> 4, bh & 15, lds, tid, lane, wave);
#pragma unroll 1
        for (int i = 0; i < 4; ++i) { const int s = (i >> 1) ? 3 - (it & 1) : (it & 1), qb = (i & 1) ? 7 - s : s;
            fox::unit(QY, KSH, VSH, OG, qk_bound, bh >> 4, bh & 15, qb, lds, tid, lane, wave, rep > 0 && G < 100000); }
    }
#endif
    GSYNC();
    { pg8::Gemm g{QY, (const bf16_t*)(ws + WS_WFOUT), M, D, D}; pg8::StaticOrder S; S.init(M, D, G, bx); pg8::EpiRes<false, 1, true, true> E{XB, XB2, A1 + 2048, ADA_LD, nullptr, {HN, nullptr}, {a.nlg + D, nullptr}, {A1 + 4096, nullptr}, SSQ2};
      pg8::gemm_phase<pg8::EpiRes<false, 1, true, true>, pg8::StaticOrder, true, true>(lds, g, S, E, tid); }
    GSYNC();
#if defined(STOP_AFTER) && STOP_AFTER == 11
    return;
#endif
    MLP_IN(WS_WM1_1, B2_MLP1);
    { pg8::Gemm g{HID, (const bf16_t*)(ws + WS_WM2_1), M, D, FF}; pg8::StaticOrder S; S.init(M, D, G, bx);
      pg8::EpiRes<false, 0, true, false> E{XB2, a.out, A1 + 5120, ADA_LD, nullptr, {nullptr, nullptr}, {nullptr, nullptr}, {nullptr, nullptr}, nullptr};
      pg8::gemm_phase<pg8::EpiRes<false, 0, true, false>, pg8::StaticOrder, true, true>(lds, g, S, E, tid); }
#undef MLP_IN
}

extern "C" void kernel_launch(void* const* d_in, const int* in_sizes, int n_in, void* d_out, int out_size, void* d_ws, size_t ws_size, hipStream_t stream) {
    static int grid = 0;
    if (grid == 0) {
        if (n_in != 21 || in_sizes[0] != M * D || out_size != M * D || ws_size < WS_END) { fprintf(stderr, "kernel_launch: unexpected shapes (n_in %d, x %d, out %d, ws %zu)\n", n_in, n_in > 0 ? in_sizes[0] : -1, out_size, ws_size); grid = -1; return; }
        int dev = 0, cus = 0, per_cu = 0;
        if (hipGetDevice(&dev) != hipSuccess || hipDeviceGetAttribute(&cus, hipDeviceAttributeMultiprocessorCount, dev) != hipSuccess) { grid = -1; return; }
        if (hipFuncSetAttribute((const void*)yoco_fwd, hipFuncAttributeMaxDynamicSharedMemorySize, LDS_BYTES) != hipSuccess) { fprintf(stderr, "kernel_launch: hipFuncSetAttribute failed\n"); grid = -1; return; }
        if (hipOccupancyMaxActiveBlocksPerMultiprocessor(&per_cu, (const void*)yoco_fwd, 512, LDS_BYTES) != hipSuccess || per_cu < 1) per_cu = 1;
        (void)hipGetLastError();
        grid = cus * per_cu; if (grid > 256) grid = 256;
    }
    if (grid < 0) return;
    Args p{};
    p.x = (const float*)d_in[0]; p.c = (const float*)d_in[1]; p.pos = (const int*)d_in[2];
    p.nmg = (const float*)d_in[3]; p.nlg = (const float*)d_in[4]; p.w_ada = (const float*)d_in[5]; p.b_ada = (const float*)d_in[6];
    p.w_mlp_in = (const float*)d_in[7]; p.w_mlp_out = (const float*)d_in[8]; p.ret_w_in = (const float*)d_in[9]; p.ret_ng = (const float*)d_in[10];
    p.ret_w_out = (const float*)d_in[11]; p.kv_ng = (const float*)d_in[12]; p.kv_w_ada = (const float*)d_in[13]; p.kv_b_ada = (const float*)d_in[14];
    p.kv_w = (const float*)d_in[15]; p.fbias = (const float*)d_in[16]; p.k_ng = (const float*)d_in[17]; p.fox_w_in = (const float*)d_in[18];
    p.q_ng = (const float*)d_in[19]; p.fox_w_out = (const float*)d_in[20];
    p.out = (float*)d_out; p.ws = (unsigned char*)d_ws;
    if (hipMemsetAsync((char*)d_ws + WS_CTL, 0, CTL_ZERO_BYTES, stream) != hipSuccess) { fprintf(stderr, "kernel_launch: memset failed\n"); return; }
    void* args[] = {&p};
    const hipError_t e = hipLaunchCooperativeKernel((const void*)yoco_fwd, dim3(grid), dim3(512), args, LDS_BYTES, stream);
    if (e != hipSuccess) fprintf(stderr, "kernel_launch: cooperative launch failed: %s (grid %d)\n", hipGetErrorString(e), grid);
}
```

```cpp
#include <hip/hip_runtime.h>
#include <hip/hip_cooperative_groups.h>
#include <cstdio>
#include <cstdint>
namespace cg = cooperative_groups;

namespace pg8 {
#define PG8_LAS __attribute__((address_space(3)))
typedef unsigned short bf16_t;
typedef short bf16x8 __attribute__((ext_vector_type(8)));
typedef float f32x4 __attribute__((ext_vector_type(4)));
typedef unsigned u32x4 __attribute__((ext_vector_type(4)));
constexpr int BM = 256, BK = 64, HALF = 128, HTB = HALF * BK * 2  , STAGE_BYTES = 8 * HTB, NXCD = 8, WGM = 8;

__host__ __device__ __forceinline__ int lds_byte(int r, int c) { const int st = (r >> 4) * 2 + (c >> 5), rr = r & 15, cc = c & 31, ob = rr * 64 + cc * 2; return st * 1024 + (ob ^ (((ob >> 9) & 1) << 5)); }
__host__ __device__ __forceinline__ void stage_rc(int b, int& R, int& C) { const int st = b / 1024, sb = b % 1024, swz = sb ^ (((sb >> 9) & 1) << 5); R = (st >> 1) * 16 + swz / 64; C = (st & 1) * 32 + (swz % 64) / 2; }
__host__ __device__ __forceinline__ int perm32(int rho) { const int n = rho >> 4, i = rho & 15; return 8 * (i >> 2) + 4 * n + (i & 3); }

struct Unit { int pm, pn; };
struct Gemm { const bf16_t* A; const bf16_t* Bt; int M, N, K; };

struct StaticOrder {
    int nM, nN, nwg, G, c;
    __host__ __device__ void init(int M, int N, int G_, int c_) { nM = M / BM; nN = N / BM; nwg = nM * nN; G = G_; c = c_; }
    __host__ __device__ bool next(int i, Unit& u) const {
        const long L = (long)i * G + c; if (L >= nwg) return false;
        int wgid = (int)L; { const int q = nwg / NXCD, r = nwg % NXCD, xcd = wgid % NXCD, off = wgid / NXCD; wgid = (xcd < r ? xcd * (q + 1) : r * (q + 1) + (xcd - r) * q) + off; }
        const int nig = WGM * nN, gid = wgid / nig, fm = gid * WGM, gsz = (nM - fm) < WGM ? (nM - fm) : WGM;
        u.pm = fm + ((wgid % nig) % gsz); u.pn = (wgid % nig) / gsz; return true;
    }
    __device__ __forceinline__ void a_ready(const Unit&) const {}
    __device__ __forceinline__ void done(const Unit&) const {}
};

typedef float f32x2 __attribute__((ext_vector_type(2)));
typedef __bf16 bf16x2_t __attribute__((ext_vector_type(2)));
__device__ __forceinline__ unsigned cvt_pk_bf16(float lo, float hi) { const f32x2 v = {lo, hi}; const bf16x2_t b = __builtin_convertvector(v, bf16x2_t); return __builtin_bit_cast(unsigned, b); }
typedef unsigned u32x2 __attribute__((ext_vector_type(2)));
__device__ __forceinline__ u32x4 pack8(f32x4 v0, f32x4 v1) { u32x4 w; w.x = cvt_pk_bf16(v0[0], v0[1]); w.y = cvt_pk_bf16(v0[2], v0[3]); w.z = cvt_pk_bf16(v1[0], v1[1]); w.w = cvt_pk_bf16(v1[2], v1[3]); return w; }
__device__ __forceinline__ float fast_sigmoid(float v) { return __builtin_amdgcn_rcpf(1.f + __expf(-v)); }

struct EpiRetIn {
    static constexpr bool PERM = true, AFTER_DRAIN = false, KHOOK = false;
    bf16_t *Q, *Kr, *V, *G; const float* tab;
    __device__ __forceinline__ void operator()(const f32x4 (&acc)[2][2][4][2], const Unit& u, int wr, int wc, int fr, int fq) const {
        const int row0 = u.pm * BM + wr * 64 + fr, cw = wc * 32 + 8 * fq;
        if (u.pn < 8) {
            const bool isk = u.pn >= 4; bf16_t* base = (isk ? Kr : Q) + (u.pn & 3) * 256 + cw; const float sc = isk ? 0.0625f : 1.f;
#pragma unroll
            for (int ab = 0; ab < 4; ++ab) {
                const int ai = ab >> 1;
                f32x4 tt[2][4];
#pragma unroll
                for (int mm = 0; mm < 2; ++mm) { const f32x4* tp = (const f32x4*)(tab + ((size_t)(row0 + ai * HALF + (2 * (ab & 1) + mm) * 16) * 128 + cw) * 2);
                    tt[mm][0] = tp[0]; tt[mm][1] = tp[1]; tt[mm][2] = tp[2]; tt[mm][3] = tp[3]; }
#pragma unroll
                for (int mm = 0; mm < 2; ++mm) {
                    const int m = 2 * (ab & 1) + mm;
                    const int row = row0 + ai * HALF + m * 16;
                    const f32x4 t0 = tt[mm][0], t1 = tt[mm][1], t2 = tt[mm][2], t3 = tt[mm][3];
                    const f32x4 xa = acc[ai][0][m][0] * sc, xb = acc[ai][0][m][1] * sc, ya = acc[ai][1][m][0] * sc, yb = acc[ai][1][m][1] * sc;
                    f32x4 o1a, o1b, o2a, o2b;
                    o1a[0] = xa[0] * t0[0] - ya[0] * t0[1]; o2a[0] = xa[0] * t0[1] + ya[0] * t0[0];
                    o1a[1] = xa[1] * t0[2] - ya[1] * t0[3]; o2a[1] = xa[1] * t0[3] + ya[1] * t0[2];
                    o1a[2] = xa[2] * t1[0] - ya[2] * t1[1]; o2a[2] = xa[2] * t1[1] + ya[2] * t1[0];
                    o1a[3] = xa[3] * t1[2] - ya[3] * t1[3]; o2a[3] = xa[3] * t1[3] + ya[3] * t1[2];
                    o1b[0] = xb[0] * t2[0] - yb[0] * t2[1]; o2b[0] = xb[0] * t2[1] + yb[0] * t2[0];
                    o1b[1] = xb[1] * t2[2] - yb[1] * t2[3]; o2b[1] = xb[1] * t2[3] + yb[1] * t2[2];
                    o1b[2] = xb[2] * t3[0] - yb[2] * t3[1]; o2b[2] = xb[2] * t3[1] + yb[2] * t3[0];
                    o1b[3] = xb[3] * t3[2] - yb[3] * t3[3]; o2b[3] = xb[3] * t3[3] + yb[3] * t3[2];
                    if (isk) { bf16_t* rp = base + (size_t)row * 1024;
                        *(u32x4*)(rp) = pack8(o1a, o1b); *(u32x4*)(rp + 128) = pack8(o2a, o2b); }
                    else {
                        bf16_t* rp = Q + ((size_t)((row >> 11) * 4 + (u.pn & 3)) * 64 + ((row >> 5) & 63)) * 8192 + (cw >> 4) * 512 + ((cw >> 3) & 1) * 256 + (row & 31) * 8;
                        *(u32x4*)(rp) = pack8(o1a, o1b); *(u32x4*)(rp + 8 * 512) = pack8(o2a, o2b); }
                }
                asm volatile("" ::: "memory");
            }
        } else if (u.pn < 16) {
            const int ct = u.pn - 8, hd = ct >> 1;
            const float lg = log2f(1.f - exp2f(-5.f - (float)hd));
#pragma unroll
            for (int ai = 0; ai < 2; ++ai)
#pragma unroll
                for (int m = 0; m < 4; ++m) {
                    const int row = row0 + ai * HALF + m * 16, tok = row & 127;
                    const float kd = exp2f((float)(127 - tok) * lg);
#pragma unroll
                    for (int bj = 0; bj < 2; ++bj) {
                        const int c0 = ct * 256 + bj * HALF + cw;
                        bf16_t* rp = V + ((((size_t)((row >> 11) * 4 + hd) * 8 + ((c0 >> 6) & 7)) * 16 + ((row >> 7) & 15)) * 8 + ((c0 >> 3) & 7)) * 1024 + tok * 8;
                        *(u32x4*)rp = pack8(acc[ai][bj][m][0] * kd, acc[ai][bj][m][1] * kd);
                    }
                }
        } else {
            const bool isg = true; bf16_t* base = G + (u.pn - 16) * 256 + cw;
#pragma unroll
            for (int ai = 0; ai < 2; ++ai)
#pragma unroll
                for (int m = 0; m < 4; ++m) {
                    bf16_t* rp = base + (size_t)(row0 + ai * HALF + m * 16) * 2048;
#pragma unroll
                    for (int bj = 0; bj < 2; ++bj) {
                        f32x4 v0 = acc[ai][bj][m][0], v1 = acc[ai][bj][m][1];
                        if (isg) {
#pragma unroll
                            for (int j = 0; j < 4; ++j) { v0[j] = v0[j] * fast_sigmoid(v0[j]); v1[j] = v1[j] * fast_sigmoid(v1[j]); }
                        }
                        *(u32x4*)(rp + bj * HALF) = pack8(v0, v1);
                    }
                }
        }
    }
};

template <bool HOOK, int NOUT, bool RIN16, bool ROUT16> struct EpiRes {
    static constexpr bool PERM = true, AFTER_DRAIN = false, KHOOK = HOOK;
    const void* resid; void* out; const float* gate; int gate_ld; const PG8_LAS float* rtab;
    bf16_t* hout[2]; const float* hgain[2]; const float* hscale[2]; float* ssq2;
    __device__ __forceinline__ void khook(f32x4 (&acc)[2][2][4][2], int seg, int wr, int fr) const {
#pragma unroll
        for (int ai = 0; ai < 2; ++ai)
#pragma unroll
            for (int m = 0; m < 4; ++m) {
                const int r = ai * HALF + wr * 64 + m * 16 + fr;
                const float f = rtab[r * 4 + seg] / rtab[r * 4 + seg + 1];
#pragma unroll
                for (int bj = 0; bj < 2; ++bj)
#pragma unroll
                    for (int n = 0; n < 2; ++n) acc[ai][bj][m][n] = acc[ai][bj][m][n] * f;
            }
    }
    __device__ __forceinline__ void operator()(const f32x4 (&acc)[2][2][4][2], const Unit& u, int wr, int wc, int fr, int fq) const {
        const int b = u.pm >> 3, col0 = u.pn * BM + wc * 32 + 8 * fq;
        f32x4 gv[2][2]; f32x4 gs[NOUT > 0 ? NOUT : 1][2][2];
#pragma unroll
        for (int bj = 0; bj < 2; ++bj)
#pragma unroll
            for (int n = 0; n < 2; ++n) { const int c = col0 + bj * HALF + 4 * n;
                gv[bj][n] = *(const f32x4*)(gate + (size_t)b * gate_ld + c);
#pragma unroll
                for (int i = 0; i < NOUT; ++i) gs[i][bj][n] = *(const f32x4*)(hgain[i] + c) * (*(const f32x4*)(hscale[i] + (size_t)b * gate_ld + c) + 1.f); }
#pragma unroll
        for (int ai = 0; ai < 2; ++ai) {
            constexpr int MB = RIN16 ? 2 : 1;
#pragma unroll
            for (int mb = 0; mb < 4; mb += MB) {
                u32x4 raw[MB][2][RIN16 ? 1 : 2];
#pragma unroll
                for (int mm = 0; mm < MB; ++mm) {
                    const size_t off = (size_t)(u.pm * BM + ai * HALF + wr * 64 + (mb + mm) * 16 + fr) * 1024 + col0;
#pragma unroll
                    for (int bj = 0; bj < 2; ++bj) {
                        if (RIN16) raw[mm][bj][0] = *(const u32x4*)((const bf16_t*)resid + off + bj * HALF);
                        else { raw[mm][bj][0] = *(const u32x4*)((const float*)resid + off + bj * HALF); raw[mm][bj][RIN16 ? 0 : 1] = *(const u32x4*)((const float*)resid + off + bj * HALF + 4); }
                    }
                }
#pragma unroll
                for (int mm = 0; mm < MB; ++mm) {
                    const int m = mb + mm;
                    const int rl = ai * HALF + wr * 64 + m * 16 + fr;
                    float rs = 1.f; if (HOOK) rs = rtab[rl * 4 + 3];
                    const size_t off = (size_t)(u.pm * BM + rl) * 1024 + col0;
                    float ss = 0.f;
#pragma unroll
                    for (int bj = 0; bj < 2; ++bj) {
                        f32x4 r[2];
                        if (RIN16) { const u32x4 rw = raw[mm][bj][0];
                            r[0] = (f32x4){__uint_as_float(rw.x << 16), __uint_as_float(rw.x & 0xffff0000u), __uint_as_float(rw.y << 16), __uint_as_float(rw.y & 0xffff0000u)};
                            r[1] = (f32x4){__uint_as_float(rw.z << 16), __uint_as_float(rw.z & 0xffff0000u), __uint_as_float(rw.w << 16), __uint_as_float(rw.w & 0xffff0000u)}; }
                        else { r[0] = __builtin_bit_cast(f32x4, raw[mm][bj][0]); r[1] = __builtin_bit_cast(f32x4, raw[mm][bj][RIN16 ? 0 : 1]); }
                        f32x4 o[2];
#pragma unroll
                        for (int n = 0; n < 2; ++n) {
                            o[n] = r[n] + gv[bj][n] * (acc[ai][bj][m][n] * rs);
                            if (!ROUT16) *(f32x4*)((float*)out + off + bj * HALF + 4 * n) = o[n];
                            if (NOUT > 0) ss += (o[n][0] * o[n][0] + o[n][1] * o[n][1]) + (o[n][2] * o[n][2] + o[n][3] * o[n][3]);
                        }
                        if (ROUT16) *(u32x4*)((bf16_t*)out + off + bj * HALF) = pack8(o[0], o[1]);
#pragma unroll
                        for (int i = 0; i < NOUT; ++i) *(u32x4*)(hout[i] + off + bj * HALF) = pack8(o[0] * gs[i][bj][0], o[1] * gs[i][bj][1]);
                    }
                    if (NOUT > 0) { ss += __shfl_xor(ss, 16); ss += __shfl_xor(ss, 32);
                        if (fq == 0) ssq2[(size_t)(u.pm * BM + rl) * 16 + u.pn * 4 + wc] = ss; }
                }
                asm volatile("" ::: "memory");
            }
        }
    }
};

__device__ __forceinline__ void wave_rstd(const float* ssq2, PG8_LAS float* scr, int pm, int wr, int lane) {
#pragma unroll
    for (int t = 0; t < 2; ++t) { const int e = lane + 64 * t; const size_t row = (size_t)pm * BM + HALF * t + 64 * wr + lane;
        const f32x4* p = (const f32x4*)(ssq2 + row * 16); const f32x4 a = p[0], b = p[1], c = p[2], d = p[3];
        const float s = ((a[0] + a[1]) + (a[2] + a[3])) + ((b[0] + b[1]) + (b[2] + b[3])) + ((c[0] + c[1]) + (c[2] + c[3])) + ((d[0] + d[1]) + (d[2] + d[3]));
        scr[e] = rsqrtf(s * (1.f / 1024.f) + 1e-6f); }
    asm volatile("s_waitcnt lgkmcnt(0)" ::: "memory");
}

struct EpiSqRelu {
    static constexpr bool PERM = true, AFTER_DRAIN = false, KHOOK = false;
    bf16_t* O; const float* ssq2; const float* bias2; PG8_LAS float* scr0;
    __device__ __forceinline__ void operator()(const f32x4 (&acc)[2][2][4][2], const Unit& u, int wr, int wc, int fr, int fq) const {
        const int row0 = u.pm * BM + wr * 64 + fr, col0 = u.pn * BM + wc * 32 + 8 * fq;
        PG8_LAS float* scr = scr0 + (wr * 4 + wc) * 128;
        wave_rstd(ssq2, scr, u.pm, wr, fq * 16 + fr);
        f32x4 bv[2][2];
#pragma unroll
        for (int bj = 0; bj < 2; ++bj)
#pragma unroll
            for (int n = 0; n < 2; ++n) bv[bj][n] = *(const f32x4*)(bias2 + (size_t)(u.pm >> 3) * 4096 + col0 + bj * HALF + 4 * n);
#pragma unroll
        for (int ai = 0; ai < 2; ++ai)
#pragma unroll
            for (int m = 0; m < 4; ++m) {
                bf16_t* rp = O + (size_t)(row0 + ai * HALF + m * 16) * 4096 + col0;
                const float rstd = scr[ai * 64 + m * 16 + fr];
#pragma unroll
                for (int bj = 0; bj < 2; ++bj) {
                    f32x4 v0 = acc[ai][bj][m][0] * rstd + bv[bj][0], v1 = acc[ai][bj][m][1] * rstd + bv[bj][1];
#pragma unroll
                    for (int j = 0; j < 4; ++j) { const float a = fmaxf(v0[j], 0.f), c = fmaxf(v1[j], 0.f); v0[j] = a * a; v1[j] = c * c; }
                    *(u32x4*)(rp + bj * HALF) = pack8(v0, v1);
                }
            }
    }
};

template <int MODE1> struct EpiHeads {
    static constexpr bool PERM = true, AFTER_DRAIN = false, KHOOK = false;
    bf16_t *O0, *O1; const float* gain; float scale0; float* logf; const float* fbias;
    const float* ssq2; const float* bias2; int bias_ld; PG8_LAS float* scr0;
    __device__ __forceinline__ void operator()(const f32x4 (&acc0)[2][2][4][2], const Unit& u, int wr, int wc, int fr, int fq) const {
        const int row0 = u.pm * BM + wr * 64 + fr;
        PG8_LAS float* scr = scr0 + (wr * 4 + wc) * 128;
        wave_rstd(ssq2, scr, u.pm, wr, fq * 16 + fr);
        f32x4 acc[2][2][4][2];
        { f32x4 bv[2][2];
#pragma unroll
          for (int bj = 0; bj < 2; ++bj)
#pragma unroll
              for (int n = 0; n < 2; ++n) bv[bj][n] = *(const f32x4*)(bias2 + (size_t)(u.pm >> 3) * bias_ld + u.pn * BM + bj * HALF + wc * 32 + 8 * fq + 4 * n);
#pragma unroll
          for (int ai = 0; ai < 2; ++ai)
#pragma unroll
              for (int m = 0; m < 4; ++m) { const float rstd = scr[ai * 64 + m * 16 + fr];
#pragma unroll
                  for (int bj = 0; bj < 2; ++bj)
#pragma unroll
                      for (int n = 0; n < 2; ++n) acc[ai][bj][m][n] = acc0[ai][bj][m][n] * rstd + bv[bj][n]; } }
        if (u.pn < 4) {
            f32x4 gk[2][2];
#pragma unroll
            for (int bj = 0; bj < 2; ++bj)
#pragma unroll
                for (int n = 0; n < 2; ++n) gk[bj][n] = *(const f32x4*)(gain + 32 * bj + 8 * fq + 4 * n) * scale0;
#pragma unroll
            for (int ai = 0; ai < 2; ++ai)
#pragma unroll
                for (int m = 0; m < 4; ++m) {
                    float ss = 0.f;
#pragma unroll
                    for (int bj = 0; bj < 2; ++bj)
#pragma unroll
                        for (int n = 0; n < 2; ++n) { const f32x4 x = acc[ai][bj][m][n]; ss += (x[0] * x[0] + x[1] * x[1]) + (x[2] * x[2] + x[3] * x[3]); }
                    ss += __shfl_xor(ss, 16); ss += __shfl_xor(ss, 32);
                    const float rstd = rsqrtf(ss * (1.f / 64.f) + 1e-6f);
                    bf16_t* rp = O0 + (size_t)(row0 + ai * HALF + m * 16) * 1024 + u.pn * 256 + wc * 64 + 8 * fq;
#pragma unroll
                    for (int bj = 0; bj < 2; ++bj) *(u32x4*)(rp + 32 * bj) = pack8(acc[ai][bj][m][0] * rstd * gk[bj][0], acc[ai][bj][m][1] * rstd * gk[bj][1]);
                }
        } else if (u.pn < 8) {
#pragma unroll
            for (int ai = 0; ai < 2; ++ai)
#pragma unroll
                for (int m = 0; m < 4; ++m) {
                    bf16_t* rp = O1 + (size_t)(row0 + ai * HALF + m * 16) * 1024 + (u.pn - 4) * 256 + wc * 64 + 8 * fq;
#pragma unroll
                    for (int bj = 0; bj < 2; ++bj) {
                        f32x4 v0 = acc[ai][bj][m][0], v1 = acc[ai][bj][m][1];
                        if (MODE1 == 1) {
#pragma unroll
                            for (int j = 0; j < 4; ++j) { v0[j] = fast_sigmoid(v0[j]); v1[j] = fast_sigmoid(v1[j]); }
                        }
                        *(u32x4*)(rp + 32 * bj) = pack8(v0, v1);
                    }
                }
        } else {
            if (wc == 0 && fq < 2) {
                const f32x4 b0 = *(const f32x4*)(fbias + 8 * fq), b1 = *(const f32x4*)(fbias + 8 * fq + 4);
#pragma unroll
                for (int ai = 0; ai < 2; ++ai)
#pragma unroll
                    for (int m = 0; m < 4; ++m) {
                        f32x4 z0 = acc[ai][0][m][0] + b0, z1 = acc[ai][0][m][1] + b1;
#pragma unroll
                        for (int j = 0; j < 4; ++j) { z0[j] = fminf(z0[j], 0.f) - log1pf(__expf(-fabsf(z0[j]))); z1[j] = fminf(z1[j], 0.f) - log1pf(__expf(-fabsf(z1[j]))); }
                        float* lp = logf + (size_t)(row0 + ai * HALF + m * 16) * 16 + 8 * fq;
                        *(f32x4*)lp = z0; *(f32x4*)(lp + 4) = z1;
                    }
            }
        }
    }
};

struct OneUnit {
    Unit u;
    __device__ __forceinline__ bool next(int i, Unit& o) const { if (i) return false; o = u; return true; }
    __device__ __forceinline__ void a_ready(const Unit&) const {}
    __device__ __forceinline__ void done(const Unit&) const {}
};
template <class Epi, class Sched, bool ALIGN_EPI = false, bool SP2 = false>
__device__ __forceinline__ void gemm_phase(PG8_LAS unsigned char* lds, const Gemm g, const Sched& S, const Epi& E, const int tid) {
    const int wid = __builtin_amdgcn_readfirstlane(tid >> 6), lane = tid & 63, wr = wid >> 2, wc = wid & 3, fr = lane & 15, fq = lane >> 4;
    const int K = g.K, nt = K / BK;
    unsigned voffA[2], voffB[2];
#pragma unroll
    for (int i = 0; i < 2; ++i) { int R, C; stage_rc(tid * 16 + i * 8192, R, C); const int Rb = Epi::PERM ? ((R & ~31) + perm32(R & 31)) : R;
        voffA[i] = (unsigned)(R * K + C) * 2u; voffB[i] = (unsigned)(Rb * K + C) * 2u; }
    const size_t kstep = (size_t)(BK * 2);
    const size_t hstep = (size_t)HALF * K * 2;
    const size_t tstep = 2 * hstep;
    const unsigned ldsw = (unsigned)wid * 1024u;
    const int aoff = lds_byte(wr * 64 + fr, fq * 8), boff = lds_byte(wc * 32 + fr, fq * 8);
#define PG8_SA(b, h) (((b) * 2 + (h)) * HTB)
#define PG8_SB(b, h) ((4 + (b) * 2 + (h)) * HTB)
#define PG8_STAGE(bufoff, gbase, voff) do { _Pragma("unroll") for (int _i = 0; _i < 2; ++_i) \
        __builtin_amdgcn_global_load_lds((const unsigned*)((const char*)(gbase) + (voff)[_i]), (PG8_LAS unsigned*)(lds + (bufoff) + ldsw + _i * 8192), 16, 0, 0); } while (0)
#define PG8_LDA(dst, b, h) do { _Pragma("unroll") for (int m = 0; m < 4; ++m) _Pragma("unroll") for (int k = 0; k < 2; ++k) dst[m][k] = *(const PG8_LAS bf16x8*)(lds + PG8_SA(b, h) + aoff + m * 2048 + k * 1024); } while (0)
#define PG8_LDB(dst, b, h) do { _Pragma("unroll") for (int n = 0; n < 2; ++n) _Pragma("unroll") for (int k = 0; k < 2; ++k) dst[n][k] = *(const PG8_LAS bf16x8*)(lds + PG8_SB(b, h) + boff + n * 2048 + k * 1024); } while (0)
#define PG8_MMA(ai, bj, At, Bt) do { __builtin_amdgcn_s_setprio(1); _Pragma("unroll") for (int m = 0; m < 4; ++m) _Pragma("unroll") for (int n = 0; n < 2; ++n) _Pragma("unroll") for (int k = 0; k < 2; ++k) \
        acc[ai][bj][m][n] = __builtin_amdgcn_mfma_f32_16x16x32_bf16(Bt[n][k], At[m][k], acc[ai][bj][m][n], 0, 0, 0); __builtin_amdgcn_s_setprio(0); } while (0)
#define PG8_WAIT_V(n) asm volatile("s_waitcnt vmcnt(" #n ")" ::: "memory")
#define PG8_WAIT_L(n) asm volatile("s_waitcnt lgkmcnt(" #n ")" ::: "memory")
#define PG8_BAR __builtin_amdgcn_s_barrier()
#define PG8_SCHED __builtin_amdgcn_sched_barrier(0)
    Unit cur, nxt; int ui = 0;
    if (!S.next(0, cur)) return;
    f32x4 acc[2][2][4][2];
#pragma unroll
    for (int a = 0; a < 2; ++a)
#pragma unroll
        for (int b = 0; b < 2; ++b)
#pragma unroll
            for (int m = 0; m < 4; ++m)
#pragma unroll
                for (int n = 0; n < 2; ++n) acc[a][b][m][n] = (f32x4){0.f, 0.f, 0.f, 0.f};
    bf16x8 At[4][2], B0[2][2], B1[2][2];
    const char* cA = (const char*)g.A + (size_t)cur.pm * tstep; const char* cB = (const char*)g.Bt + (size_t)cur.pn * tstep;
    S.a_ready(cur);
    if constexpr (SP2) {
        PG8_STAGE(PG8_SB(0, 0), cB, voffB); PG8_STAGE(PG8_SB(0, 1), cB + hstep, voffB); PG8_STAGE(PG8_SA(0, 0), cA, voffA); PG8_STAGE(PG8_SA(0, 1), cA + hstep, voffA);
        if (wr == 1) PG8_BAR;
        PG8_WAIT_V(2); PG8_BAR;
        PG8_STAGE(PG8_SB(1, 0), cB + kstep, voffB); PG8_STAGE(PG8_SA(1, 0), cA + kstep, voffA); PG8_STAGE(PG8_SB(1, 1), cB + hstep + kstep, voffB);
        PG8_WAIT_V(6); PG8_BAR;
    } else {
        PG8_STAGE(PG8_SB(0, 0), cB, voffB); PG8_STAGE(PG8_SA(0, 0), cA, voffA); PG8_STAGE(PG8_SB(0, 1), cB + hstep, voffB); PG8_STAGE(PG8_SA(0, 1), cA + hstep, voffA);
        if (wr == 1) PG8_BAR;
        PG8_WAIT_V(4); PG8_BAR;
        PG8_STAGE(PG8_SB(1, 0), cB + kstep, voffB); PG8_STAGE(PG8_SA(1, 0), cA + kstep, voffA); PG8_STAGE(PG8_SB(1, 1), cB + hstep + kstep, voffB);
        PG8_WAIT_V(6); PG8_BAR;
    }
    for (;;) {
        const bool has_next = S.next(ui + 1, nxt);
        const char* nA = has_next ? (const char*)g.A + (size_t)nxt.pm * tstep : cA; const char* nB = has_next ? (const char*)g.Bt + (size_t)nxt.pn * tstep : cB;
        for (int t = 0; t < nt; t += 2) {
            const bool last = (t == nt - 2);
            const char* a1 = cA + (size_t)(t + 1) * kstep;
            const char* a2 = last ? nA : cA + (size_t)(t + 2) * kstep; const char* b2 = last ? nB : cB + (size_t)(t + 2) * kstep;
            const char* a3 = a2 + kstep; const char* b3 = b2 + kstep;
            if (last && has_next) S.a_ready(nxt);
            if constexpr (SP2) {
            PG8_LDB(B0, 0, 0); PG8_LDB(B1, 0, 1); PG8_SCHED; PG8_LDA(At, 0, 0); PG8_STAGE(PG8_SA(1, 1), a1 + hstep, voffA);
            PG8_WAIT_V(8); PG8_WAIT_L(0); PG8_BAR; PG8_MMA(0, 0, At, B0); PG8_MMA(0, 1, At, B1); PG8_BAR; PG8_SCHED;
            PG8_LDA(At, 0, 1); PG8_STAGE(PG8_SB(0, 0), b2, voffB); PG8_STAGE(PG8_SB(0, 1), b2 + hstep, voffB); PG8_STAGE(PG8_SA(0, 0), a2, voffA);
            PG8_WAIT_V(8); PG8_WAIT_L(0); PG8_BAR; PG8_MMA(1, 0, At, B0); PG8_MMA(1, 1, At, B1); PG8_BAR; PG8_SCHED;
            PG8_LDB(B0, 1, 0); PG8_LDB(B1, 1, 1); PG8_SCHED; PG8_LDA(At, 1, 0); PG8_STAGE(PG8_SA(0, 1), a2 + hstep, voffA);
            PG8_WAIT_V(8); PG8_WAIT_L(0); PG8_BAR; PG8_MMA(0, 0, At, B0); PG8_MMA(0, 1, At, B1); PG8_BAR; PG8_SCHED;
            PG8_LDA(At, 1, 1); PG8_STAGE(PG8_SB(1, 0), b3, voffB); PG8_STAGE(PG8_SB(1, 1), b3 + hstep, voffB); PG8_STAGE(PG8_SA(1, 0), a3, voffA);
            PG8_WAIT_V(8); PG8_WAIT_L(0); PG8_BAR; PG8_MMA(1, 0, At, B0); PG8_MMA(1, 1, At, B1); PG8_BAR; PG8_SCHED;
            if constexpr (Epi::KHOOK) { if ((((t + 2) & 7) == 0) && (t + 2 < nt)) E.khook(acc, ((t + 2) >> 3) - 1, wr, fr); }
            } else {
            PG8_LDB(B0, 0, 0); PG8_SCHED; PG8_LDA(At, 0, 0); PG8_STAGE(PG8_SA(1, 1), a1 + hstep, voffA);
            PG8_WAIT_L(8); PG8_BAR; PG8_WAIT_L(0); PG8_MMA(0, 0, At, B0); PG8_BAR; PG8_SCHED;
            PG8_LDB(B1, 0, 1); PG8_STAGE(PG8_SB(0, 0), b2, voffB);
            PG8_BAR; PG8_WAIT_L(0); PG8_MMA(0, 1, At, B1); PG8_BAR;
            PG8_LDA(At, 0, 1); PG8_STAGE(PG8_SA(0, 0), a2, voffA);
            PG8_BAR; PG8_WAIT_L(0); PG8_MMA(1, 0, At, B0); PG8_BAR; PG8_SCHED;
            PG8_STAGE(PG8_SB(0, 1), b2 + hstep, voffB);
            PG8_WAIT_V(6); PG8_BAR; PG8_MMA(1, 1, At, B1); PG8_BAR;
            PG8_LDB(B0, 1, 0); PG8_SCHED; PG8_LDA(At, 1, 0); PG8_STAGE(PG8_SA(0, 1), a2 + hstep, voffA);
            PG8_WAIT_L(8); PG8_BAR; PG8_WAIT_L(0); PG8_MMA(0, 0, At, B0); PG8_BAR; PG8_SCHED;
            PG8_LDB(B1, 1, 1); PG8_STAGE(PG8_SB(1, 0), b3, voffB);
            PG8_BAR; PG8_WAIT_L(0); PG8_MMA(0, 1, At, B1); PG8_BAR;
            PG8_LDA(At, 1, 1); PG8_STAGE(PG8_SA(1, 0), a3, voffA);
            PG8_BAR; PG8_WAIT_L(0); PG8_MMA(1, 0, At, B0); PG8_BAR; PG8_SCHED;
            PG8_STAGE(PG8_SB(1, 1), b3 + hstep, voffB);
            PG8_WAIT_V(6); PG8_BAR; PG8_MMA(1, 1, At, B1); PG8_BAR;
            }
        }
        if constexpr (ALIGN_EPI) { if (wr == 0) PG8_BAR; }
        if constexpr (!Epi::AFTER_DRAIN) { E(acc, cur, wr, wc, fr, fq); S.done(cur); }
        if (!has_next) break;
#pragma unroll
        for (int a = 0; a < 2; ++a)
#pragma unroll
            for (int b = 0; b < 2; ++b)
#pragma unroll
                for (int m = 0; m < 4; ++m)
#pragma unroll
                    for (int n = 0; n < 2; ++n) acc[a][b][m][n] = (f32x4){0.f, 0.f, 0.f, 0.f};
        cur = nxt; cA = nA; cB = nB; ++ui;
        if constexpr (ALIGN_EPI) { if (wr == 1) PG8_BAR; }
    }
    PG8_WAIT_V(0);
    if constexpr (!ALIGN_EPI) { if (wr == 0) PG8_BAR; }
    PG8_BAR;
    if constexpr (Epi::AFTER_DRAIN) { E.fused(acc, cur, wr, wc, fr, fq, lds, wid, lane); S.done(cur); }
#undef PG8_SA
#undef PG8_SB
#undef PG8_STAGE
#undef PG8_LDA
#undef PG8_LDB
#undef PG8_MMA
#undef PG8_WAIT_V
#undef PG8_WAIT_L
#undef PG8_BAR
#undef PG8_SCHED
}
}

using pg8::bf16_t; using pg8::bf16x8; using pg8::f32x4; using pg8::u32x4; using pg8::u32x2; using pg8::cvt_pk_bf16;
#define LAS __attribute__((address_space(3)))
typedef float f32x16 __attribute__((ext_vector_type(16)));
typedef short s16x4 __attribute__((ext_vector_type(4)));

constexpr int BATCH = 8, SEQ = 2048, D = 1024, M = BATCH * SEQ, FF = 4096;
constexpr int RH = 4, RDK = 256, RDV = 512, RVW = RH * RDV, RIN = 6144, RC = 128, NCH = SEQ / RC;
constexpr int FH = 16, FD = 64;
constexpr int ADA_LD = 14336;
constexpr float EPS = 1e-6f;
constexpr float LOG2E = 1.4426950408889634f;
constexpr float QSCALE = 0.125f * LOG2E;

constexpr size_t MiB = 1u << 20;
constexpr size_t WS_ADA = 1 * MiB, WS_LOGF = 2 * MiB, WS_SSQ = 4 * MiB;
constexpr size_t WS_SSQ2 = 3 * MiB;
constexpr size_t WS_BIAS2 = 1 * MiB + 512 * 1024;
constexpr size_t B2_MLP0 = 0, B2_MLP1 = 8 * 4096, B2_KV = 16 * 4096, B2_FOX = 16 * 4096 + 8 * 2304;
constexpr size_t WS_WRIN = 8 * MiB, WS_WROUT = 20 * MiB, WS_WM1_0 = 24 * MiB;
constexpr size_t WS_TAB = 32 * MiB;
constexpr size_t WS_HKV = 8 * MiB;
constexpr size_t WS_WM2_0 = 48 * MiB, WS_WM1_1 = 56 * MiB, WS_WM2_1 = 64 * MiB, WS_WKV = 72 * MiB, WS_WFIN = 77 * MiB, WS_WFOUT = 81 * MiB;
constexpr size_t WS_HN = 83 * MiB;
constexpr size_t WS_BIG = 115 * MiB;
constexpr size_t WS_END = 243 * MiB;

constexpr int LDS_BYTES = 155648;
constexpr int RING_BYTES = 131072;
constexpr int RTAB_OFF = 132096;
constexpr int WSCR_OFF = 136192;
constexpr int XBST_OFF = LDS_BYTES - 64;
constexpr size_t WS_CTL = 0, CTL_ZERO_BYTES = 16384;

__device__ __forceinline__ float bf2f(unsigned b) { return __uint_as_float(b << 16); }
__device__ __forceinline__ unsigned f2bf(float f) { unsigned u = __float_as_uint(f); return (u + 0x7fffu + ((u >> 16) & 1u)) >> 16; }
__device__ __forceinline__ unsigned pk2(float lo, float hi) { return f2bf(lo) | (f2bf(hi) << 16); }
__device__ __forceinline__ float wave_sum(float v) {
#pragma unroll
    for (int o = 1; o < 64; o <<= 1) v += __shfl_xor(v, o);
    return v;
}
#define LDS_WAIT() asm volatile("s_waitcnt lgkmcnt(0)" ::: "memory")

struct Args {
    const float* x; const float* c; const int* pos;
    const float *nmg, *nlg, *w_ada, *b_ada, *w_mlp_in, *w_mlp_out, *ret_w_in, *ret_ng, *ret_w_out, *kv_ng, *kv_w_ada, *kv_b_ada, *kv_w, *fbias, *k_ng, *fox_w_in, *q_ng, *fox_w_out;
    float* out; unsigned char* ws;
};

__device__ __forceinline__ int perm_row(int n) { return (n & ~255) + 128 * ((n >> 5) & 1) + 32 * ((n >> 6) & 3) + (n & 31); }
struct TDesc { const float* W; int ldw, K, nblk; bf16_t* WT; int permute, r; };
__device__ __forceinline__ void transpose_load(const TDesc& d, f32x4 (&wv)[16], int lane) {
    const int kb = d.r / d.nblk, nb = d.r % d.nblk;
    const float* wp = d.W + (size_t)(64 * kb + (lane >> 4)) * d.ldw + 64 * nb + 4 * (lane & 15);
#pragma unroll
    for (int i = 0; i < 16; ++i) wv[i] = __builtin_nontemporal_load((const f32x4*)(wp + (size_t)(4 * i) * d.ldw));
}
__device__ __forceinline__ void transpose_to_lds(const f32x4 (&wv)[16], LAS float* scr, int lane) {
#pragma unroll
    for (int i = 0; i < 16; ++i) { LAS float* sp = scr + (4 * i + (lane >> 4)) * 65 + 4 * (lane & 15); sp[0] = wv[i][0]; sp[1] = wv[i][1]; sp[2] = wv[i][2]; sp[3] = wv[i][3]; }
    LDS_WAIT(); asm volatile("" ::: "memory");
}
__device__ __forceinline__ void transpose_store(const TDesc& d, LAS float* scr, int lane) {
    const int kb = d.r / d.nblk, nb = d.r % d.nblk, k0 = 64 * kb, n0 = 64 * nb;
    const int c = lane & 7;
#pragma unroll
    for (int j = 0; j < 8; ++j) { const int n = (lane >> 3) + 8 * j; const LAS float* s = scr + (8 * c) * 65 + n;
        u32x4 o; o.x = pk2(s[0 * 65], s[1 * 65]); o.y = pk2(s[2 * 65], s[3 * 65]); o.z = pk2(s[4 * 65], s[5 * 65]); o.w = pk2(s[6 * 65], s[7 * 65]);
        const int r = d.permute ? perm_row(n0 + n) : n0 + n;
        *(u32x4*)(d.WT + (size_t)r * d.K + k0 + 8 * c) = o; }
    LDS_WAIT(); asm volatile("" ::: "memory");
}

__device__ __forceinline__ void phase0(const Args& a, LAS unsigned char* lds, int tid, int lane, int wave) {
    unsigned char* ws = a.ws;
    const int G = gridDim.x, bx = blockIdx.x;
    LAS float* cact = (LAS float*)lds;
    LAS float* red = (LAS float*)(lds + 32768);
    float* ADA = (float*)(ws + WS_ADA);
    for (int it = bx; it < ADA_LD / 64; it += G) {
        __syncthreads();
        for (int i = tid; i < BATCH * D; i += 512) { const int b = i >> 10, k = i & 1023; const float v = a.c[i]; cact[k * 8 + b] = v * pg8::fast_sigmoid(v); }
        __syncthreads();
        const int n0 = it * 64;
        const float* W; const float* bias; int ldw, nn;
        if (n0 < 6144) { W = a.w_ada; bias = a.b_ada; ldw = 6144; nn = n0; }
        else if (n0 < 12288) { W = a.w_ada + (size_t)D * 6144; bias = a.b_ada + 6144; ldw = 6144; nn = n0 - 6144; }
        else { W = a.kv_w_ada; bias = a.kv_b_ada; ldw = 2048; nn = n0 - 12288; }
        float acc[8];
#pragma unroll
        for (int b = 0; b < 8; ++b) acc[b] = 0.f;
        const float* wp = W + (size_t)(wave * 128) * ldw + nn + lane;
        for (int kb = 0; kb < 128; kb += 16) {
            float wv[16];
#pragma unroll
            for (int i = 0; i < 16; ++i) wv[i] = __builtin_nontemporal_load(wp + (size_t)(kb + i) * ldw);
            __builtin_amdgcn_sched_barrier(0);
#pragma unroll
            for (int i = 0; i < 16; ++i) {
                const float w = wv[i];
                const f32x4 c0 = *(const LAS f32x4*)(cact + (wave * 128 + kb + i) * 8), c1 = *(const LAS f32x4*)(cact + (wave * 128 + kb + i) * 8 + 4);
                acc[0] += c0[0] * w; acc[1] += c0[1] * w; acc[2] += c0[2] * w; acc[3] += c0[3] * w;
                acc[4] += c1[0] * w; acc[5] += c1[1] * w; acc[6] += c1[2] * w; acc[7] += c1[3] * w;
            }
            __builtin_amdgcn_sched_barrier(0);
        }
#pragma unroll
        for (int b = 0; b < 8; ++b) red[(wave * 8 + b) * 64 + lane] = acc[b];
        __syncthreads();
        { const int b = tid >> 6; float s = bias[nn + lane];
#pragma unroll
          for (int w = 0; w < 8; ++w) s += red[(w * 8 + b) * 64 + lane];
          ADA[(size_t)b * ADA_LD + n0 + lane] = s; }
    }
    __syncthreads();
    {
        LAS float* scr = (LAS float*)(lds + wave * 16640);
        const int gw = bx * 8 + wave, NGW = G * 8;
        constexpr int I0 = 16 * 96, I1 = 32 * 16, I2 = 16 * 64, I3 = 64 * 16, I4 = 16 * 32, I5 = 16 * 32, I6 = 16 * 16;
        constexpr int NITEMS = I0 + I1 + 2 * I2 + 2 * I3 + I4 + I5 + I6;
        auto desc = [&](int it) -> TDesc {
            int r = it;
            if (r < I0) return TDesc{a.ret_w_in, RIN, D, 96, (bf16_t*)(ws + WS_WRIN), 0, r}; r -= I0;
            if (r < I1) return TDesc{a.ret_w_out, D, RVW, 16, (bf16_t*)(ws + WS_WROUT), 0, r}; r -= I1;
            if (r < I2) return TDesc{a.w_mlp_in, FF, D, 64, (bf16_t*)(ws + WS_WM1_0), 0, r}; r -= I2;
            if (r < I2) return TDesc{a.w_mlp_in + (size_t)D * FF, FF, D, 64, (bf16_t*)(ws + WS_WM1_1), 0, r}; r -= I2;
            if (r < I3) return TDesc{a.w_mlp_out, D, FF, 16, (bf16_t*)(ws + WS_WM2_0), 0, r}; r -= I3;
            if (r < I3) return TDesc{a.w_mlp_out + (size_t)FF * D, D, FF, 16, (bf16_t*)(ws + WS_WM2_1), 0, r}; r -= I3;
            if (r < I4) return TDesc{a.kv_w, 2 * D + FH, D, 32, (bf16_t*)(ws + WS_WKV), 1, r}; r -= I4;
            if (r < I5) return TDesc{a.fox_w_in, 2 * D, D, 32, (bf16_t*)(ws + WS_WFIN), 1, r}; r -= I5;
            return TDesc{a.fox_w_out, D, D, 16, (bf16_t*)(ws + WS_WFOUT), 0, r};
        };
        f32x4 wv[16];
        int it = gw;
        TDesc cur{}; if (it < NITEMS) { cur = desc(it); transpose_load(cur, wv, lane); }
        while (it < NITEMS) {
            transpose_to_lds(wv, scr, lane);
            const int nx = it + NGW; TDesc nd{};
            if (nx < NITEMS) { nd = desc(nx); transpose_load(nd, wv, lane); }
            transpose_store(cur, scr, lane);
            cur = nd; it = nx;
        }
    }
    const int gt = bx * 512 + tid, NT = G * 512;
    {
        bf16_t* wkv = (bf16_t*)(ws + WS_WKV) + (size_t)2048 * D;
        for (int i = gt; i < 256 * (D / 8); i += NT) {
            const int row = i >> 7, c8 = i & 127; u32x4 o = (u32x4){0u, 0u, 0u, 0u};
            if (row < FH) { float v[8];
#pragma unroll
                for (int e = 0; e < 8; ++e) v[e] = a.kv_w[(size_t)(8 * c8 + e) * (2 * D + FH) + 2 * D + row];
                o.x = pk2(v[0], v[1]); o.y = pk2(v[2], v[3]); o.z = pk2(v[4], v[5]); o.w = pk2(v[6], v[7]); }
            *(u32x4*)(wkv + (size_t)row * D + 8 * c8) = o;
        }
    }
    {
        float* tab = (float*)(ws + WS_TAB);
        const int i = gt & 127;
        double invf = 1.0; { const double r = 0.93057204092969897;
            for (int k = 0; k < i; ++k) invf *= r; }
        for (int idx0 = gt; idx0 < M * 128; idx0 += 16 * NT) {
            int pv[16];
#pragma unroll
            for (int k = 0; k < 16; ++k) { const int idx = idx0 + k * NT; pv[k] = (idx < M * 128) ? a.pos[idx >> 7] : 0; }
#pragma unroll
            for (int k = 0; k < 16; ++k) { const int idx = idx0 + k * NT;
                if (idx < M * 128) {
                    double rev = (double)pv[k] * invf * 0.15915494309189535; rev -= floor(rev);
                    const float rf = (float)rev;
                    *(pg8::f32x2*)(tab + (size_t)idx * 2) = (pg8::f32x2){__builtin_amdgcn_cosf(rf), __builtin_amdgcn_sinf(rf)}; } }
        }
    }
}

__device__ __forceinline__ void norm_rows(const float* xs, const float* gain, const float* shift, const float* scale, bf16_t* out, int lane, int wave) {
    const int gw = blockIdx.x * 8 + wave, NGW = gridDim.x * 8;
    const int per = (M + NGW - 1) / NGW, r0 = gw * per, r1 = (r0 + per < M) ? r0 + per : M;
    if (r0 >= r1) return;
    f32x4 gs[4], sh[4]; int bcur = -1;
    f32x4 vn[4];
    { const f32x4* xr = (const f32x4*)(xs + (size_t)r0 * D) + lane;
#pragma unroll
      for (int j = 0; j < 4; ++j) vn[j] = xr[64 * j]; }
    for (int row = r0; row < r1; ++row) {
        f32x4 v[4];
#pragma unroll
        for (int j = 0; j < 4; ++j) v[j] = vn[j];
        if (row + 1 < r1) { const f32x4* xr = (const f32x4*)(xs + (size_t)(row + 1) * D) + lane;
#pragma unroll
            for (int j = 0; j < 4; ++j) vn[j] = xr[64 * j]; }
        const int b = row >> 11;
        if (b != bcur) { bcur = b;
#pragma unroll
            for (int j = 0; j < 4; ++j) { const int col = 4 * lane + 256 * j;
                gs[j] = *(const f32x4*)(gain + col) * (*(const f32x4*)(scale + (size_t)b * ADA_LD + col) + 1.f); sh[j] = *(const f32x4*)(shift + (size_t)b * ADA_LD + col); } }
        float ss = 0.f;
#pragma unroll
        for (int j = 0; j < 4; ++j) ss += (v[j][0] * v[j][0] + v[j][1] * v[j][1]) + (v[j][2] * v[j][2] + v[j][3] * v[j][3]);
        const float rstd = rsqrtf(wave_sum(ss) * (1.f / D) + EPS);
#pragma unroll
        for (int j = 0; j < 4; ++j) {
            const f32x4 o = v[j] * rstd * gs[j] + sh[j];
            u32x2 w; w.x = cvt_pk_bf16(o[0], o[1]); w.y = cvt_pk_bf16(o[2], o[3]);
            *(u32x2*)(out + (size_t)row * D + 4 * lane + 256 * j) = w;
        }
    }
}

__device__ __forceinline__ void bias2_rows(const bf16_t* Wt, int nrows, const float* shift  , float* out, int out_ld, int lane, int wave) {
    const int gw = blockIdx.x * 8 + wave, NGW = gridDim.x * 8;
    if (gw >= nrows) return;
    float sh[8][16];
#pragma unroll
    for (int b = 0; b < 8; ++b)
#pragma unroll
        for (int q = 0; q < 4; ++q) { const f32x4 v = *(const f32x4*)(shift + (size_t)b * ADA_LD + 16 * lane + 4 * q); sh[b][4 * q] = v[0]; sh[b][4 * q + 1] = v[1]; sh[b][4 * q + 2] = v[2]; sh[b][4 * q + 3] = v[3]; }
    u32x4 n0 = *(const u32x4*)(Wt + (size_t)gw * D + 16 * lane), n1 = *(const u32x4*)(Wt + (size_t)gw * D + 16 * lane + 8);
    for (int r = gw; r < nrows; r += NGW) {
        const u32x4 w0 = n0, w1 = n1;
        if (r + NGW < nrows) { n0 = *(const u32x4*)(Wt + (size_t)(r + NGW) * D + 16 * lane); n1 = *(const u32x4*)(Wt + (size_t)(r + NGW) * D + 16 * lane + 8); }
        const unsigned ww[8] = {w0.x, w0.y, w0.z, w0.w, w1.x, w1.y, w1.z, w1.w};
        float wf[16];
#pragma unroll
        for (int i = 0; i < 8; ++i) { wf[2 * i] = bf2f(ww[i] & 0xffffu); wf[2 * i + 1] = bf2f(ww[i] >> 16); }
        float res = 0.f;
#pragma unroll
        for (int b = 0; b < 8; ++b) { float s = 0.f;
#pragma unroll
            for (int i = 0; i < 16; ++i) s += sh[b][i] * wf[i];
            s = wave_sum(s); if (lane == b) res = s; }
        if (lane < 8) out[(size_t)lane * out_ld + r] = res;
    }
}

__device__ __forceinline__ void logf_rows(const bf16_t* HKV, const bf16_t* Wf, const float* ssq2, const float* bias, int bias_ld, const float* fbias, float* logf, LAS unsigned char* lds, int tid, int lane, int w) {
    const int r32 = lane & 31, hh = lane >> 5;
    LAS float* part = (LAS float*)lds;
    for (int rt = blockIdx.x; rt < M / 64; rt += gridDim.x) {
        const size_t row0 = (size_t)rt * 64;
        f32x16 acc[2];
#pragma unroll
        for (int i = 0; i < 16; ++i) { acc[0][i] = 0.f; acc[1][i] = 0.f; }
        const bf16_t* ap = HKV + (row0 + r32) * 1024 + 128 * w + 8 * hh;
        const bf16_t* bp = Wf + (size_t)r32 * 1024 + 128 * w + 8 * hh;
#pragma unroll
        for (int ks = 0; ks < 8; ++ks) { const bf16x8 bf = *(const bf16x8*)(bp + 16 * ks);
#pragma unroll
            for (int rb = 0; rb < 2; ++rb) { const bf16x8 af = *(const bf16x8*)(ap + (size_t)rb * 32 * 1024 + 16 * ks); acc[rb] = __builtin_amdgcn_mfma_f32_32x32x16_bf16(af, bf, acc[rb], 0, 0, 0); } }
        __syncthreads();
        if (r32 < 16) {
#pragma unroll
            for (int rb = 0; rb < 2; ++rb)
#pragma unroll
                for (int i = 0; i < 16; ++i) part[(w * 64 + 32 * rb + (i & 3) + 8 * (i >> 2) + 4 * hh) * 16 + r32] = acc[rb][i];
        }
        __syncthreads();
        for (int o = tid; o < 1024; o += 512) {
            const int row = o >> 4, hd = o & 15;
            float s = 0.f;
#pragma unroll
            for (int ww = 0; ww < 8; ++ww) s += part[(ww * 64 + row) * 16 + hd];
            const f32x4* sp = (const f32x4*)(ssq2 + (row0 + row) * 16); const f32x4 a = sp[0], b = sp[1], c = sp[2], d = sp[3];
            const float q = ((a[0] + a[1]) + (a[2] + a[3])) + ((b[0] + b[1]) + (b[2] + b[3])) + ((c[0] + c[1]) + (c[2] + c[3])) + ((d[0] + d[1]) + (d[2] + d[3]));
            const float z = s * rsqrtf(q * (1.f / 1024.f) + EPS) + bias[(row0 >> 11) * bias_ld + hd] + fbias[hd];
            logf[(row0 + row) * 16 + hd] = fminf(z, 0.f) - log1pf(__expf(-fabsf(z)));
        }
    }
    __syncthreads();
}

#ifndef RET_PREF_K
#define RET_PREF_K 1
#endif
namespace ret {
constexpr int KP = 528, VP = 272, PP = 272, RP = 528;
constexpr int L_KC = 0, L_VT = 128 * KP, L_PS = L_VT + 64 * VP, L_RB = L_PS + 128 * PP, L_DEC = L_RB + 64 * RP, L_END = L_DEC + 1024;
static_assert(L_END <= XBST_OFF, "retention LDS");
__device__ __forceinline__ s16x4 tr_read(const LAS unsigned char* p) { return __builtin_bit_cast(s16x4, __builtin_amdgcn_ds_read_tr16_b64_v4i16((LAS s16x4*)p)); }

template <int CTRL, int RMASK> __device__ __forceinline__ float dpp_add(float v) { return v + __int_as_float(__builtin_amdgcn_update_dpp(0, __float_as_int(v), CTRL, RMASK, 0xf, true)); }
__device__ __forceinline__ float half_sum_hi(float v) { v = dpp_add<0x111, 0xf>(v); v = dpp_add<0x112, 0xf>(v); v = dpp_add<0x114, 0xf>(v); v = dpp_add<0x118, 0xf>(v); return dpp_add<0x142, 0xa>(v); }

__device__ __forceinline__ void unit(const bf16_t* Q, const bf16_t* Kr, const bf16_t* V, bf16_t* G, float* SSQ, const float* rgain, int b, int h, int vs, LAS unsigned char* lds, int tid, int lane, int w, bool dry = false) {
    const int r32 = lane & 31, hh = lane >> 5, rb = w & 3, cx = w >> 2;
    const float gam = 1.f - exp2f(-5.f - (float)h), lg = log2f(gam), gC = exp2f(128.f * lg);
    LAS float* kd = (LAS float*)(lds + L_DEC);
    LAS float* rs1 = (LAS float*)(lds + L_DEC + 512);
    __syncthreads();
    if (tid < 128) { kd[tid] = exp2f((float)(127 - tid) * lg); rs1[tid] = exp2f((float)(tid - 127) * lg); }
    f32x16 racc[2];
#pragma unroll
    for (int i = 0; i < 16; ++i) { racc[0][i] = 0.f; racc[1][i] = 0.f; }
    const int col = h * RDV + vs * 64 + cx * 32 + r32;
    const float gn = rgain[col];
    const int trrow = 8 * (lane >> 5) + ((lane & 15) >> 2), trcol = 16 * ((lane >> 4) & 1) + 4 * (lane & 3);
    const size_t row0 = (size_t)b * SEQ;
    const bf16_t* kg = Kr + (row0 + (tid >> 5)) * 1024 + h * RDK + 8 * (tid & 31);
    const bf16_t* vg = V + ((size_t)((b * 4 + h) * 8 + vs) * 16) * 8192 + (size_t)(tid >> 7) * 1024 + (tid & 127) * 8;
    const bf16_t* qg = Q + ((size_t)(b * 4 + h) * 64 + rb) * 8192 + hh * 256 + r32 * 8;
    u32x4 kreg[8], vreg[2]; bf16x8 qf[16];
#pragma unroll
    for (int i = 0; i < 8; ++i) kreg[i] = *(const u32x4*)(kg + (size_t)(16 * i) * 1024);
#pragma unroll
    for (int i = 0; i < 2; ++i) vreg[i] = *(const u32x4*)(vg + (size_t)(4 * i) * 1024);
#pragma unroll
    for (int ks = 0; ks < 16; ++ks) qf[ks] = *(const bf16x8*)(qg + 512 * ks);
    for (int ch = 0; ch < NCH; ++ch) {
        const size_t rowbase = row0 + (size_t)ch * RC;
        const bool more = ch + 1 < NCH;
        __syncthreads();
#if !RET_PREF_K
        if (ch > 0) {
#pragma unroll
            for (int i = 0; i < 8; ++i) kreg[i] = *(const u32x4*)(kg + (size_t)(ch * RC + 16 * i) * 1024);
#pragma unroll
            for (int i = 0; i < 2; ++i) vreg[i] = *(const u32x4*)(vg + (size_t)(ch * RC + 64 * i) * RVW);
        }
#endif
#pragma unroll
        for (int i = 0; i < 8; ++i) *(LAS u32x4*)(lds + L_KC + ((tid >> 5) + 16 * i) * KP + 16 * (tid & 31)) = kreg[i];
#pragma unroll
        for (int i = 0; i < 2; ++i) { const int tok = tid & 127, c8 = (tid >> 7) + 4 * i;
            const unsigned wv[4] = {vreg[i].x, vreg[i].y, vreg[i].z, vreg[i].w};
#pragma unroll
            for (int e = 0; e < 4; ++e) {
                *(LAS unsigned short*)(lds + L_VT + (8 * c8 + 2 * e) * VP + tok * 2) = (unsigned short)(wv[e] & 0xffffu);
                *(LAS unsigned short*)(lds + L_VT + (8 * c8 + 2 * e + 1) * VP + tok * 2) = (unsigned short)(wv[e] >> 16);
            } }
#pragma unroll
        for (int vt = 0; vt < 2; ++vt) {
#pragma unroll
            for (int i = 0; i < 16; ++i) racc[vt][i] *= gC;
#pragma unroll
            for (int g = 0; g < 4; ++g) { u32x2 o; o.x = cvt_pk_bf16(racc[vt][4 * g], racc[vt][4 * g + 1]); o.y = cvt_pk_bf16(racc[vt][4 * g + 2], racc[vt][4 * g + 3]);
                *(LAS u32x2*)(lds + L_RB + (32 * vt + r32) * RP + (32 * w + 8 * g + 4 * hh) * 2) = o; }
        }
#if RET_PREF_K
        if (more) {
#pragma unroll
            for (int i = 0; i < 8; ++i) kreg[i] = *(const u32x4*)(kg + (size_t)((ch + 1) * RC + 16 * i) * 1024);
#pragma unroll
            for (int i = 0; i < 2; ++i) vreg[i] = *(const u32x4*)(vg + (size_t)(ch + 1) * 8192 + (size_t)(4 * i) * 1024);
        }
#endif
        __syncthreads();
        __builtin_amdgcn_sched_barrier(0);
#pragma unroll
        for (int t = 0; t < 2; ++t) {
            const int cb = 2 * cx + t;
            if (cb <= rb) {
                f32x16 s;
#pragma unroll
                for (int i = 0; i < 16; ++i) s[i] = 0.f;
                const LAS unsigned char* kp = lds + L_KC + (32 * cb + r32) * KP + 16 * hh;
#pragma unroll
                for (int ks = 0; ks < 16; ++ks) { const bf16x8 kf = *(const LAS bf16x8*)(kp + 32 * ks); s = __builtin_amdgcn_mfma_f32_32x32x16_bf16(kf, qf[ks], s, 0, 0, 0); }
                if (cb == rb) {
#pragma unroll
                    for (int i = 0; i < 16; ++i) { const int key = (i & 3) + 8 * (i >> 2) + 4 * hh; if (key > r32) s[i] = 0.f; }
                }
#pragma unroll
                for (int g = 0; g < 4; ++g) { u32x2 o; o.x = cvt_pk_bf16(s[4 * g], s[4 * g + 1]); o.y = cvt_pk_bf16(s[4 * g + 2], s[4 * g + 3]);
                    *(LAS u32x2*)(lds + L_PS + (32 * rb + r32) * PP + (32 * cb + 8 * g + 4 * hh) * 2) = o; }
            }
        }
        __syncthreads();
        f32x16 o;
#pragma unroll
        for (int i = 0; i < 16; ++i) o[i] = 0.f;
        { const LAS unsigned char* rp = lds + L_RB + (32 * cx + r32) * RP + 16 * hh;
#pragma unroll
          for (int ks = 0; ks < 16; ++ks) { const bf16x8 rf = *(const LAS bf16x8*)(rp + 32 * ks); o = __builtin_amdgcn_mfma_f32_32x32x16_bf16(qf[ks], rf, o, 0, 0, 0); } }
        __builtin_amdgcn_sched_barrier(0);
        if (more) {
#pragma unroll
            for (int ks = 0; ks < 16; ++ks) qf[ks] = *(const bf16x8*)(qg + (size_t)(ch + 1) * 4 * 8192 + 512 * ks);
        }
        __builtin_amdgcn_sched_barrier(0);
        { const LAS unsigned char* pp = lds + L_PS + (32 * rb + r32) * PP + 16 * hh;
          const LAS unsigned char* vp = lds + L_VT + (32 * cx + r32) * VP + 16 * hh;
          const int nks = 2 * (rb + 1);
          for (int ks = 0; ks < nks; ++ks) { const bf16x8 pf = *(const LAS bf16x8*)(pp + 32 * ks), vf = *(const LAS bf16x8*)(vp + 32 * ks); o = __builtin_amdgcn_mfma_f32_32x32x16_bf16(pf, vf, o, 0, 0, 0); } }
#pragma unroll
        for (int ks = 0; ks < 8; ++ks) {
            const LAS unsigned char* kt = lds + L_KC + (16 * ks + trrow) * KP + (32 * w + trcol) * 2;
            const s16x4 lo = tr_read(kt), hi = tr_read(kt + 4 * KP);
            const bf16x8 af = (bf16x8){lo[0], lo[1], lo[2], lo[3], hi[0], hi[1], hi[2], hi[3]};
#pragma unroll
            for (int vt = 0; vt < 2; ++vt) { const bf16x8 vf = *(const LAS bf16x8*)(lds + L_VT + (32 * vt + r32) * VP + (16 * ks + 8 * hh) * 2);
                racc[vt] = __builtin_amdgcn_mfma_f32_32x32x16_bf16(af, vf, racc[vt], 0, 0, 0); }
        }
#pragma unroll
        for (int gb = 0; gb < 2; ++gb) {
            unsigned gz[8];
#pragma unroll
            for (int i = 0; i < 8; ++i) gz[i] = (unsigned)G[(rowbase + 32 * rb + (i & 3) + 8 * (2 * gb + (i >> 2)) + 4 * hh) * RVW + col];
#pragma unroll
            for (int g2 = 0; g2 < 2; ++g2) {
                const int g = 2 * gb + g2;
                const f32x4 rs = *(const LAS f32x4*)(rs1 + 32 * rb + 8 * g + 4 * hh);
#pragma unroll
                for (int j = 0; j < 4; ++j) {
                    const int q = 32 * rb + 8 * g + 4 * hh + j;
                    const float y = o[4 * g + j] * rs[j];
                    const float sq = half_sum_hi(y * y);
                    if (r32 == 31 && !dry) SSQ[(rowbase + q) * 64 + h * 16 + vs * 2 + cx] = sq;
                    const bf16_t ov = (bf16_t)f2bf(y * bf2f(gz[4 * g2 + j]) * gn);
                    if (!dry) G[(rowbase + q) * RVW + col] = ov;
                }
            }
        }
    }
}
}

namespace fox {
constexpr int TP = 144;
constexpr int L_K = 0, L_V = 2 * 128 * TP, L_KB = 4 * 128 * TP, L_WS = L_KB + SEQ * 4, L_SC = L_WS + 8 * 32 * 4, L_END = L_SC + 96;
__device__ __forceinline__ int crow(int r, int hi) { return (r & 3) + 8 * (r >> 2) + 4 * hi; }

__device__ __forceinline__ void prep(const float* logf, int b, int h, LAS unsigned char* lds, int tid, int lane, int w) {
    const size_t rowbase = (size_t)b * SEQ;
    LAS float* kb2 = (LAS float*)(lds + L_KB);
    LAS float* wsum = (LAS float*)(lds + L_SC);
    __syncthreads();
    float a[4];
#pragma unroll
    for (int i = 0; i < 4; ++i) a[i] = logf[(rowbase + 4 * tid + i) * 16 + h];
    a[1] += a[0]; a[2] += a[1]; a[3] += a[2];
    float x = a[3];
#pragma unroll
    for (int off = 1; off < 64; off <<= 1) { const float t = __shfl_up(x, off); if (lane >= off) x += t; }
    if (lane == 63) wsum[w] = x;
    __syncthreads();
    float pre = 0.f;
    for (int i = 0; i < w; ++i) pre += wsum[i];
    const float ex = pre + x - a[3];
    *(LAS f32x4*)(kb2 + 4 * tid) = (f32x4){-LOG2E * (ex + a[0]), -LOG2E * (ex + a[1]), -LOG2E * (ex + a[2]), -LOG2E * (ex + a[3])};
    __syncthreads();
}

__device__ __forceinline__ void unit(bf16_t* QY, const bf16_t* K, const bf16_t* V, const bf16_t* OG, float qk_bound, int b, int h, int qb, LAS unsigned char* lds, int tid, int lane, int w, bool dry = false) {
    const int r32 = lane & 31, hh = lane >> 5;
    const size_t rowbase = (size_t)b * SEQ; const int q0 = qb * 256;
    LAS float* kb2 = (LAS float*)(lds + L_KB);
    LAS float* wsf = (LAS float*)(lds + L_WS) + w * 32;
    LAS unsigned* flags = (LAS unsigned*)(lds + L_SC + 32);
    __syncthreads();
    bf16x8 qr[4];
    { const bf16_t* qp = QY + (rowbase + q0 + 32 * w + r32) * 1024 + h * FD + 8 * hh;
#pragma unroll
      for (int ks = 0; ks < 4; ++ks) qr[ks] = *(const bf16x8*)(qp + 16 * ks); }
    const int NT = 4 * (qb + 1), NP = NT / 2;
    const int srow = tid >> 3, sc8 = tid & 7;
    const bf16_t* kg = K + (rowbase + srow) * 1024 + h * FD + 8 * sc8;
    const bf16_t* vg = V + (rowbase + srow) * 1024 + h * FD + 8 * sc8;
    u32x4 kreg[2], vreg[2];
#pragma unroll
    for (int i = 0; i < 2; ++i) { kreg[i] = *(const u32x4*)(kg + (size_t)((NP - 1) * 128 + 64 * i) * 1024); vreg[i] = *(const u32x4*)(vg + (size_t)((NP - 1) * 128 + 64 * i) * 1024); }
#pragma unroll
    for (int i = 0; i < 2; ++i) { *(LAS u32x4*)(lds + L_K + (srow + 64 * i) * TP + 16 * sc8) = kreg[i]; *(LAS u32x4*)(lds + L_V + (srow + 64 * i) * TP + 16 * sc8) = vreg[i]; }
    __syncthreads();
    float m_run = -INFINITY, l_run = 0.f;
    f32x16 o[2];
#pragma unroll
    for (int i = 0; i < 16; ++i) { o[0][i] = 0.f; o[1][i] = 0.f; }
    const int qmin = q0 + 32 * w, query = qmin + r32;
    const int trrow = 4 * (lane >> 5) + ((lane & 15) >> 2), trcol = 16 * ((lane >> 4) & 1) + 4 * (lane & 3);
    bool wdone = false;
    int buf = 0;
#define FOX_TILE(t, kbuf, vbuf) do { \
        if (!wdone && 64 * t <= qmin + 31) { \
            f32x16 p[2]; \
_Pragma("unroll") \
            for (int half = 0; half < 2; ++half) { \
_Pragma("unroll") \
                for (int g = 0; g < 4; ++g) { const f32x4 kb = *(const LAS f32x4*)(kb2 + 64 * t + 32 * half + 8 * g + 4 * hh); \
                    p[half][4 * g] = kb[0]; p[half][4 * g + 1] = kb[1]; p[half][4 * g + 2] = kb[2]; p[half][4 * g + 3] = kb[3]; } \
_Pragma("unroll") \
                for (int ks = 0; ks < 4; ++ks) { const bf16x8 kf = *(const LAS bf16x8*)(kbuf + (32 * half + r32) * TP + (16 * ks + 8 * hh) * 2); \
                    p[half] = __builtin_amdgcn_mfma_f32_32x32x16_bf16(kf, qr[ks], p[half], 0, 0, 0); } \
            } \
            if (64 * t + 63 > qmin) { \
_Pragma("unroll") \
                for (int half = 0; half < 2; ++half) \
_Pragma("unroll") \
                    for (int i = 0; i < 16; ++i) { const int key = 64 * t + 32 * half + crow(i, hh); if (key > query) p[half][i] = -INFINITY; } \
            } \
            float mx = __builtin_fmaxf(__builtin_fmaxf(p[0][0], p[0][1]), p[1][0]); \
_Pragma("unroll") \
            for (int i = 2; i < 16; i += 2) mx = __builtin_fmaxf(__builtin_fmaxf(mx, p[0][i]), p[0][i + 1]); \
_Pragma("unroll") \
            for (int i = 1; i < 15; i += 2) mx = __builtin_fmaxf(__builtin_fmaxf(mx, p[1][i]), p[1][i + 1]); \
            mx = __builtin_fmaxf(mx, p[1][15]); \
            mx = fmaxf(mx, __shfl_xor(mx, 32)); \
            const float m_new = fmaxf(m_run, mx); \
            const float alpha = __builtin_amdgcn_exp2f(m_run - m_new); \
            const bool resc = __any(m_new > m_run); \
            m_run = m_new; \
            float ls = 0.f; \
_Pragma("unroll") \
            for (int half = 0; half < 2; ++half) \
_Pragma("unroll") \
                for (int i = 0; i < 16; ++i) { p[half][i] = __builtin_amdgcn_exp2f(p[half][i] - m_new); ls += p[half][i]; } \
            ls += __shfl_xor(ls, 32); \
            l_run = l_run * alpha + ls; \
            if (resc) { \
                if (hh == 0) wsf[r32] = alpha; \
                LDS_WAIT(); asm volatile("" ::: "memory"); \
_Pragma("unroll") \
                for (int g = 0; g < 4; ++g) { const f32x4 al = *(const LAS f32x4*)(wsf + 8 * g + 4 * hh); \
_Pragma("unroll") \
                    for (int j = 0; j < 4; ++j) { o[0][4 * g + j] *= al[j]; o[1][4 * g + j] *= al[j]; } } \
            } \
 \
_Pragma("unroll") \
            for (int half = 0; half < 2; ++half) \
_Pragma("unroll") \
                for (int s = 0; s < 2; ++s) { \
                    u32x4 pw; pw.x = cvt_pk_bf16(p[half][8 * s], p[half][8 * s + 1]); pw.y = cvt_pk_bf16(p[half][8 * s + 2], p[half][8 * s + 3]); \
                    pw.z = cvt_pk_bf16(p[half][8 * s + 4], p[half][8 * s + 5]); pw.w = cvt_pk_bf16(p[half][8 * s + 6], p[half][8 * s + 7]); \
                    const bf16x8 pf = __builtin_bit_cast(bf16x8, pw); \
                    const int kbase = 32 * half + 16 * s; \
_Pragma("unroll") \
                    for (int dt = 0; dt < 2; ++dt) { \
                        const LAS unsigned char* vp = vbuf + (kbase + trrow) * TP + (32 * dt + trcol) * 2; \
                        const s16x4 lo = ret::tr_read(vp), hi = ret::tr_read(vp + 8 * TP); \
                        const bf16x8 vf = (bf16x8){lo[0], lo[1], lo[2], lo[3], hi[0], hi[1], hi[2], hi[3]}; \
                        o[dt] = __builtin_amdgcn_mfma_f32_32x32x16_bf16(pf, vf, o[dt], 0, 0, 0); \
                    } \
                } \
 \
            if (t > 0) { const float nxt = kb2[64 * t - 1] + qk_bound + 64.f; \
                if (__all(nxt < m_run)) wdone = true; } \
        } \
    } while (0)
    for (int tp = NP - 1; tp >= 0; --tp, buf ^= 1) {
        if (tp > 0) {
#pragma unroll
            for (int i = 0; i < 2; ++i) { kreg[i] = *(const u32x4*)(kg + (size_t)((tp - 1) * 128 + 64 * i) * 1024); vreg[i] = *(const u32x4*)(vg + (size_t)((tp - 1) * 128 + 64 * i) * 1024); } }
        { const LAS unsigned char* kb1 = lds + L_K + (buf * 128 + 64) * TP; const LAS unsigned char* vb1 = lds + L_V + (buf * 128 + 64) * TP;
          const int t1 = 2 * tp + 1; FOX_TILE(t1, kb1, vb1); }
        { const LAS unsigned char* kb0 = lds + L_K + (buf * 128) * TP; const LAS unsigned char* vb0 = lds + L_V + (buf * 128) * TP;
          const int t0 = 2 * tp; FOX_TILE(t0, kb0, vb0); }
        if (lane == 0) flags[(tp & 1) * 8 + w] = wdone ? 1u : 0u;
        if (tp > 0) {
#pragma unroll
            for (int i = 0; i < 2; ++i) { *(LAS u32x4*)(lds + L_K + ((buf ^ 1) * 128 + srow + 64 * i) * TP + 16 * sc8) = kreg[i]; *(LAS u32x4*)(lds + L_V + ((buf ^ 1) * 128 + srow + 64 * i) * TP + 16 * sc8) = vreg[i]; } }
        __syncthreads();
        { const u32x4 f0 = *(const LAS u32x4*)(flags + (tp & 1) * 8), f1 = *(const LAS u32x4*)(flags + (tp & 1) * 8 + 4);
          if ((f0.x & f0.y & f0.z & f0.w & f1.x & f1.y & f1.z & f1.w) != 0u) break; }
    }
#undef FOX_TILE
    if (hh == 0) wsf[r32] = 1.f / l_run;
    LDS_WAIT(); asm volatile("" ::: "memory");
    unsigned ogv[2][16];
#pragma unroll
    for (int i = 0; i < 16; ++i)
#pragma unroll
        for (int dt = 0; dt < 2; ++dt) ogv[dt][i] = (unsigned)OG[(rowbase + q0 + 32 * w + (i & 3) + 8 * (i >> 2) + 4 * hh) * 1024 + h * FD + 32 * dt + r32];
#pragma unroll
    for (int g = 0; g < 4; ++g) { const f32x4 rl = *(const LAS f32x4*)(wsf + 8 * g + 4 * hh);
#pragma unroll
        for (int j = 0; j < 4; ++j) {
            const size_t row = rowbase + q0 + 32 * w + 8 * g + 4 * hh + j;
#pragma unroll
            for (int dt = 0; dt < 2; ++dt) { const size_t off = row * 1024 + h * FD + 32 * dt + r32;
                const bf16_t yv = (bf16_t)f2bf(o[dt][4 * g + j] * rl[j] * bf2f(ogv[dt][4 * g + j])); if (!dry) QY[off] = yv; }
        } }
}
}

#define XB_TMO      128
#define XB_XCNT(j)  (256  + 64 * (j))
#define XB_XSUB(j)  (1280 + 64 * (j))
#define XB_XGEN(j)  (2304 + 64 * (j))
#define XB_TOP      3328
#define XB_TOPGEN   3392
#define XCD_BAR_WORDS 3456
#define XB_SPIN_CAP (1u << 18)

__device__ __forceinline__ unsigned xb_ld(unsigned* p)              { return __hip_atomic_load(p, __ATOMIC_RELAXED, __HIP_MEMORY_SCOPE_AGENT); }
__device__ __forceinline__ unsigned xb_add(unsigned* p, unsigned v) { return __hip_atomic_fetch_add(p, v, __ATOMIC_RELAXED, __HIP_MEMORY_SCOPE_AGENT); }
__device__ __forceinline__ unsigned xb_xcc_id() { return (unsigned)__builtin_amdgcn_s_getreg((3 << 11) | 20) & 0xFu; }
#define XB_SPIN(cond, bar) do { unsigned _sp = 0; while (cond) { __builtin_amdgcn_s_sleep(1); \
    if ((++_sp & 255u) == 0u) { if (xb_ld(&(bar)[XB_TMO])) break; if (_sp > XB_SPIN_CAP) { atomicAdd(&(bar)[XB_TMO], 1u); break; } } } } while (0)

struct XcdBarrier {
    unsigned* bar; unsigned x;
    volatile LAS unsigned* st;
};

__device__ __forceinline__ XcdBarrier xcd_barrier_post(unsigned* bar, volatile LAS unsigned* st) {
    XcdBarrier b; b.bar = bar; b.x = xb_xcc_id(); b.st = st;
    if (threadIdx.x == 0) (void)xb_add(&bar[XB_XCNT(b.x)], 1u);
    return b;
}
__device__ __forceinline__ void xcd_barrier_complete(unsigned* bar, unsigned x, unsigned& nloc, unsigned& nx) {
    const unsigned G = gridDim.x * gridDim.y * gridDim.z;
    unsigned sum, cnt, mine, sp = 0u;
    for (;;) {
        sum = 0u; cnt = 0u; mine = 0u;
#pragma unroll
        for (unsigned j = 0; j < 16; ++j) { const unsigned c = xb_ld(&bar[XB_XCNT(j)]); sum += c; cnt += (c > 0u) ? 1u : 0u; mine = (j == x) ? c : mine; }
        if (sum == G) break;
        __builtin_amdgcn_s_sleep(1);
        if ((++sp & 255u) == 0u) { if (xb_ld(&bar[XB_TMO])) break; if (sp > XB_SPIN_CAP) { atomicAdd(&bar[XB_TMO], 1u); break; } }
    }
    nloc = mine > 0u ? mine : 1u; nx = cnt > 0u ? cnt : 1u;
}

__device__ __forceinline__ void xcd_barrier(const XcdBarrier& b) {
    asm volatile("s_waitcnt vmcnt(0)" ::: "memory");
    __syncthreads();
    if (threadIdx.x == 0) {
        unsigned* bar = b.bar;
        __builtin_amdgcn_s_waitcnt(0);
        unsigned nloc = b.st[0], nx = b.st[1];
        if (nloc == 0u) { xcd_barrier_complete(bar, b.x, nloc, nx); b.st[0] = nloc; b.st[1] = nx; }
        const unsigned old = xb_add(&bar[XB_XSUB(b.x)], 1u);
        const unsigned gen = old / nloc;
        if (old + 1u == (gen + 1u) * nloc) {
            __builtin_amdgcn_fence(__ATOMIC_RELEASE, "agent");
            asm volatile("s_waitcnt vmcnt(0)" ::: "memory");
            const unsigned og = xb_add(&bar[XB_TOP], 1u);
            const unsigned tg = og / nx;
            if (og + 1u == (tg + 1u) * nx) xb_add(&bar[XB_TOPGEN], 1u);
            else XB_SPIN(xb_ld(&bar[XB_TOPGEN]) == tg, bar);
            __builtin_amdgcn_fence(__ATOMIC_ACQUIRE, "agent");
            xb_add(&bar[XB_XGEN(b.x)], 1u);
            asm volatile("s_waitcnt vmcnt(0)" ::: "memory");
        } else {
            XB_SPIN(xb_ld(&bar[XB_XGEN(b.x)]) == gen, bar);
            __builtin_amdgcn_fence(__ATOMIC_ACQUIRE, "agent");
            asm volatile("s_waitcnt vmcnt(0)" ::: "memory");
        }
    }
    __syncthreads();
}

__global__ void __launch_bounds__(512, 2) yoco_fwd(Args a) {
    extern __shared__ __attribute__((aligned(16))) unsigned char lds_raw[];
    LAS unsigned char* lds = (LAS unsigned char*)lds_raw;
    cg::grid_group grid = cg::this_grid();
    int tid = threadIdx.x, lane = tid & 63, wave = __builtin_amdgcn_readfirstlane(tid >> 6);
#define FENCE() do { asm volatile("" : "+v"(tid)); lane = tid & 63; wave = __builtin_amdgcn_readfirstlane(tid >> 6); } while (0)
#define GSYNC_CG() do { if (G > (1 << 20)) grid.sync(); xcd_barrier(xbar); FENCE(); } while (0)
#define GSYNC() do { xcd_barrier(xbar); FENCE(); } while (0)
    const int G = gridDim.x, bx = blockIdx.x;
    const int vcu = (G % 8 == 0) ? (bx % 8) * (G / 8) + bx / 8 : bx;
    unsigned char* ws = a.ws;
    volatile LAS unsigned* bst = (volatile LAS unsigned*)(lds + XBST_OFF);
    if (tid < 2) bst[tid] = 0u;
    __syncthreads();
    const XcdBarrier xbar = xcd_barrier_post((unsigned*)(ws + WS_CTL), bst);
    float* ADA = (float*)(ws + WS_ADA);
    float* LOGF = (float*)(ws + WS_LOGF);
    float* SSQ = (float*)(ws + WS_SSQ);
    bf16_t* HN = (bf16_t*)(ws + WS_HN);
    bf16_t* HKV = (bf16_t*)(ws + WS_HKV);
    bf16_t* BIG = (bf16_t*)(ws + WS_BIG);
    bf16_t* RQ = (bf16_t*)a.out;
    bf16_t* RK = RQ + (size_t)M * 1024;
    bf16_t* RV = BIG;
    bf16_t* RG = BIG + (size_t)M * 2048;
    bf16_t* HID = BIG;
    bf16_t* KSH = BIG, *VSH = BIG + (size_t)M * 1024, *QY = BIG + (size_t)2 * M * 1024, *OG = BIG + (size_t)3 * M * 1024;
    const float* A0 = ADA, *A1 = ADA + 6144, *AKV = ADA + 12288;
    float* SSQ2 = (float*)(ws + WS_SSQ2);
    bf16_t* XB = (bf16_t*)a.out;
    bf16_t* XB2 = HKV;
    LAS float* wscr = (LAS float*)(lds + WSCR_OFF);

#ifndef EXTRA_P0
#define EXTRA_P0 0
#endif
    for (int rep = EXTRA_P0; rep >= 0; --rep) { phase0(a, lds, tid, lane, wave); __syncthreads(); }
    GSYNC_CG();
    norm_rows(a.x, a.nmg, A0, A0 + 1024, HN, lane, wave);
    { float* B2 = (float*)(ws + WS_BIAS2);
      bias2_rows((const bf16_t*)(ws + WS_WM1_0), FF, A0 + 3072, B2 + B2_MLP0, FF, lane, wave);
      bias2_rows((const bf16_t*)(ws + WS_WM1_1), FF, A1 + 3072, B2 + B2_MLP1, FF, lane, wave);
      bias2_rows((const bf16_t*)(ws + WS_WKV), 2 * D + 256, AKV, B2 + B2_KV, 2 * D + 256, lane, wave);
      bias2_rows((const bf16_t*)(ws + WS_WFIN), 2 * D, A1, B2 + B2_FOX, 2 * D, lane, wave); }
    GSYNC();
    { pg8::Gemm g{HN, (const bf16_t*)(ws + WS_WRIN), M, RIN, D}; pg8::StaticOrder S; S.init(M, RIN, G, bx);
      pg8::EpiRetIn E{RQ, RK, RV, RG, (const float*)(ws + WS_TAB)};
      pg8::gemm_phase<pg8::EpiRetIn, pg8::StaticOrder, true, true>(lds, g, S, E, tid); }
    GSYNC();
#ifndef EXTRA_P3
#define EXTRA_P3 0
#endif
    for (int rep = EXTRA_P3; rep >= 0; --rep)
    for (int u = vcu; u < BATCH * RH * 8; u += G) ret::unit(RQ, RK, RV, RG, SSQ, a.ret_ng, u >> 5, (u >> 3) & 3, u & 7, lds, tid, lane, wave, rep > 0 && G < 100000);
    GSYNC();
    { pg8::Gemm g{RG, (const bf16_t*)(ws + WS_WROUT), M, D, RVW}; pg8::StaticOrder S; S.init(M, D, G, bx);
      LAS float* rtab = (LAS float*)(lds + RTAB_OFF);
      pg8::Unit u;
      for (int i = 0; S.next(i, u); ++i) {
          __syncthreads();
          { const int r = tid >> 1, h0 = (tid & 1) * 2; const float* sp = SSQ + ((size_t)(u.pm * 256 + r) * 4 + h0) * 16;
#pragma unroll
            for (int hh = 0; hh < 2; ++hh) { float s = 0.f;
#pragma unroll
                for (int k = 0; k < 4; ++k) { const f32x4 v = *(const f32x4*)(sp + hh * 16 + 4 * k); s += (v[0] + v[1]) + (v[2] + v[3]); }
                rtab[r * 4 + h0 + hh] = rsqrtf(s * (1.f / RDV) + EPS); } }
          __syncthreads();
          pg8::OneUnit S1{u}; pg8::EpiRes<true, 1, false, true> E{a.x, XB, A0 + 2048, ADA_LD, rtab, {HN, nullptr}, {a.nlg, nullptr}, {A0 + 4096, nullptr}, SSQ2};
          pg8::gemm_phase<pg8::EpiRes<true, 1, false, true>, pg8::OneUnit, false, true>(lds, g, S1, E, tid);
      } }
    GSYNC();
#if defined(STOP_AFTER) && STOP_AFTER == 4
    return;
#endif
#ifndef EXTRA_P6
#define EXTRA_P6 0
#endif
#ifndef EXTRA_NORM
#define EXTRA_NORM 0
#endif
#ifndef EXTRA_SYNC
#define EXTRA_SYNC 0
#endif
#define MLP_IN(WM1, B2OFF) do { \
    { pg8::Gemm g{HN, (const bf16_t*)(ws + (WM1)), M, FF, D}; pg8::StaticOrder S; S.init(M, FF, G, bx); pg8::EpiSqRelu E{HID, SSQ2, (const float*)(ws + WS_BIAS2) + (B2OFF), wscr}; \
      pg8::gemm_phase<pg8::EpiSqRelu, pg8::StaticOrder, true, true>(lds, g, S, E, tid); } \
    GSYNC(); } while (0)
    MLP_IN(WS_WM1_0, B2_MLP0);
    { pg8::Gemm g{HID, (const bf16_t*)(ws + WS_WM2_0), M, D, FF}; pg8::StaticOrder S; S.init(M, D, G, bx);
      pg8::EpiRes<false, 2, true, true> E{XB, XB, A0 + 5120, ADA_LD, nullptr, {HKV, HN}, {a.kv_ng, a.nmg + D}, {AKV + 1024, A1 + 1024}, SSQ2};
      pg8::gemm_phase<pg8::EpiRes<false, 2, true, true>, pg8::StaticOrder, true, true>(lds, g, S, E, tid); }
    GSYNC();
#if defined(STOP_AFTER) && STOP_AFTER == 7
    return;
#endif
    logf_rows(HKV, (const bf16_t*)(ws + WS_WKV) + (size_t)2048 * D, SSQ2, (const float*)(ws + WS_BIAS2) + B2_KV + 2048, 2 * D + 256, a.fbias, LOGF, lds, tid, lane, wave);
    { pg8::Gemm g{HKV, (const bf16_t*)(ws + WS_WKV), M, 2 * D, D}; pg8::StaticOrder S; S.init(M, 2 * D, G, bx);
      pg8::EpiHeads<0> E{KSH, VSH, a.k_ng, 1.f, LOGF, a.fbias, SSQ2, (const float*)(ws + WS_BIAS2) + B2_KV, 2 * D + 256, wscr};
      pg8::gemm_phase<pg8::EpiHeads<0>, pg8::StaticOrder, true, true>(lds, g, S, E, tid); }
    FENCE();
    { pg8::Gemm g{HN, (const bf16_t*)(ws + WS_WFIN), M, 2 * D, D}; pg8::StaticOrder S; S.init(M, 2 * D, G, bx);
      pg8::EpiHeads<1> E{QY, OG, a.q_ng, QSCALE, nullptr, nullptr, SSQ2, (const float*)(ws + WS_BIAS2) + B2_FOX, 2 * D, wscr};
      pg8::gemm_phase<pg8::EpiHeads<1>, pg8::StaticOrder, true, true>(lds, g, S, E, tid); }
    GSYNC();
#ifndef SKIP_ATTN
#ifndef EXTRA_P10
#define EXTRA_P10 0
#endif
    float qk_bound;
    { float gq = fabsf(a.q_ng[lane]), gk = fabsf(a.k_ng[lane]);
#pragma unroll
      for (int o = 1; o < 64; o <<= 1) { gq = fmaxf(gq, __shfl_xor(gq, o)); gk = fmaxf(gk, __shfl_xor(gk, o)); }
      qk_bound = 64.f * gq * gk * QSCALE * 1.02f; }
    for (int rep = EXTRA_P10; rep >= 0; --rep)
    for (int it = vcu; it < 256; it += G) {
        const int bh = it >> 1;
        fox::prep(LOGF, bh >> 4, bh & 15, lds, tid, lane, wave);
#pragma unroll 1
        for (int i = 0; i < 4; ++i) { const int s = (i >> 1) ? 3 - (it & 1) : (it & 1), qb = (i & 1) ? 7 - s : s;
            fox::unit(QY, KSH, VSH, OG, qk_bound, bh >> 4, bh & 15, qb, lds, tid, lane, wave, rep > 0 && G < 100000); }
    }
#endif
    GSYNC();
    { pg8::Gemm g{QY, (const bf16_t*)(ws + WS_WFOUT), M, D, D}; pg8::StaticOrder S; S.init(M, D, G, bx); pg8::EpiRes<false, 1, true, true> E{XB, XB2, A1 + 2048, ADA_LD, nullptr, {HN, nullptr}, {a.nlg + D, nullptr}, {A1 + 4096, nullptr}, SSQ2};
      pg8::gemm_phase<pg8::EpiRes<false, 1, true, true>, pg8::StaticOrder, true, true>(lds, g, S, E, tid); }
    GSYNC();
#if defined(STOP_AFTER) && STOP_AFTER == 11
    return;
#endif
    MLP_IN(WS_WM1_1, B2_MLP1);
    { pg8::Gemm g{HID, (const bf16_t*)(ws + WS_WM2_1), M, D, FF}; pg8::StaticOrder S; S.init(M, D, G, bx);
      pg8::EpiRes<false, 0, true, false> E{XB2, a.out, A1 + 5120, ADA_LD, nullptr, {nullptr, nullptr}, {nullptr, nullptr}, {nullptr, nullptr}, nullptr};
      pg8::gemm_phase<pg8::EpiRes<false, 0, true, false>, pg8::StaticOrder, true, true>(lds, g, S, E, tid); }
#undef MLP_IN
}

extern "C" void kernel_launch(void* const* d_in, const int* in_sizes, int n_in, void* d_out, int out_size, void* d_ws, size_t ws_size, hipStream_t stream) {
    static int grid = 0;
    if (grid == 0) {
        if (n_in != 21 || in_sizes[0] != M * D || out_size != M * D || ws_size < WS_END) { fprintf(stderr, "kernel_launch: unexpected shapes (n_in %d, x %d, out %d, ws %zu)\n", n_in, n_in > 0 ? in_sizes[0] : -1, out_size, ws_size); grid = -1; return; }
        int dev = 0, cus = 0, per_cu = 0;
        if (hipGetDevice(&dev) != hipSuccess || hipDeviceGetAttribute(&cus, hipDeviceAttributeMultiprocessorCount, dev) != hipSuccess) { grid = -1; return; }
        if (hipFuncSetAttribute((const void*)yoco_fwd, hipFuncAttributeMaxDynamicSharedMemorySize, LDS_BYTES) != hipSuccess) { fprintf(stderr, "kernel_launch: hipFuncSetAttribute failed\n"); grid = -1; return; }
        if (hipOccupancyMaxActiveBlocksPerMultiprocessor(&per_cu, (const void*)yoco_fwd, 512, LDS_BYTES) != hipSuccess || per_cu < 1) per_cu = 1;
        (void)hipGetLastError();
        grid = cus * per_cu; if (grid > 256) grid = 256;
    }
    if (grid < 0) return;
    Args p{};
    p.x = (const float*)d_in[0]; p.c = (const float*)d_in[1]; p.pos = (const int*)d_in[2];
    p.nmg = (const float*)d_in[3]; p.nlg = (const float*)d_in[4]; p.w_ada = (const float*)d_in[5]; p.b_ada = (const float*)d_in[6];
    p.w_mlp_in = (const float*)d_in[7]; p.w_mlp_out = (const float*)d_in[8]; p.ret_w_in = (const float*)d_in[9]; p.ret_ng = (const float*)d_in[10];
    p.ret_w_out = (const float*)d_in[11]; p.kv_ng = (const float*)d_in[12]; p.kv_w_ada = (const float*)d_in[13]; p.kv_b_ada = (const float*)d_in[14];
    p.kv_w = (const float*)d_in[15]; p.fbias = (const float*)d_in[16]; p.k_ng = (const float*)d_in[17]; p.fox_w_in = (const float*)d_in[18];
    p.q_ng = (const float*)d_in[19]; p.fox_w_out = (const float*)d_in[20];
    p.out = (float*)d_out; p.ws = (unsigned char*)d_ws;
    if (hipMemsetAsync((char*)d_ws + WS_CTL, 0, CTL_ZERO_BYTES, stream) != hipSuccess) { fprintf(stderr, "kernel_launch: memset failed\n"); return; }
    void* args[] = {&p};
    const hipError_t e = hipLaunchCooperativeKernel((const void*)yoco_fwd, dim3(grid), dim3(512), args, LDS_BYTES, stream);
    if (e != hipSuccess) fprintf(stderr, "kernel_launch: cooperative launch failed: %s (grid %d)\n", hipGetErrorString(e), grid);
}
```

```cpp
#include <hip/hip_runtime.h>
#include <hip/hip_cooperative_groups.h>
#include <cstdio>
#include <cstdint>
namespace cg = cooperative_groups;

namespace pg8 {
#define PG8_LAS __attribute__((address_space(3)))
typedef unsigned short bf16_t;
typedef short bf16x8 __attribute__((ext_vector_type(8)));
typedef float f32x4 __attribute__((ext_vector_type(4)));
typedef unsigned u32x4 __attribute__((ext_vector_type(4)));
constexpr int BM = 256, BK = 64, HALF = 128, HTB = HALF * BK * 2  , STAGE_BYTES = 8 * HTB, NXCD = 8, WGM = 8;

__host__ __device__ __forceinline__ int lds_byte(int r, int c) { const int st = (r >> 4) * 2 + (c >> 5), rr = r & 15, cc = c & 31, ob = rr * 64 + cc * 2; return st * 1024 + (ob ^ (((ob >> 9) & 1) << 5)); }
__host__ __device__ __forceinline__ void stage_rc(int b, int& R, int& C) { const int st = b / 1024, sb = b % 1024, swz = sb ^ (((sb >> 9) & 1) << 5); R = (st >> 1) * 16 + swz / 64; C = (st & 1) * 32 + (swz % 64) / 2; }
__host__ __device__ __forceinline__ int perm32(int rho) { const int n = rho >> 4, i = rho & 15; return 8 * (i >> 2) + 4 * n + (i & 3); }

struct Unit { int pm, pn; };
struct Gemm { const bf16_t* A; const bf16_t* Bt; int M, N, K; };

struct StaticOrder {
    int nM, nN, nwg, G, c;
    __host__ __device__ void init(int M, int N, int G_, int c_) { nM = M / BM; nN = N / BM; nwg = nM * nN; G = G_; c = c_; }
    __host__ __device__ bool next(int i, Unit& u) const {
        const long L = (long)i * G + c; if (L >= nwg) return false;
        int wgid = (int)L; { const int q = nwg / NXCD, r = nwg % NXCD, xcd = wgid % NXCD, off = wgid / NXCD; wgid = (xcd < r ? xcd * (q + 1) : r * (q + 1) + (xcd - r) * q) + off; }
        const int nig = WGM * nN, gid = wgid / nig, fm = gid * WGM, gsz = (nM - fm) < WGM ? (nM - fm) : WGM;
        u.pm = fm + ((wgid % nig) % gsz); u.pn = (wgid % nig) / gsz; return true;
    }
    __device__ __forceinline__ void a_ready(const Unit&) const {}
    __device__ __forceinline__ void done(const Unit&) const {}
};

typedef float f32x2 __attribute__((ext_vector_type(2)));
typedef __bf16 bf16x2_t __attribute__((ext_vector_type(2)));
__device__ __forceinline__ unsigned cvt_pk_bf16(float lo, float hi) { const f32x2 v = {lo, hi}; const bf16x2_t b = __builtin_convertvector(v, bf16x2_t); return __builtin_bit_cast(unsigned, b); }
typedef unsigned u32x2 __attribute__((ext_vector_type(2)));
__device__ __forceinline__ u32x4 pack8(f32x4 v0, f32x4 v1) { u32x4 w; w.x = cvt_pk_bf16(v0[0], v0[1]); w.y = cvt_pk_bf16(v0[2], v0[3]); w.z = cvt_pk_bf16(v1[0], v1[1]); w.w = cvt_pk_bf16(v1[2], v1[3]); return w; }
__device__ __forceinline__ float fast_sigmoid(float v) { return __builtin_amdgcn_rcpf(1.f + __expf(-v)); }

struct EpiRetIn {
    static constexpr bool PERM = true, AFTER_DRAIN = false, KHOOK = false;
    bf16_t *Q, *Kr, *V, *G; const float* tab;
    __device__ __forceinline__ void operator()(const f32x4 (&acc)[2][2][4][2], const Unit& u, int wr, int wc, int fr, int fq) const {
        const int row0 = u.pm * BM + wr * 64 + fr, cw = wc * 32 + 8 * fq;
        if (u.pn < 8) {
            const bool isk = u.pn >= 4; bf16_t* base = (isk ? Kr : Q) + (u.pn & 3) * 256 + cw; const float sc = isk ? 0.0625f : 1.f;
#pragma unroll
            for (int ab = 0; ab < 4; ++ab) {
                const int ai = ab >> 1;
                f32x4 tt[2][4];
#pragma unroll
                for (int mm = 0; mm < 2; ++mm) { const f32x4* tp = (const f32x4*)(tab + ((size_t)(row0 + ai * HALF + (2 * (ab & 1) + mm) * 16) * 128 + cw) * 2);
                    tt[mm][0] = tp[0]; tt[mm][1] = tp[1]; tt[mm][2] = tp[2]; tt[mm][3] = tp[3]; }
#pragma unroll
                for (int mm = 0; mm < 2; ++mm) {
                    const int m = 2 * (ab & 1) + mm;
                    const int row = row0 + ai * HALF + m * 16;
                    const f32x4 t0 = tt[mm][0], t1 = tt[mm][1], t2 = tt[mm][2], t3 = tt[mm][3];
                    const f32x4 xa = acc[ai][0][m][0] * sc, xb = acc[ai][0][m][1] * sc, ya = acc[ai][1][m][0] * sc, yb = acc[ai][1][m][1] * sc;
                    f32x4 o1a, o1b, o2a, o2b;
                    o1a[0] = xa[0] * t0[0] - ya[0] * t0[1]; o2a[0] = xa[0] * t0[1] + ya[0] * t0[0];
                    o1a[1] = xa[1] * t0[2] - ya[1] * t0[3]; o2a[1] = xa[1] * t0[3] + ya[1] * t0[2];
                    o1a[2] = xa[2] * t1[0] - ya[2] * t1[1]; o2a[2] = xa[2] * t1[1] + ya[2] * t1[0];
                    o1a[3] = xa[3] * t1[2] - ya[3] * t1[3]; o2a[3] = xa[3] * t1[3] + ya[3] * t1[2];
                    o1b[0] = xb[0] * t2[0] - yb[0] * t2[1]; o2b[0] = xb[0] * t2[1] + yb[0] * t2[0];
                    o1b[1] = xb[1] * t2[2] - yb[1] * t2[3]; o2b[1] = xb[1] * t2[3] + yb[1] * t2[2];
                    o1b[2] = xb[2] * t3[0] - yb[2] * t3[1]; o2b[2] = xb[2] * t3[1] + yb[2] * t3[0];
                    o1b[3] = xb[3] * t3[2] - yb[3] * t3[3]; o2b[3] = xb[3] * t3[3] + yb[3] * t3[2];
                    if (isk) { bf16_t* rp = base + (size_t)row * 1024;
                        *(u32x4*)(rp) = pack8(o1a, o1b); *(u32x4*)(rp + 128) = pack8(o2a, o2b); }
                    else {
                        bf16_t* rp = Q + ((size_t)((row >> 11) * 4 + (u.pn & 3)) * 64 + ((row >> 5) & 63)) * 8192 + (cw >> 4) * 512 + ((cw >> 3) & 1) * 256 + (row & 31) * 8;
                        *(u32x4*)(rp) = pack8(o1a, o1b); *(u32x4*)(rp + 8 * 512) = pack8(o2a, o2b); }
                }
                asm volatile("" ::: "memory");
            }
        } else if (u.pn < 16) {
            const int ct = u.pn - 8, hd = ct >> 1;
            const float lg = log2f(1.f - exp2f(-5.f - (float)hd));
#pragma unroll
            for (int ai = 0; ai < 2; ++ai)
#pragma unroll
                for (int m = 0; m < 4; ++m) {
                    const int row = row0 + ai * HALF + m * 16, tok = row & 127;
                    const float kd = exp2f((float)(127 - tok) * lg);
#pragma unroll
                    for (int bj = 0; bj < 2; ++bj) {
                        const int c0 = ct * 256 + bj * HALF + cw;
                        bf16_t* rp = V + ((((size_t)((row >> 11) * 4 + hd) * 8 + ((c0 >> 6) & 7)) * 16 + ((row >> 7) & 15)) * 8 + ((c0 >> 3) & 7)) * 1024 + tok * 8;
                        *(u32x4*)rp = pack8(acc[ai][bj][m][0] * kd, acc[ai][bj][m][1] * kd);
                    }
                }
        } else {
            const bool isg = true; bf16_t* base = G + (u.pn - 16) * 256 + cw;
#pragma unroll
            for (int ai = 0; ai < 2; ++ai)
#pragma unroll
                for (int m = 0; m < 4; ++m) {
                    bf16_t* rp = base + (size_t)(row0 + ai * HALF + m * 16) * 2048;
#pragma unroll
                    for (int bj = 0; bj < 2; ++bj) {
                        f32x4 v0 = acc[ai][bj][m][0], v1 = acc[ai][bj][m][1];
                        if (isg) {
#pragma unroll
                            for (int j = 0; j < 4; ++j) { v0[j] = v0[j] * fast_sigmoid(v0[j]); v1[j] = v1[j] * fast_sigmoid(v1[j]); }
                        }
                        *(u32x4*)(rp + bj * HALF) = pack8(v0, v1);
                    }
                }
        }
    }
};

template <bool HOOK, int NOUT, bool RIN16, bool ROUT16> struct EpiRes {
    static constexpr bool PERM = true, AFTER_DRAIN = false, KHOOK = HOOK;
    const void* resid; void* out; const float* gate; int gate_ld; const PG8_LAS float* rtab;
    bf16_t* hout[2]; const float* hgain[2]; const float* hscale[2]; float* ssq2;
    __device__ __forceinline__ void khook(f32x4 (&acc)[2][2][4][2], int seg, int wr, int fr) const {
#pragma unroll
        for (int ai = 0; ai < 2; ++ai)
#pragma unroll
            for (int m = 0; m < 4; ++m) {
                const int r = ai * HALF + wr * 64 + m * 16 + fr;
                const float f = rtab[r * 4 + seg] / rtab[r * 4 + seg + 1];
#pragma unroll
                for (int bj = 0; bj < 2; ++bj)
#pragma unroll
                    for (int n = 0; n < 2; ++n) acc[ai][bj][m][n] = acc[ai][bj][m][n] * f;
            }
    }
    __device__ __forceinline__ void operator()(const f32x4 (&acc)[2][2][4][2], const Unit& u, int wr, int wc, int fr, int fq) const {
        const int b = u.pm >> 3, col0 = u.pn * BM + wc * 32 + 8 * fq;
        f32x4 gv[2][2]; f32x4 gs[NOUT > 0 ? NOUT : 1][2][2];
#pragma unroll
        for (int bj = 0; bj < 2; ++bj)
#pragma unroll
            for (int n = 0; n < 2; ++n) { const int c = col0 + bj * HALF + 4 * n;
                gv[bj][n] = *(const f32x4*)(gate + (size_t)b * gate_ld + c);
#pragma unroll
                for (int i = 0; i < NOUT; ++i) gs[i][bj][n] = *(const f32x4*)(hgain[i] + c) * (*(const f32x4*)(hscale[i] + (size_t)b * gate_ld + c) + 1.f); }
#pragma unroll
        for (int ai = 0; ai < 2; ++ai) {
            constexpr int MB = RIN16 ? 2 : 1;
#pragma unroll
            for (int mb = 0; mb < 4; mb += MB) {
                u32x4 raw[MB][2][RIN16 ? 1 : 2];
#pragma unroll
                for (int mm = 0; mm < MB; ++mm) {
                    const size_t off = (size_t)(u.pm * BM + ai * HALF + wr * 64 + (mb + mm) * 16 + fr) * 1024 + col0;
#pragma unroll
                    for (int bj = 0; bj < 2; ++bj) {
                        if (RIN16) raw[mm][bj][0] = __builtin_nontemporal_load((const u32x4*)((const bf16_t*)resid + off + bj * HALF));
                        else { raw[mm][bj][0] = __builtin_nontemporal_load((const u32x4*)((const float*)resid + off + bj * HALF)); raw[mm][bj][RIN16 ? 0 : 1] = __builtin_nontemporal_load((const u32x4*)((const float*)resid + off + bj * HALF + 4)); }
                    }
                }
#pragma unroll
                for (int mm = 0; mm < MB; ++mm) {
                    const int m = mb + mm;
                    const int rl = ai * HALF + wr * 64 + m * 16 + fr;
                    float rs = 1.f; if (HOOK) rs = rtab[rl * 4 + 3];
                    const size_t off = (size_t)(u.pm * BM + rl) * 1024 + col0;
                    float ss = 0.f;
#pragma unroll
                    for (int bj = 0; bj < 2; ++bj) {
                        f32x4 r[2];
                        if (RIN16) { const u32x4 rw = raw[mm][bj][0];
                            r[0] = (f32x4){__uint_as_float(rw.x << 16), __uint_as_float(rw.x & 0xffff0000u), __uint_as_float(rw.y << 16), __uint_as_float(rw.y & 0xffff0000u)};
                            r[1] = (f32x4){__uint_as_float(rw.z << 16), __uint_as_float(rw.z & 0xffff0000u), __uint_as_float(rw.w << 16), __uint_as_float(rw.w & 0xffff0000u)}; }
                        else { r[0] = __builtin_bit_cast(f32x4, raw[mm][bj][0]); r[1] = __builtin_bit_cast(f32x4, raw[mm][bj][RIN16 ? 0 : 1]); }
                        f32x4 o[2];
#pragma unroll
                        for (int n = 0; n < 2; ++n) {
                            o[n] = r[n] + gv[bj][n] * (acc[ai][bj][m][n] * rs);
                            if (!ROUT16) *(f32x4*)((float*)out + off + bj * HALF + 4 * n) = o[n];
                            if (NOUT > 0) ss += (o[n][0] * o[n][0] + o[n][1] * o[n][1]) + (o[n][2] * o[n][2] + o[n][3] * o[n][3]);
                        }
                        if (ROUT16) *(u32x4*)((bf16_t*)out + off + bj * HALF) = pack8(o[0], o[1]);
#pragma unroll
                        for (int i = 0; i < NOUT; ++i) *(u32x4*)(hout[i] + off + bj * HALF) = pack8(o[0] * gs[i][bj][0], o[1] * gs[i][bj][1]);
                    }
                    if (NOUT > 0) { ss += __shfl_xor(ss, 16); ss += __shfl_xor(ss, 32);
                        if (fq == 0) ssq2[(size_t)(u.pm * BM + rl) * 16 + u.pn * 4 + wc] = ss; }
                }
                asm volatile("" ::: "memory");
            }
        }
    }
};

__device__ __forceinline__ void wave_rstd(const float* ssq2, PG8_LAS float* scr, int pm, int wr, int lane) {
#pragma unroll
    for (int t = 0; t < 2; ++t) { const int e = lane + 64 * t; const size_t row = (size_t)pm * BM + HALF * t + 64 * wr + lane;
        const f32x4* p = (const f32x4*)(ssq2 + row * 16); const f32x4 a = p[0], b = p[1], c = p[2], d = p[3];
        const float s = ((a[0] + a[1]) + (a[2] + a[3])) + ((b[0] + b[1]) + (b[2] + b[3])) + ((c[0] + c[1]) + (c[2] + c[3])) + ((d[0] + d[1]) + (d[2] + d[3]));
        scr[e] = rsqrtf(s * (1.f / 1024.f) + 1e-6f); }
    asm volatile("s_waitcnt lgkmcnt(0)" ::: "memory");
}

struct EpiSqRelu {
    static constexpr bool PERM = true, AFTER_DRAIN = false, KHOOK = false;
    bf16_t* O; const float* ssq2; const float* bias2; PG8_LAS float* scr0;
    __device__ __forceinline__ void operator()(const f32x4 (&acc)[2][2][4][2], const Unit& u, int wr, int wc, int fr, int fq) const {
        const int row0 = u.pm * BM + wr * 64 + fr, col0 = u.pn * BM + wc * 32 + 8 * fq;
        PG8_LAS float* scr = scr0 + (wr * 4 + wc) * 128;
        wave_rstd(ssq2, scr, u.pm, wr, fq * 16 + fr);
        f32x4 bv[2][2];
#pragma unroll
        for (int bj = 0; bj < 2; ++bj)
#pragma unroll
            for (int n = 0; n < 2; ++n) bv[bj][n] = *(const f32x4*)(bias2 + (size_t)(u.pm >> 3) * 4096 + col0 + bj * HALF + 4 * n);
#pragma unroll
        for (int ai = 0; ai < 2; ++ai)
#pragma unroll
            for (int m = 0; m < 4; ++m) {
                bf16_t* rp = O + (size_t)(row0 + ai * HALF + m * 16) * 4096 + col0;
                const float rstd = scr[ai * 64 + m * 16 + fr];
#pragma unroll
                for (int bj = 0; bj < 2; ++bj) {
                    f32x4 v0 = acc[ai][bj][m][0] * rstd + bv[bj][0], v1 = acc[ai][bj][m][1] * rstd + bv[bj][1];
#pragma unroll
                    for (int j = 0; j < 4; ++j) { const float a = fmaxf(v0[j], 0.f), c = fmaxf(v1[j], 0.f); v0[j] = a * a; v1[j] = c * c; }
                    *(u32x4*)(rp + bj * HALF) = pack8(v0, v1);
                }
            }
    }
};

template <int MODE1> struct EpiHeads {
    static constexpr bool PERM = true, AFTER_DRAIN = false, KHOOK = false;
    bf16_t *O0, *O1; const float* gain; float scale0; float* logf; const float* fbias;
    const float* ssq2; const float* bias2; int bias_ld; PG8_LAS float* scr0;
    __device__ __forceinline__ void operator()(const f32x4 (&acc0)[2][2][4][2], const Unit& u, int wr, int wc, int fr, int fq) const {
        const int row0 = u.pm * BM + wr * 64 + fr;
        PG8_LAS float* scr = scr0 + (wr * 4 + wc) * 128;
        wave_rstd(ssq2, scr, u.pm, wr, fq * 16 + fr);
        f32x4 acc[2][2][4][2];
        { f32x4 bv[2][2];
#pragma unroll
          for (int bj = 0; bj < 2; ++bj)
#pragma unroll
              for (int n = 0; n < 2; ++n) bv[bj][n] = *(const f32x4*)(bias2 + (size_t)(u.pm >> 3) * bias_ld + u.pn * BM + bj * HALF + wc * 32 + 8 * fq + 4 * n);
#pragma unroll
          for (int ai = 0; ai < 2; ++ai)
#pragma unroll
              for (int m = 0; m < 4; ++m) { const float rstd = scr[ai * 64 + m * 16 + fr];
#pragma unroll
                  for (int bj = 0; bj < 2; ++bj)
#pragma unroll
                      for (int n = 0; n < 2; ++n) acc[ai][bj][m][n] = acc0[ai][bj][m][n] * rstd + bv[bj][n]; } }
        if (u.pn < 4) {
            f32x4 gk[2][2];
#pragma unroll
            for (int bj = 0; bj < 2; ++bj)
#pragma unroll
                for (int n = 0; n < 2; ++n) gk[bj][n] = *(const f32x4*)(gain + 32 * bj + 8 * fq + 4 * n) * scale0;
#pragma unroll
            for (int ai = 0; ai < 2; ++ai)
#pragma unroll
                for (int m = 0; m < 4; ++m) {
                    float ss = 0.f;
#pragma unroll
                    for (int bj = 0; bj < 2; ++bj)
#pragma unroll
                        for (int n = 0; n < 2; ++n) { const f32x4 x = acc[ai][bj][m][n]; ss += (x[0] * x[0] + x[1] * x[1]) + (x[2] * x[2] + x[3] * x[3]); }
                    ss += __shfl_xor(ss, 16); ss += __shfl_xor(ss, 32);
                    const float rstd = rsqrtf(ss * (1.f / 64.f) + 1e-6f);
                    bf16_t* rp = O0 + (size_t)(row0 + ai * HALF + m * 16) * 1024 + u.pn * 256 + wc * 64 + 8 * fq;
#pragma unroll
                    for (int bj = 0; bj < 2; ++bj) *(u32x4*)(rp + 32 * bj) = pack8(acc[ai][bj][m][0] * rstd * gk[bj][0], acc[ai][bj][m][1] * rstd * gk[bj][1]);
                }
        } else if (u.pn < 8) {
#pragma unroll
            for (int ai = 0; ai < 2; ++ai)
#pragma unroll
                for (int m = 0; m < 4; ++m) {
                    bf16_t* rp = O1 + (size_t)(row0 + ai * HALF + m * 16) * 1024 + (u.pn - 4) * 256 + wc * 64 + 8 * fq;
#pragma unroll
                    for (int bj = 0; bj < 2; ++bj) {
                        f32x4 v0 = acc[ai][bj][m][0], v1 = acc[ai][bj][m][1];
                        if (MODE1 == 1) {
#pragma unroll
                            for (int j = 0; j < 4; ++j) { v0[j] = fast_sigmoid(v0[j]); v1[j] = fast_sigmoid(v1[j]); }
                        }
                        *(u32x4*)(rp + 32 * bj) = pack8(v0, v1);
                    }
                }
        } else {
            if (wc == 0 && fq < 2) {
                const f32x4 b0 = *(const f32x4*)(fbias + 8 * fq), b1 = *(const f32x4*)(fbias + 8 * fq + 4);
#pragma unroll
                for (int ai = 0; ai < 2; ++ai)
#pragma unroll
                    for (int m = 0; m < 4; ++m) {
                        f32x4 z0 = acc[ai][0][m][0] + b0, z1 = acc[ai][0][m][1] + b1;
#pragma unroll
                        for (int j = 0; j < 4; ++j) { z0[j] = fminf(z0[j], 0.f) - log1pf(__expf(-fabsf(z0[j]))); z1[j] = fminf(z1[j], 0.f) - log1pf(__expf(-fabsf(z1[j]))); }
                        float* lp = logf + (size_t)(row0 + ai * HALF + m * 16) * 16 + 8 * fq;
                        *(f32x4*)lp = z0; *(f32x4*)(lp + 4) = z1;
                    }
            }
        }
    }
};

struct OneUnit {
    Unit u;
    __device__ __forceinline__ bool next(int i, Unit& o) const { if (i) return false; o = u; return true; }
    __device__ __forceinline__ void a_ready(const Unit&) const {}
    __device__ __forceinline__ void done(const Unit&) const {}
};
template <class Epi, class Sched, bool ALIGN_EPI = false, bool SP2 = false>
__device__ __forceinline__ void gemm_phase(PG8_LAS unsigned char* lds, const Gemm g, const Sched& S, const Epi& E, const int tid) {
    const int wid = __builtin_amdgcn_readfirstlane(tid >> 6), lane = tid & 63, wr = wid >> 2, wc = wid & 3, fr = lane & 15, fq = lane >> 4;
    const int K = g.K, nt = K / BK;
    unsigned voffA[2], voffB[2];
#pragma unroll
    for (int i = 0; i < 2; ++i) { int R, C; stage_rc(tid * 16 + i * 8192, R, C); const int Rb = Epi::PERM ? ((R & ~31) + perm32(R & 31)) : R;
        voffA[i] = (unsigned)(R * K + C) * 2u; voffB[i] = (unsigned)(Rb * K + C) * 2u; }
    const size_t kstep = (size_t)(BK * 2);
    const size_t hstep = (size_t)HALF * K * 2;
    const size_t tstep = 2 * hstep;
    const unsigned ldsw = (unsigned)wid * 1024u;
    const int aoff = lds_byte(wr * 64 + fr, fq * 8), boff = lds_byte(wc * 32 + fr, fq * 8);
#define PG8_SA(b, h) (((b) * 2 + (h)) * HTB)
#define PG8_SB(b, h) ((4 + (b) * 2 + (h)) * HTB)
#define PG8_STAGE(bufoff, gbase, voff) do { _Pragma("unroll") for (int _i = 0; _i < 2; ++_i) \
        __builtin_amdgcn_global_load_lds((const unsigned*)((const char*)(gbase) + (voff)[_i]), (PG8_LAS unsigned*)(lds + (bufoff) + ldsw + _i * 8192), 16, 0, 0); } while (0)
#define PG8_LDA(dst, b, h) do { _Pragma("unroll") for (int m = 0; m < 4; ++m) _Pragma("unroll") for (int k = 0; k < 2; ++k) dst[m][k] = *(const PG8_LAS bf16x8*)(lds + PG8_SA(b, h) + aoff + m * 2048 + k * 1024); } while (0)
#define PG8_LDB(dst, b, h) do { _Pragma("unroll") for (int n = 0; n < 2; ++n) _Pragma("unroll") for (int k = 0; k < 2; ++k) dst[n][k] = *(const PG8_LAS bf16x8*)(lds + PG8_SB(b, h) + boff + n * 2048 + k * 1024); } while (0)
#define PG8_MMA(ai, bj, At, Bt) do { __builtin_amdgcn_s_setprio(1); _Pragma("unroll") for (int m = 0; m < 4; ++m) _Pragma("unroll") for (int n = 0; n < 2; ++n) _Pragma("unroll") for (int k = 0; k < 2; ++k) \
        acc[ai][bj][m][n] = __builtin_amdgcn_mfma_f32_16x16x32_bf16(Bt[n][k], At[m][k], acc[ai][bj][m][n], 0, 0, 0); __builtin_amdgcn_s_setprio(0); } while (0)
#define PG8_WAIT_V(n) asm volatile("s_waitcnt vmcnt(" #n ")" ::: "memory")
#define PG8_WAIT_L(n) asm volatile("s_waitcnt lgkmcnt(" #n ")" ::: "memory")
#define PG8_BAR __builtin_amdgcn_s_barrier()
#define PG8_SCHED __builtin_amdgcn_sched_barrier(0)
    Unit cur, nxt; int ui = 0;
    if (!S.next(0, cur)) return;
    f32x4 acc[2][2][4][2];
#pragma unroll
    for (int a = 0; a < 2; ++a)
#pragma unroll
        for (int b = 0; b < 2; ++b)
#pragma unroll
            for (int m = 0; m < 4; ++m)
#pragma unroll
                for (int n = 0; n < 2; ++n) acc[a][b][m][n] = (f32x4){0.f, 0.f, 0.f, 0.f};
    bf16x8 At[4][2], B0[2][2], B1[2][2];
    const char* cA = (const char*)g.A + (size_t)cur.pm * tstep; const char* cB = (const char*)g.Bt + (size_t)cur.pn * tstep;
    S.a_ready(cur);
    if constexpr (SP2) {
        PG8_STAGE(PG8_SB(0, 0), cB, voffB); PG8_STAGE(PG8_SB(0, 1), cB + hstep, voffB); PG8_STAGE(PG8_SA(0, 0), cA, voffA); PG8_STAGE(PG8_SA(0, 1), cA + hstep, voffA);
        if (wr == 1) PG8_BAR;
        PG8_WAIT_V(2); PG8_BAR;
        PG8_STAGE(PG8_SB(1, 0), cB + kstep, voffB); PG8_STAGE(PG8_SA(1, 0), cA + kstep, voffA); PG8_STAGE(PG8_SB(1, 1), cB + hstep + kstep, voffB);
        PG8_WAIT_V(6); PG8_BAR;
    } else {
        PG8_STAGE(PG8_SB(0, 0), cB, voffB); PG8_STAGE(PG8_SA(0, 0), cA, voffA); PG8_STAGE(PG8_SB(0, 1), cB + hstep, voffB); PG8_STAGE(PG8_SA(0, 1), cA + hstep, voffA);
        if (wr == 1) PG8_BAR;
        PG8_WAIT_V(4); PG8_BAR;
        PG8_STAGE(PG8_SB(1, 0), cB + kstep, voffB); PG8_STAGE(PG8_SA(1, 0), cA + kstep, voffA); PG8_STAGE(PG8_SB(1, 1), cB + hstep + kstep, voffB);
        PG8_WAIT_V(6); PG8_BAR;
    }
    for (;;) {
        const bool has_next = S.next(ui + 1, nxt);
        const char* nA = has_next ? (const char*)g.A + (size_t)nxt.pm * tstep : cA; const char* nB = has_next ? (const char*)g.Bt + (size_t)nxt.pn * tstep : cB;
        for (int t = 0; t < nt; t += 2) {
            const bool last = (t == nt - 2);
            const char* a1 = cA + (size_t)(t + 1) * kstep;
            const char* a2 = last ? nA : cA + (size_t)(t + 2) * kstep; const char* b2 = last ? nB : cB + (size_t)(t + 2) * kstep;
            const char* a3 = a2 + kstep; const char* b3 = b2 + kstep;
            if (last && has_next) S.a_ready(nxt);
            if constexpr (SP2) {
            PG8_LDB(B0, 0, 0); PG8_LDB(B1, 0, 1); PG8_SCHED; PG8_LDA(At, 0, 0); PG8_STAGE(PG8_SA(1, 1), a1 + hstep, voffA);
            PG8_WAIT_V(8); PG8_WAIT_L(0); PG8_BAR; PG8_MMA(0, 0, At, B0); PG8_MMA(0, 1, At, B1); PG8_BAR; PG8_SCHED;
            PG8_LDA(At, 0, 1); PG8_STAGE(PG8_SB(0, 0), b2, voffB); PG8_STAGE(PG8_SB(0, 1), b2 + hstep, voffB); PG8_STAGE(PG8_SA(0, 0), a2, voffA);
            PG8_WAIT_V(8); PG8_WAIT_L(0); PG8_BAR; PG8_MMA(1, 0, At, B0); PG8_MMA(1, 1, At, B1); PG8_BAR; PG8_SCHED;
            PG8_LDB(B0, 1, 0); PG8_LDB(B1, 1, 1); PG8_SCHED; PG8_LDA(At, 1, 0); PG8_STAGE(PG8_SA(0, 1), a2 + hstep, voffA);
            PG8_WAIT_V(8); PG8_WAIT_L(0); PG8_BAR; PG8_MMA(0, 0, At, B0); PG8_MMA(0, 1, At, B1); PG8_BAR; PG8_SCHED;
            PG8_LDA(At, 1, 1); PG8_STAGE(PG8_SB(1, 0), b3, voffB); PG8_STAGE(PG8_SB(1, 1), b3 + hstep, voffB); PG8_STAGE(PG8_SA(1, 0), a3, voffA);
            PG8_WAIT_V(8); PG8_WAIT_L(0); PG8_BAR; PG8_MMA(1, 0, At, B0); PG8_MMA(1, 1, At, B1); PG8_BAR; PG8_SCHED;
            if constexpr (Epi::KHOOK) { if ((((t + 2) & 7) == 0) && (t + 2 < nt)) E.khook(acc, ((t + 2) >> 3) - 1, wr, fr); }
            } else {
            PG8_LDB(B0, 0, 0); PG8_SCHED; PG8_LDA(At, 0, 0); PG8_STAGE(PG8_SA(1, 1), a1 + hstep, voffA);
            PG8_WAIT_L(8); PG8_BAR; PG8_WAIT_L(0); PG8_MMA(0, 0, At, B0); PG8_BAR; PG8_SCHED;
            PG8_LDB(B1, 0, 1); PG8_STAGE(PG8_SB(0, 0), b2, voffB);
            PG8_BAR; PG8_WAIT_L(0); PG8_MMA(0, 1, At, B1); PG8_BAR;
            PG8_LDA(At, 0, 1); PG8_STAGE(PG8_SA(0, 0), a2, voffA);
            PG8_BAR; PG8_WAIT_L(0); PG8_MMA(1, 0, At, B0); PG8_BAR; PG8_SCHED;
            PG8_STAGE(PG8_SB(0, 1), b2 + hstep, voffB);
            PG8_WAIT_V(6); PG8_BAR; PG8_MMA(1, 1, At, B1); PG8_BAR;
            PG8_LDB(B0, 1, 0); PG8_SCHED; PG8_LDA(At, 1, 0); PG8_STAGE(PG8_SA(0, 1), a2 + hstep, voffA);
            PG8_WAIT_L(8); PG8_BAR; PG8_WAIT_L(0); PG8_MMA(0, 0, At, B0); PG8_BAR; PG8_SCHED;
            PG8_LDB(B1, 1, 1); PG8_STAGE(PG8_SB(1, 0), b3, voffB);
            PG8_BAR; PG8_WAIT_L(0); PG8_MMA(0, 1, At, B1); PG8_BAR;
            PG8_LDA(At, 1, 1); PG8_STAGE(PG8_SA(1, 0), a3, voffA);
            PG8_BAR; PG8_WAIT_L(0); PG8_MMA(1, 0, At, B0); PG8_BAR; PG8_SCHED;
            PG8_STAGE(PG8_SB(1, 1), b3 + hstep, voffB);
            PG8_WAIT_V(6); PG8_BAR; PG8_MMA(1, 1, At, B1); PG8_BAR;
            }
        }
        if constexpr (ALIGN_EPI) { if (wr == 0) PG8_BAR; }
        if constexpr (!Epi::AFTER_DRAIN) { E(acc, cur, wr, wc, fr, fq); S.done(cur); }
        if (!has_next) break;
#pragma unroll
        for (int a = 0; a < 2; ++a)
#pragma unroll
            for (int b = 0; b < 2; ++b)
#pragma unroll
                for (int m = 0; m < 4; ++m)
#pragma unroll
                    for (int n = 0; n < 2; ++n) acc[a][b][m][n] = (f32x4){0.f, 0.f, 0.f, 0.f};
        cur = nxt; cA = nA; cB = nB; ++ui;
        if constexpr (ALIGN_EPI) { if (wr == 1) PG8_BAR; }
    }
    PG8_WAIT_V(0);
    if constexpr (!ALIGN_EPI) { if (wr == 0) PG8_BAR; }
    PG8_BAR;
    if constexpr (Epi::AFTER_DRAIN) { E.fused(acc, cur, wr, wc, fr, fq, lds, wid, lane); S.done(cur); }
#undef PG8_SA
#undef PG8_SB
#undef PG8_STAGE
#undef PG8_LDA
#undef PG8_LDB
#undef PG8_MMA
#undef PG8_WAIT_V
#undef PG8_WAIT_L
#undef PG8_BAR
#undef PG8_SCHED
}
}

using pg8::bf16_t; using pg8::bf16x8; using pg8::f32x4; using pg8::u32x4; using pg8::u32x2; using pg8::cvt_pk_bf16;
#define LAS __attribute__((address_space(3)))
typedef float f32x16 __attribute__((ext_vector_type(16)));
typedef short s16x4 __attribute__((ext_vector_type(4)));

constexpr int BATCH = 8, SEQ = 2048, D = 1024, M = BATCH * SEQ, FF = 4096;
constexpr int RH = 4, RDK = 256, RDV = 512, RVW = RH * RDV, RIN = 6144, RC = 128, NCH = SEQ / RC;
constexpr int FH = 16, FD = 64;
constexpr int ADA_LD = 14336;
constexpr float EPS = 1e-6f;
constexpr float LOG2E = 1.4426950408889634f;
constexpr float QSCALE = 0.125f * LOG2E;

constexpr size_t MiB = 1u << 20;
constexpr size_t WS_ADA = 1 * MiB, WS_LOGF = 2 * MiB, WS_SSQ = 4 * MiB;
constexpr size_t WS_SSQ2 = 3 * MiB;
constexpr size_t WS_BIAS2 = 1 * MiB + 512 * 1024;
constexpr size_t B2_MLP0 = 0, B2_MLP1 = 8 * 4096, B2_KV = 16 * 4096, B2_FOX = 16 * 4096 + 8 * 2304;
constexpr size_t WS_WRIN = 8 * MiB, WS_WROUT = 20 * MiB, WS_WM1_0 = 24 * MiB;
constexpr size_t WS_TAB = 32 * MiB;
constexpr size_t WS_HKV = 8 * MiB;
constexpr size_t WS_WM2_0 = 48 * MiB, WS_WM1_1 = 56 * MiB, WS_WM2_1 = 64 * MiB, WS_WKV = 72 * MiB, WS_WFIN = 77 * MiB, WS_WFOUT = 81 * MiB;
constexpr size_t WS_HN = 83 * MiB;
constexpr size_t WS_BIG = 115 * MiB;
constexpr size_t WS_END = 243 * MiB;

constexpr int LDS_BYTES = 155648;
constexpr int RING_BYTES = 131072;
constexpr int RTAB_OFF = 132096;
constexpr int WSCR_OFF = 136192;
constexpr int XBST_OFF = LDS_BYTES - 64;
constexpr size_t WS_CTL = 0, CTL_ZERO_BYTES = 16384;

__device__ __forceinline__ float bf2f(unsigned b) { return __uint_as_float(b << 16); }
__device__ __forceinline__ unsigned f2bf(float f) { unsigned u = __float_as_uint(f); return (u + 0x7fffu + ((u >> 16) & 1u)) >> 16; }
__device__ __forceinline__ unsigned pk2(float lo, float hi) { return f2bf(lo) | (f2bf(hi) << 16); }
__device__ __forceinline__ float wave_sum(float v) {
#pragma unroll
    for (int o = 1; o < 64; o <<= 1) v += __shfl_xor(v, o);
    return v;
}
#define LDS_WAIT() asm volatile("s_waitcnt lgkmcnt(0)" ::: "memory")

struct Args {
    const float* x; const float* c; const int* pos;
    const float *nmg, *nlg, *w_ada, *b_ada, *w_mlp_in, *w_mlp_out, *ret_w_in, *ret_ng, *ret_w_out, *kv_ng, *kv_w_ada, *kv_b_ada, *kv_w, *fbias, *k_ng, *fox_w_in, *q_ng, *fox_w_out;
    float* out; unsigned char* ws;
};

__device__ __forceinline__ int perm_row(int n) { return (n & ~255) + 128 * ((n >> 5) & 1) + 32 * ((n >> 6) & 3) + (n & 31); }
struct TDesc { const float* W; int ldw, K, nblk; bf16_t* WT; int permute, r; };
__device__ __forceinline__ void transpose_load(const TDesc& d, f32x4 (&wv)[16], int lane) {
    const int kb = d.r / d.nblk, nb = d.r % d.nblk;
    const float* wp = d.W + (size_t)(64 * kb + (lane >> 4)) * d.ldw + 64 * nb + 4 * (lane & 15);
#pragma unroll
    for (int i = 0; i < 16; ++i) wv[i] = __builtin_nontemporal_load((const f32x4*)(wp + (size_t)(4 * i) * d.ldw));
}
__device__ __forceinline__ void transpose_to_lds(const f32x4 (&wv)[16], LAS float* scr, int lane) {
#pragma unroll
    for (int i = 0; i < 16; ++i) { LAS float* sp = scr + (4 * i + (lane >> 4)) * 65 + 4 * (lane & 15); sp[0] = wv[i][0]; sp[1] = wv[i][1]; sp[2] = wv[i][2]; sp[3] = wv[i][3]; }
    LDS_WAIT(); asm volatile("" ::: "memory");
}
__device__ __forceinline__ void transpose_store(const TDesc& d, LAS float* scr, int lane) {
    const int kb = d.r / d.nblk, nb = d.r % d.nblk, k0 = 64 * kb, n0 = 64 * nb;
    const int c = lane & 7;
#pragma unroll
    for (int j = 0; j < 8; ++j) { const int n = (lane >> 3) + 8 * j; const LAS float* s = scr + (8 * c) * 65 + n;
        u32x4 o; o.x = pk2(s[0 * 65], s[1 * 65]); o.y = pk2(s[2 * 65], s[3 * 65]); o.z = pk2(s[4 * 65], s[5 * 65]); o.w = pk2(s[6 * 65], s[7 * 65]);
        const int r = d.permute ? perm_row(n0 + n) : n0 + n;
        *(u32x4*)(d.WT + (size_t)r * d.K + k0 + 8 * c) = o; }
    LDS_WAIT(); asm volatile("" ::: "memory");
}

__device__ __forceinline__ void phase0(const Args& a, LAS unsigned char* lds, int tid, int lane, int wave) {
    unsigned char* ws = a.ws;
    const int G = gridDim.x, bx = blockIdx.x;
    LAS float* cact = (LAS float*)lds;
    LAS float* red = (LAS float*)(lds + 32768);
    float* ADA = (float*)(ws + WS_ADA);
    for (int it = bx; it < ADA_LD / 64; it += G) {
        __syncthreads();
        for (int i = tid; i < BATCH * D; i += 512) { const int b = i >> 10, k = i & 1023; const float v = a.c[i]; cact[k * 8 + b] = v * pg8::fast_sigmoid(v); }
        __syncthreads();
        const int n0 = it * 64;
        const float* W; const float* bias; int ldw, nn;
        if (n0 < 6144) { W = a.w_ada; bias = a.b_ada; ldw = 6144; nn = n0; }
        else if (n0 < 12288) { W = a.w_ada + (size_t)D * 6144; bias = a.b_ada + 6144; ldw = 6144; nn = n0 - 6144; }
        else { W = a.kv_w_ada; bias = a.kv_b_ada; ldw = 2048; nn = n0 - 12288; }
        float acc[8];
#pragma unroll
        for (int b = 0; b < 8; ++b) acc[b] = 0.f;
        const float* wp = W + (size_t)(wave * 128) * ldw + nn + lane;
        for (int kb = 0; kb < 128; kb += 16) {
            float wv[16];
#pragma unroll
            for (int i = 0; i < 16; ++i) wv[i] = __builtin_nontemporal_load(wp + (size_t)(kb + i) * ldw);
            __builtin_amdgcn_sched_barrier(0);
#pragma unroll
            for (int i = 0; i < 16; ++i) {
                const float w = wv[i];
                const f32x4 c0 = *(const LAS f32x4*)(cact + (wave * 128 + kb + i) * 8), c1 = *(const LAS f32x4*)(cact + (wave * 128 + kb + i) * 8 + 4);
                acc[0] += c0[0] * w; acc[1] += c0[1] * w; acc[2] += c0[2] * w; acc[3] += c0[3] * w;
                acc[4] += c1[0] * w; acc[5] += c1[1] * w; acc[6] += c1[2] * w; acc[7] += c1[3] * w;
            }
            __builtin_amdgcn_sched_barrier(0);
        }
#pragma unroll
        for (int b = 0; b < 8; ++b) red[(wave * 8 + b) * 64 + lane] = acc[b];
        __syncthreads();
        { const int b = tid >> 6; float s = bias[nn + lane];
#pragma unroll
          for (int w = 0; w < 8; ++w) s += red[(w * 8 + b) * 64 + lane];
          ADA[(size_t)b * ADA_LD + n0 + lane] = s; }
    }
    __syncthreads();
    {
        LAS float* scr = (LAS float*)(lds + wave * 16640);
        const int gw = bx * 8 + wave, NGW = G * 8;
        constexpr int I0 = 16 * 96, I1 = 32 * 16, I2 = 16 * 64, I3 = 64 * 16, I4 = 16 * 32, I5 = 16 * 32, I6 = 16 * 16;
        constexpr int NITEMS = I0 + I1 + 2 * I2 + 2 * I3 + I4 + I5 + I6;
        auto desc = [&](int it) -> TDesc {
            int r = it;
            if (r < I0) return TDesc{a.ret_w_in, RIN, D, 96, (bf16_t*)(ws + WS_WRIN), 0, r}; r -= I0;
            if (r < I1) return TDesc{a.ret_w_out, D, RVW, 16, (bf16_t*)(ws + WS_WROUT), 0, r}; r -= I1;
            if (r < I2) return TDesc{a.w_mlp_in, FF, D, 64, (bf16_t*)(ws + WS_WM1_0), 0, r}; r -= I2;
            if (r < I2) return TDesc{a.w_mlp_in + (size_t)D * FF, FF, D, 64, (bf16_t*)(ws + WS_WM1_1), 0, r}; r -= I2;
            if (r < I3) return TDesc{a.w_mlp_out, D, FF, 16, (bf16_t*)(ws + WS_WM2_0), 0, r}; r -= I3;
            if (r < I3) return TDesc{a.w_mlp_out + (size_t)FF * D, D, FF, 16, (bf16_t*)(ws + WS_WM2_1), 0, r}; r -= I3;
            if (r < I4) return TDesc{a.kv_w, 2 * D + FH, D, 32, (bf16_t*)(ws + WS_WKV), 1, r}; r -= I4;
            if (r < I5) return TDesc{a.fox_w_in, 2 * D, D, 32, (bf16_t*)(ws + WS_WFIN), 1, r}; r -= I5;
            return TDesc{a.fox_w_out, D, D, 16, (bf16_t*)(ws + WS_WFOUT), 0, r};
        };
        f32x4 wv[16];
        int it = gw;
        TDesc cur{}; if (it < NITEMS) { cur = desc(it); transpose_load(cur, wv, lane); }
        while (it < NITEMS) {
            transpose_to_lds(wv, scr, lane);
            const int nx = it + NGW; TDesc nd{};
            if (nx < NITEMS) { nd = desc(nx); transpose_load(nd, wv, lane); }
            transpose_store(cur, scr, lane);
            cur = nd; it = nx;
        }
    }
    const int gt = bx * 512 + tid, NT = G * 512;
    {
        bf16_t* wkv = (bf16_t*)(ws + WS_WKV) + (size_t)2048 * D;
        for (int i = gt; i < 256 * (D / 8); i += NT) {
            const int row = i >> 7, c8 = i & 127; u32x4 o = (u32x4){0u, 0u, 0u, 0u};
            if (row < FH) { float v[8];
#pragma unroll
                for (int e = 0; e < 8; ++e) v[e] = a.kv_w[(size_t)(8 * c8 + e) * (2 * D + FH) + 2 * D + row];
                o.x = pk2(v[0], v[1]); o.y = pk2(v[2], v[3]); o.z = pk2(v[4], v[5]); o.w = pk2(v[6], v[7]); }
            *(u32x4*)(wkv + (size_t)row * D + 8 * c8) = o;
        }
    }
    {
        float* tab = (float*)(ws + WS_TAB);
        const int i = gt & 127;
        double invf = 1.0; { const double r = 0.93057204092969897;
            for (int k = 0; k < i; ++k) invf *= r; }
        for (int idx0 = gt; idx0 < M * 128; idx0 += 16 * NT) {
            int pv[16];
#pragma unroll
            for (int k = 0; k < 16; ++k) { const int idx = idx0 + k * NT; pv[k] = (idx < M * 128) ? a.pos[idx >> 7] : 0; }
#pragma unroll
            for (int k = 0; k < 16; ++k) { const int idx = idx0 + k * NT;
                if (idx < M * 128) {
                    double rev = (double)pv[k] * invf * 0.15915494309189535; rev -= floor(rev);
                    const float rf = (float)rev;
                    *(pg8::f32x2*)(tab + (size_t)idx * 2) = (pg8::f32x2){__builtin_amdgcn_cosf(rf), __builtin_amdgcn_sinf(rf)}; } }
        }
    }
}

__device__ __forceinline__ void norm_rows(const float* xs, const float* gain, const float* shift, const float* scale, bf16_t* out, int lane, int wave) {
    const int gw = blockIdx.x * 8 + wave, NGW = gridDim.x * 8;
    const int per = (M + NGW - 1) / NGW, r0 = gw * per, r1 = (r0 + per < M) ? r0 + per : M;
    if (r0 >= r1) return;
    f32x4 gs[4], sh[4]; int bcur = -1;
    f32x4 vn[4];
    { const f32x4* xr = (const f32x4*)(xs + (size_t)r0 * D) + lane;
#pragma unroll
      for (int j = 0; j < 4; ++j) vn[j] = __builtin_nontemporal_load(xr + 64 * j); }
    for (int row = r0; row < r1; ++row) {
        f32x4 v[4];
#pragma unroll
        for (int j = 0; j < 4; ++j) v[j] = vn[j];
        if (row + 1 < r1) { const f32x4* xr = (const f32x4*)(xs + (size_t)(row + 1) * D) + lane;
#pragma unroll
            for (int j = 0; j < 4; ++j) vn[j] = __builtin_nontemporal_load(xr + 64 * j); }
        const int b = row >> 11;
        if (b != bcur) { bcur = b;
#pragma unroll
            for (int j = 0; j < 4; ++j) { const int col = 4 * lane + 256 * j;
                gs[j] = *(const f32x4*)(gain + col) * (*(const f32x4*)(scale + (size_t)b * ADA_LD + col) + 1.f); sh[j] = *(const f32x4*)(shift + (size_t)b * ADA_LD + col); } }
        float ss = 0.f;
#pragma unroll
        for (int j = 0; j < 4; ++j) ss += (v[j][0] * v[j][0] + v[j][1] * v[j][1]) + (v[j][2] * v[j][2] + v[j][3] * v[j][3]);
        const float rstd = rsqrtf(wave_sum(ss) * (1.f / D) + EPS);
#pragma unroll
        for (int j = 0; j < 4; ++j) {
            const f32x4 o = v[j] * rstd * gs[j] + sh[j];
            u32x2 w; w.x = cvt_pk_bf16(o[0], o[1]); w.y = cvt_pk_bf16(o[2], o[3]);
            *(u32x2*)(out + (size_t)row * D + 4 * lane + 256 * j) = w;
        }
    }
}

__device__ __forceinline__ void bias2_rows(const bf16_t* Wt, int nrows, const float* shift  , float* out, int out_ld, int lane, int wave) {
    const int gw = blockIdx.x * 8 + wave, NGW = gridDim.x * 8;
    if (gw >= nrows) return;
    float sh[8][16];
#pragma unroll
    for (int b = 0; b < 8; ++b)
#pragma unroll
        for (int q = 0; q < 4; ++q) { const f32x4 v = *(const f32x4*)(shift + (size_t)b * ADA_LD + 16 * lane + 4 * q); sh[b][4 * q] = v[0]; sh[b][4 * q + 1] = v[1]; sh[b][4 * q + 2] = v[2]; sh[b][4 * q + 3] = v[3]; }
    u32x4 n0 = *(const u32x4*)(Wt + (size_t)gw * D + 16 * lane), n1 = *(const u32x4*)(Wt + (size_t)gw * D + 16 * lane + 8);
    for (int r = gw; r < nrows; r += NGW) {
        const u32x4 w0 = n0, w1 = n1;
        if (r + NGW < nrows) { n0 = *(const u32x4*)(Wt + (size_t)(r + NGW) * D + 16 * lane); n1 = *(const u32x4*)(Wt + (size_t)(r + NGW) * D + 16 * lane + 8); }
        const unsigned ww[8] = {w0.x, w0.y, w0.z, w0.w, w1.x, w1.y, w1.z, w1.w};
        float wf[16];
#pragma unroll
        for (int i = 0; i < 8; ++i) { wf[2 * i] = bf2f(ww[i] & 0xffffu); wf[2 * i + 1] = bf2f(ww[i] >> 16); }
        float res = 0.f;
#pragma unroll
        for (int b = 0; b < 8; ++b) { float s = 0.f;
#pragma unroll
            for (int i = 0; i < 16; ++i) s += sh[b][i] * wf[i];
            s = wave_sum(s); if (lane == b) res = s; }
        if (lane < 8) out[(size_t)lane * out_ld + r] = res;
    }
}

__device__ __forceinline__ void logf_rows(const bf16_t* HKV, const bf16_t* Wf, const float* ssq2, const float* bias, int bias_ld, const float* fbias, float* logf, LAS unsigned char* lds, int tid, int lane, int w) {
    const int r32 = lane & 31, hh = lane >> 5;
    LAS float* part = (LAS float*)lds;
    for (int rt = blockIdx.x; rt < M / 64; rt += gridDim.x) {
        const size_t row0 = (size_t)rt * 64;
        f32x16 acc[2];
#pragma unroll
        for (int i = 0; i < 16; ++i) { acc[0][i] = 0.f; acc[1][i] = 0.f; }
        const bf16_t* ap = HKV + (row0 + r32) * 1024 + 128 * w + 8 * hh;
        const bf16_t* bp = Wf + (size_t)r32 * 1024 + 128 * w + 8 * hh;
#pragma unroll
        for (int ks = 0; ks < 8; ++ks) { const bf16x8 bf = *(const bf16x8*)(bp + 16 * ks);
#pragma unroll
            for (int rb = 0; rb < 2; ++rb) { const bf16x8 af = *(const bf16x8*)(ap + (size_t)rb * 32 * 1024 + 16 * ks); acc[rb] = __builtin_amdgcn_mfma_f32_32x32x16_bf16(af, bf, acc[rb], 0, 0, 0); } }
        __syncthreads();
        if (r32 < 16) {
#pragma unroll
            for (int rb = 0; rb < 2; ++rb)
#pragma unroll
                for (int i = 0; i < 16; ++i) part[(w * 64 + 32 * rb + (i & 3) + 8 * (i >> 2) + 4 * hh) * 16 + r32] = acc[rb][i];
        }
        __syncthreads();
        for (int o = tid; o < 1024; o += 512) {
            const int row = o >> 4, hd = o & 15;
            float s = 0.f;
#pragma unroll
            for (int ww = 0; ww < 8; ++ww) s += part[(ww * 64 + row) * 16 + hd];
            const f32x4* sp = (const f32x4*)(ssq2 + (row0 + row) * 16); const f32x4 a = sp[0], b = sp[1], c = sp[2], d = sp[3];
            const float q = ((a[0] + a[1]) + (a[2] + a[3])) + ((b[0] + b[1]) + (b[2] + b[3])) + ((c[0] + c[1]) + (c[2] + c[3])) + ((d[0] + d[1]) + (d[2] + d[3]));
            const float z = s * rsqrtf(q * (1.f / 1024.f) + EPS) + bias[(row0 >> 11) * bias_ld + hd] + fbias[hd];
            logf[(row0 + row) * 16 + hd] = fminf(z, 0.f) - log1pf(__expf(-fabsf(z)));
        }
    }
    __syncthreads();
}

#ifndef RET_PREF_K
#define RET_PREF_K 1
#endif
namespace ret {
constexpr int KP = 528, VP = 272, PP = 272, RP = 528;
constexpr int L_KC = 0, L_VT = 128 * KP, L_PS = L_VT + 64 * VP, L_RB = L_PS + 128 * PP, L_DEC = L_RB + 64 * RP, L_END = L_DEC + 1024;
static_assert(L_END <= XBST_OFF, "retention LDS");
__device__ __forceinline__ s16x4 tr_read(const LAS unsigned char* p) { return __builtin_bit_cast(s16x4, __builtin_amdgcn_ds_read_tr16_b64_v4i16((LAS s16x4*)p)); }

template <int CTRL, int RMASK> __device__ __forceinline__ float dpp_add(float v) { return v + __int_as_float(__builtin_amdgcn_update_dpp(0, __float_as_int(v), CTRL, RMASK, 0xf, true)); }
__device__ __forceinline__ float half_sum_hi(float v) { v = dpp_add<0x111, 0xf>(v); v = dpp_add<0x112, 0xf>(v); v = dpp_add<0x114, 0xf>(v); v = dpp_add<0x118, 0xf>(v); return dpp_add<0x142, 0xa>(v); }

__device__ __forceinline__ void unit(const bf16_t* Q, const bf16_t* Kr, const bf16_t* V, bf16_t* G, float* SSQ, const float* rgain, int b, int h, int vs, LAS unsigned char* lds, int tid, int lane, int w, bool dry = false) {
    const int r32 = lane & 31, hh = lane >> 5, rb = w & 3, cx = w >> 2;
    const float gam = 1.f - exp2f(-5.f - (float)h), lg = log2f(gam), gC = exp2f(128.f * lg);
    LAS float* kd = (LAS float*)(lds + L_DEC);
    LAS float* rs1 = (LAS float*)(lds + L_DEC + 512);
    __syncthreads();
    if (tid < 128) { kd[tid] = exp2f((float)(127 - tid) * lg); rs1[tid] = exp2f((float)(tid - 127) * lg); }
    f32x16 racc[2];
#pragma unroll
    for (int i = 0; i < 16; ++i) { racc[0][i] = 0.f; racc[1][i] = 0.f; }
    const int col = h * RDV + vs * 64 + cx * 32 + r32;
    const float gn = rgain[col];
    const int trrow = 8 * (lane >> 5) + ((lane & 15) >> 2), trcol = 16 * ((lane >> 4) & 1) + 4 * (lane & 3);
    const size_t row0 = (size_t)b * SEQ;
    const bf16_t* kg = Kr + (row0 + (tid >> 5)) * 1024 + h * RDK + 8 * (tid & 31);
    const bf16_t* vg = V + ((size_t)((b * 4 + h) * 8 + vs) * 16) * 8192 + (size_t)(tid >> 7) * 1024 + (tid & 127) * 8;
    const bf16_t* qg = Q + ((size_t)(b * 4 + h) * 64 + rb) * 8192 + hh * 256 + r32 * 8;
    u32x4 kreg[8], vreg[2]; bf16x8 qf[16];
#pragma unroll
    for (int i = 0; i < 8; ++i) kreg[i] = *(const u32x4*)(kg + (size_t)(16 * i) * 1024);
#pragma unroll
    for (int i = 0; i < 2; ++i) vreg[i] = __builtin_nontemporal_load((const u32x4*)(vg + (size_t)(4 * i) * 1024));
#pragma unroll
    for (int ks = 0; ks < 16; ++ks) qf[ks] = *(const bf16x8*)(qg + 512 * ks);
    for (int ch = 0; ch < NCH; ++ch) {
        const size_t rowbase = row0 + (size_t)ch * RC;
        const bool more = ch + 1 < NCH;
        __syncthreads();
#if !RET_PREF_K
        if (ch > 0) {
#pragma unroll
            for (int i = 0; i < 8; ++i) kreg[i] = *(const u32x4*)(kg + (size_t)(ch * RC + 16 * i) * 1024);
#pragma unroll
            for (int i = 0; i < 2; ++i) vreg[i] = *(const u32x4*)(vg + (size_t)(ch * RC + 64 * i) * RVW);
        }
#endif
#pragma unroll
        for (int i = 0; i < 8; ++i) *(LAS u32x4*)(lds + L_KC + ((tid >> 5) + 16 * i) * KP + 16 * (tid & 31)) = kreg[i];
#pragma unroll
        for (int i = 0; i < 2; ++i) { const int tok = tid & 127, c8 = (tid >> 7) + 4 * i;
            const unsigned wv[4] = {vreg[i].x, vreg[i].y, vreg[i].z, vreg[i].w};
#pragma unroll
            for (int e = 0; e < 4; ++e) {
                *(LAS unsigned short*)(lds + L_VT + (8 * c8 + 2 * e) * VP + tok * 2) = (unsigned short)(wv[e] & 0xffffu);
                *(LAS unsigned short*)(lds + L_VT + (8 * c8 + 2 * e + 1) * VP + tok * 2) = (unsigned short)(wv[e] >> 16);
            } }
#pragma unroll
        for (int vt = 0; vt < 2; ++vt) {
#pragma unroll
            for (int i = 0; i < 16; ++i) racc[vt][i] *= gC;
#pragma unroll
            for (int g = 0; g < 4; ++g) { u32x2 o; o.x = cvt_pk_bf16(racc[vt][4 * g], racc[vt][4 * g + 1]); o.y = cvt_pk_bf16(racc[vt][4 * g + 2], racc[vt][4 * g + 3]);
                *(LAS u32x2*)(lds + L_RB + (32 * vt + r32) * RP + (32 * w + 8 * g + 4 * hh) * 2) = o; }
        }
#if RET_PREF_K
        if (more) {
#pragma unroll
            for (int i = 0; i < 8; ++i) kreg[i] = *(const u32x4*)(kg + (size_t)((ch + 1) * RC + 16 * i) * 1024);
#pragma unroll
            for (int i = 0; i < 2; ++i) vreg[i] = __builtin_nontemporal_load((const u32x4*)(vg + (size_t)(ch + 1) * 8192 + (size_t)(4 * i) * 1024));
        }
#endif
        __syncthreads();
        __builtin_amdgcn_sched_barrier(0);
#pragma unroll
        for (int t = 0; t < 2; ++t) {
            const int cb = 2 * cx + t;
            if (cb <= rb) {
                f32x16 s;
#pragma unroll
                for (int i = 0; i < 16; ++i) s[i] = 0.f;
                const LAS unsigned char* kp = lds + L_KC + (32 * cb + r32) * KP + 16 * hh;
#pragma unroll
                for (int ks = 0; ks < 16; ++ks) { const bf16x8 kf = *(const LAS bf16x8*)(kp + 32 * ks); s = __builtin_amdgcn_mfma_f32_32x32x16_bf16(kf, qf[ks], s, 0, 0, 0); }
                if (cb == rb) {
#pragma unroll
                    for (int i = 0; i < 16; ++i) { const int key = (i & 3) + 8 * (i >> 2) + 4 * hh; if (key > r32) s[i] = 0.f; }
                }
#pragma unroll
                for (int g = 0; g < 4; ++g) { u32x2 o; o.x = cvt_pk_bf16(s[4 * g], s[4 * g + 1]); o.y = cvt_pk_bf16(s[4 * g + 2], s[4 * g + 3]);
                    *(LAS u32x2*)(lds + L_PS + (32 * rb + r32) * PP + (32 * cb + 8 * g + 4 * hh) * 2) = o; }
            }
        }
        __syncthreads();
        f32x16 o;
#pragma unroll
        for (int i = 0; i < 16; ++i) o[i] = 0.f;
        { const LAS unsigned char* rp = lds + L_RB + (32 * cx + r32) * RP + 16 * hh;
#pragma unroll
          for (int ks = 0; ks < 16; ++ks) { const bf16x8 rf = *(const LAS bf16x8*)(rp + 32 * ks); o = __builtin_amdgcn_mfma_f32_32x32x16_bf16(qf[ks], rf, o, 0, 0, 0); } }
        __builtin_amdgcn_sched_barrier(0);
        if (more) {
#pragma unroll
            for (int ks = 0; ks < 16; ++ks) qf[ks] = *(const bf16x8*)(qg + (size_t)(ch + 1) * 4 * 8192 + 512 * ks);
        }
        __builtin_amdgcn_sched_barrier(0);
        { const LAS unsigned char* pp = lds + L_PS + (32 * rb + r32) * PP + 16 * hh;
          const LAS unsigned char* vp = lds + L_VT + (32 * cx + r32) * VP + 16 * hh;
          const int nks = 2 * (rb + 1);
          for (int ks = 0; ks < nks; ++ks) { const bf16x8 pf = *(const LAS bf16x8*)(pp + 32 * ks), vf = *(const LAS bf16x8*)(vp + 32 * ks); o = __builtin_amdgcn_mfma_f32_32x32x16_bf16(pf, vf, o, 0, 0, 0); } }
#pragma unroll
        for (int ks = 0; ks < 8; ++ks) {
            const LAS unsigned char* kt = lds + L_KC + (16 * ks + trrow) * KP + (32 * w + trcol) * 2;
            const s16x4 lo = tr_read(kt), hi = tr_read(kt + 4 * KP);
            const bf16x8 af = (bf16x8){lo[0], lo[1], lo[2], lo[3], hi[0], hi[1], hi[2], hi[3]};
#pragma unroll
            for (int vt = 0; vt < 2; ++vt) { const bf16x8 vf = *(const LAS bf16x8*)(lds + L_VT + (32 * vt + r32) * VP + (16 * ks + 8 * hh) * 2);
                racc[vt] = __builtin_amdgcn_mfma_f32_32x32x16_bf16(af, vf, racc[vt], 0, 0, 0); }
        }
#pragma unroll
        for (int gb = 0; gb < 2; ++gb) {
            unsigned gz[8];
#pragma unroll
            for (int i = 0; i < 8; ++i) gz[i] = (unsigned)G[(rowbase + 32 * rb + (i & 3) + 8 * (2 * gb + (i >> 2)) + 4 * hh) * RVW + col];
#pragma unroll
            for (int g2 = 0; g2 < 2; ++g2) {
                const int g = 2 * gb + g2;
                const f32x4 rs = *(const LAS f32x4*)(rs1 + 32 * rb + 8 * g + 4 * hh);
#pragma unroll
                for (int j = 0; j < 4; ++j) {
                    const int q = 32 * rb + 8 * g + 4 * hh + j;
                    const float y = o[4 * g + j] * rs[j];
                    const float sq = half_sum_hi(y * y);
                    if (r32 == 31 && !dry) SSQ[(rowbase + q) * 64 + h * 16 + vs * 2 + cx] = sq;
                    const bf16_t ov = (bf16_t)f2bf(y * bf2f(gz[4 * g2 + j]) * gn);
                    if (!dry) G[(rowbase + q) * RVW + col] = ov;
                }
            }
        }
    }
}
}

namespace fox {
constexpr int TP = 144;
constexpr int L_K = 0, L_V = 2 * 128 * TP, L_KB = 4 * 128 * TP, L_WS = L_KB + SEQ * 4, L_SC = L_WS + 8 * 32 * 4, L_END = L_SC + 96;
__device__ __forceinline__ int crow(int r, int hi) { return (r & 3) + 8 * (r >> 2) + 4 * hi; }

__device__ __forceinline__ void prep(const float* logf, int b, int h, LAS unsigned char* lds, int tid, int lane, int w) {
    const size_t rowbase = (size_t)b * SEQ;
    LAS float* kb2 = (LAS float*)(lds + L_KB);
    LAS float* wsum = (LAS float*)(lds + L_SC);
    __syncthreads();
    float a[4];
#pragma unroll
    for (int i = 0; i < 4; ++i) a[i] = logf[(rowbase + 4 * tid + i) * 16 + h];
    a[1] += a[0]; a[2] += a[1]; a[3] += a[2];
    float x = a[3];
#pragma unroll
    for (int off = 1; off < 64; off <<= 1) { const float t = __shfl_up(x, off); if (lane >= off) x += t; }
    if (lane == 63) wsum[w] = x;
    __syncthreads();
    float pre = 0.f;
    for (int i = 0; i < w; ++i) pre += wsum[i];
    const float ex = pre + x - a[3];
    *(LAS f32x4*)(kb2 + 4 * tid) = (f32x4){-LOG2E * (ex + a[0]), -LOG2E * (ex + a[1]), -LOG2E * (ex + a[2]), -LOG2E * (ex + a[3])};
    __syncthreads();
}

__device__ __forceinline__ void unit(bf16_t* QY, const bf16_t* K, const bf16_t* V, const bf16_t* OG, float qk_bound, int b, int h, int qb, LAS unsigned char* lds, int tid, int lane, int w, bool dry = false) {
    const int r32 = lane & 31, hh = lane >> 5;
    const size_t rowbase = (size_t)b * SEQ; const int q0 = qb * 256;
    LAS float* kb2 = (LAS float*)(lds + L_KB);
    LAS float* wsf = (LAS float*)(lds + L_WS) + w * 32;
    LAS unsigned* flags = (LAS unsigned*)(lds + L_SC + 32);
    __syncthreads();
    bf16x8 qr[4];
    { const bf16_t* qp = QY + (rowbase + q0 + 32 * w + r32) * 1024 + h * FD + 8 * hh;
#pragma unroll
      for (int ks = 0; ks < 4; ++ks) qr[ks] = *(const bf16x8*)(qp + 16 * ks); }
    const int NT = 4 * (qb + 1), NP = NT / 2;
    const int srow = tid >> 3, sc8 = tid & 7;
    const bf16_t* kg = K + (rowbase + srow) * 1024 + h * FD + 8 * sc8;
    const bf16_t* vg = V + (rowbase + srow) * 1024 + h * FD + 8 * sc8;
    u32x4 kreg[2], vreg[2];
#pragma unroll
    for (int i = 0; i < 2; ++i) { kreg[i] = *(const u32x4*)(kg + (size_t)((NP - 1) * 128 + 64 * i) * 1024); vreg[i] = *(const u32x4*)(vg + (size_t)((NP - 1) * 128 + 64 * i) * 1024); }
#pragma unroll
    for (int i = 0; i < 2; ++i) { *(LAS u32x4*)(lds + L_K + (srow + 64 * i) * TP + 16 * sc8) = kreg[i]; *(LAS u32x4*)(lds + L_V + (srow + 64 * i) * TP + 16 * sc8) = vreg[i]; }
    __syncthreads();
    float m_run = -INFINITY, l_run = 0.f;
    f32x16 o[2];
#pragma unroll
    for (int i = 0; i < 16; ++i) { o[0][i] = 0.f; o[1][i] = 0.f; }
    const int qmin = q0 + 32 * w, query = qmin + r32;
    const int trrow = 4 * (lane >> 5) + ((lane & 15) >> 2), trcol = 16 * ((lane >> 4) & 1) + 4 * (lane & 3);
    bool wdone = false;
    int buf = 0;
#define FOX_TILE(t, kbuf, vbuf) do { \
        if (!wdone && 64 * t <= qmin + 31) { \
            f32x16 p[2]; \
_Pragma("unroll") \
            for (int half = 0; half < 2; ++half) { \
_Pragma("unroll") \
                for (int g = 0; g < 4; ++g) { const f32x4 kb = *(const LAS f32x4*)(kb2 + 64 * t + 32 * half + 8 * g + 4 * hh); \
                    p[half][4 * g] = kb[0]; p[half][4 * g + 1] = kb[1]; p[half][4 * g + 2] = kb[2]; p[half][4 * g + 3] = kb[3]; } \
_Pragma("unroll") \
                for (int ks = 0; ks < 4; ++ks) { const bf16x8 kf = *(const LAS bf16x8*)(kbuf + (32 * half + r32) * TP + (16 * ks + 8 * hh) * 2); \
                    p[half] = __builtin_amdgcn_mfma_f32_32x32x16_bf16(kf, qr[ks], p[half], 0, 0, 0); } \
            } \
            if (64 * t + 63 > qmin) { \
_Pragma("unroll") \
                for (int half = 0; half < 2; ++half) \
_Pragma("unroll") \
                    for (int i = 0; i < 16; ++i) { const int key = 64 * t + 32 * half + crow(i, hh); if (key > query) p[half][i] = -INFINITY; } \
            } \
            float mx = __builtin_fmaxf(__builtin_fmaxf(p[0][0], p[0][1]), p[1][0]); \
_Pragma("unroll") \
            for (int i = 2; i < 16; i += 2) mx = __builtin_fmaxf(__builtin_fmaxf(mx, p[0][i]), p[0][i + 1]); \
_Pragma("unroll") \
            for (int i = 1; i < 15; i += 2) mx = __builtin_fmaxf(__builtin_fmaxf(mx, p[1][i]), p[1][i + 1]); \
            mx = __builtin_fmaxf(mx, p[1][15]); \
            mx = fmaxf(mx, __shfl_xor(mx, 32)); \
            const float m_new = fmaxf(m_run, mx); \
            const float alpha = __builtin_amdgcn_exp2f(m_run - m_new); \
            const bool resc = __any(m_new > m_run); \
            m_run = m_new; \
            float ls = 0.f; \
_Pragma("unroll") \
            for (int half = 0; half < 2; ++half) \
_Pragma("unroll") \
                for (int i = 0; i < 16; ++i) { p[half][i] = __builtin_amdgcn_exp2f(p[half][i] - m_new); ls += p[half][i]; } \
            ls += __shfl_xor(ls, 32); \
            l_run = l_run * alpha + ls; \
            if (resc) { \
                if (hh == 0) wsf[r32] = alpha; \
                LDS_WAIT(); asm volatile("" ::: "memory"); \
_Pragma("unroll") \
                for (int g = 0; g < 4; ++g) { const f32x4 al = *(const LAS f32x4*)(wsf + 8 * g + 4 * hh); \
_Pragma("unroll") \
                    for (int j = 0; j < 4; ++j) { o[0][4 * g + j] *= al[j]; o[1][4 * g + j] *= al[j]; } } \
            } \
 \
_Pragma("unroll") \
            for (int half = 0; half < 2; ++half) \
_Pragma("unroll") \
                for (int s = 0; s < 2; ++s) { \
                    u32x4 pw; pw.x = cvt_pk_bf16(p[half][8 * s], p[half][8 * s + 1]); pw.y = cvt_pk_bf16(p[half][8 * s + 2], p[half][8 * s + 3]); \
                    pw.z = cvt_pk_bf16(p[half][8 * s + 4], p[half][8 * s + 5]); pw.w = cvt_pk_bf16(p[half][8 * s + 6], p[half][8 * s + 7]); \
                    const bf16x8 pf = __builtin_bit_cast(bf16x8, pw); \
                    const int kbase = 32 * half + 16 * s; \
_Pragma("unroll") \
                    for (int dt = 0; dt < 2; ++dt) { \
                        const LAS unsigned char* vp = vbuf + (kbase + trrow) * TP + (32 * dt + trcol) * 2; \
                        const s16x4 lo = ret::tr_read(vp), hi = ret::tr_read(vp + 8 * TP); \
                        const bf16x8 vf = (bf16x8){lo[0], lo[1], lo[2], lo[3], hi[0], hi[1], hi[2], hi[3]}; \
                        o[dt] = __builtin_amdgcn_mfma_f32_32x32x16_bf16(pf, vf, o[dt], 0, 0, 0); \
                    } \
                } \
 \
            if (t > 0) { const float nxt = kb2[64 * t - 1] + qk_bound + 64.f; \
                if (__all(nxt < m_run)) wdone = true; } \
        } \
    } while (0)
    for (int tp = NP - 1; tp >= 0; --tp, buf ^= 1) {
        if (tp > 0) {
#pragma unroll
            for (int i = 0; i < 2; ++i) { kreg[i] = *(const u32x4*)(kg + (size_t)((tp - 1) * 128 + 64 * i) * 1024); vreg[i] = *(const u32x4*)(vg + (size_t)((tp - 1) * 128 + 64 * i) * 1024); } }
        { const LAS unsigned char* kb1 = lds + L_K + (buf * 128 + 64) * TP; const LAS unsigned char* vb1 = lds + L_V + (buf * 128 + 64) * TP;
          const int t1 = 2 * tp + 1; FOX_TILE(t1, kb1, vb1); }
        { const LAS unsigned char* kb0 = lds + L_K + (buf * 128) * TP; const LAS unsigned char* vb0 = lds + L_V + (buf * 128) * TP;
          const int t0 = 2 * tp; FOX_TILE(t0, kb0, vb0); }
        if (lane == 0) flags[(tp & 1) * 8 + w] = wdone ? 1u : 0u;
        if (tp > 0) {
#pragma unroll
            for (int i = 0; i < 2; ++i) { *(LAS u32x4*)(lds + L_K + ((buf ^ 1) * 128 + srow + 64 * i) * TP + 16 * sc8) = kreg[i]; *(LAS u32x4*)(lds + L_V + ((buf ^ 1) * 128 + srow + 64 * i) * TP + 16 * sc8) = vreg[i]; } }
        __syncthreads();
        { const u32x4 f0 = *(const LAS u32x4*)(flags + (tp & 1) * 8), f1 = *(const LAS u32x4*)(flags + (tp & 1) * 8 + 4);
          if ((f0.x & f0.y & f0.z & f0.w & f1.x & f1.y & f1.z & f1.w) != 0u) break; }
    }
#undef FOX_TILE
    if (hh == 0) wsf[r32] = 1.f / l_run;
    LDS_WAIT(); asm volatile("" ::: "memory");
    unsigned ogv[2][16];
#pragma unroll
    for (int i = 0; i < 16; ++i)
#pragma unroll
        for (int dt = 0; dt < 2; ++dt) ogv[dt][i] = (unsigned)OG[(rowbase + q0 + 32 * w + (i & 3) + 8 * (i >> 2) + 4 * hh) * 1024 + h * FD + 32 * dt + r32];
#pragma unroll
    for (int g = 0; g < 4; ++g) { const f32x4 rl = *(const LAS f32x4*)(wsf + 8 * g + 4 * hh);
#pragma unroll
        for (int j = 0; j < 4; ++j) {
            const size_t row = rowbase + q0 + 32 * w + 8 * g + 4 * hh + j;
#pragma unroll
            for (int dt = 0; dt < 2; ++dt) { const size_t off = row * 1024 + h * FD + 32 * dt + r32;
                const bf16_t yv = (bf16_t)f2bf(o[dt][4 * g + j] * rl[j] * bf2f(ogv[dt][4 * g + j])); if (!dry) QY[off] = yv; }
        } }
}
}

#define XB_TMO      128
#define XB_XCNT(j)  (256  + 64 * (j))
#define XB_XSUB(j)  (1280 + 64 * (j))
#define XB_XGEN(j)  (2304 + 64 * (j))
#define XB_TOP      3328
#define XB_TOPGEN   3392
#define XCD_BAR_WORDS 3456
#define XB_SPIN_CAP (1u << 18)

__device__ __forceinline__ unsigned xb_ld(unsigned* p)              { return __hip_atomic_load(p, __ATOMIC_RELAXED, __HIP_MEMORY_SCOPE_AGENT); }
__device__ __forceinline__ unsigned xb_add(unsigned* p, unsigned v) { return __hip_atomic_fetch_add(p, v, __ATOMIC_RELAXED, __HIP_MEMORY_SCOPE_AGENT); }
__device__ __forceinline__ unsigned xb_xcc_id() { return (unsigned)__builtin_amdgcn_s_getreg((3 << 11) | 20) & 0xFu; }
#define XB_SPIN(cond, bar) do { unsigned _sp = 0; while (cond) { __builtin_amdgcn_s_sleep(1); \
    if ((++_sp & 255u) == 0u) { if (xb_ld(&(bar)[XB_TMO])) break; if (_sp > XB_SPIN_CAP) { atomicAdd(&(bar)[XB_TMO], 1u); break; } } } } while (0)

struct XcdBarrier {
    unsigned* bar; unsigned x;
    volatile LAS unsigned* st;
};

__device__ __forceinline__ XcdBarrier xcd_barrier_post(unsigned* bar, volatile LAS unsigned* st) {
    XcdBarrier b; b.bar = bar; b.x = xb_xcc_id(); b.st = st;
    if (threadIdx.x == 0) (void)xb_add(&bar[XB_XCNT(b.x)], 1u);
    return b;
}
__device__ __forceinline__ void xcd_barrier_complete(unsigned* bar, unsigned x, unsigned& nloc, unsigned& nx) {
    const unsigned G = gridDim.x * gridDim.y * gridDim.z;
    unsigned sum, cnt, mine, sp = 0u;
    for (;;) {
        sum = 0u; cnt = 0u; mine = 0u;
#pragma unroll
        for (unsigned j = 0; j < 16; ++j) { const unsigned c = xb_ld(&bar[XB_XCNT(j)]); sum += c; cnt += (c > 0u) ? 1u : 0u; mine = (j == x) ? c : mine; }
        if (sum == G) break;
        __builtin_amdgcn_s_sleep(1);
        if ((++sp & 255u) == 0u) { if (xb_ld(&bar[XB_TMO])) break; if (sp > XB_SPIN_CAP) { atomicAdd(&bar[XB_TMO], 1u); break; } }
    }
    nloc = mine > 0u ? mine : 1u; nx = cnt > 0u ? cnt : 1u;
}

__device__ __forceinline__ void xcd_barrier(const XcdBarrier& b) {
    asm volatile("s_waitcnt vmcnt(0)" ::: "memory");
    __syncthreads();
    if (threadIdx.x == 0) {
        unsigned* bar = b.bar;
        __builtin_amdgcn_s_waitcnt(0);
        unsigned nloc = b.st[0], nx = b.st[1];
        if (nloc == 0u) { xcd_barrier_complete(bar, b.x, nloc, nx); b.st[0] = nloc; b.st[1] = nx; }
        const unsigned old = xb_add(&bar[XB_XSUB(b.x)], 1u);
        const unsigned gen = old / nloc;
        if (old + 1u == (gen + 1u) * nloc) {
            __builtin_amdgcn_fence(__ATOMIC_RELEASE, "agent");
            asm volatile("s_waitcnt vmcnt(0)" ::: "memory");
            const unsigned og = xb_add(&bar[XB_TOP], 1u);
            const unsigned tg = og / nx;
            if (og + 1u == (tg + 1u) * nx) xb_add(&bar[XB_TOPGEN], 1u);
            else XB_SPIN(xb_ld(&bar[XB_TOPGEN]) == tg, bar);
            __builtin_amdgcn_fence(__ATOMIC_ACQUIRE, "agent");
            xb_add(&bar[XB_XGEN(b.x)], 1u);
            asm volatile("s_waitcnt vmcnt(0)" ::: "memory");
        } else {
            XB_SPIN(xb_ld(&bar[XB_XGEN(b.x)]) == gen, bar);
            __builtin_amdgcn_fence(__ATOMIC_ACQUIRE, "agent");
            asm volatile("s_waitcnt vmcnt(0)" ::: "memory");
        }
    }
    __syncthreads();
}

__global__ void __launch_bounds__(512, 2) yoco_fwd(Args a) {
    extern __shared__ __attribute__((aligned(16))) unsigned char lds_raw[];
    LAS unsigned char* lds = (LAS unsigned char*)lds_raw;
    cg::grid_group grid = cg::this_grid();
    int tid = threadIdx.x, lane = tid & 63, wave = __builtin_amdgcn_readfirstlane(tid >> 6);
#define FENCE() do { asm volatile("" : "+v"(tid)); lane = tid & 63; wave = __builtin_amdgcn_readfirstlane(tid >> 6); } while (0)
#define GSYNC_CG() do { if (G > (1 << 20)) grid.sync(); xcd_barrier(xbar); FENCE(); } while (0)
#define GSYNC() do { xcd_barrier(xbar); FENCE(); } while (0)
    const int G = gridDim.x, bx = blockIdx.x;
    const int vcu = (G % 8 == 0) ? (bx % 8) * (G / 8) + bx / 8 : bx;
    unsigned char* ws = a.ws;
    volatile LAS unsigned* bst = (volatile LAS unsigned*)(lds + XBST_OFF);
    if (tid < 2) bst[tid] = 0u;
    __syncthreads();
    const XcdBarrier xbar = xcd_barrier_post((unsigned*)(ws + WS_CTL), bst);
    float* ADA = (float*)(ws + WS_ADA);
    float* LOGF = (float*)(ws + WS_LOGF);
    float* SSQ = (float*)(ws + WS_SSQ);
    bf16_t* HN = (bf16_t*)(ws + WS_HN);
    bf16_t* HKV = (bf16_t*)(ws + WS_HKV);
    bf16_t* BIG = (bf16_t*)(ws + WS_BIG);
    bf16_t* RQ = (bf16_t*)a.out;
    bf16_t* RK = RQ + (size_t)M * 1024;
    bf16_t* RV = BIG;
    bf16_t* RG = BIG + (size_t)M * 2048;
    bf16_t* HID = BIG;
    bf16_t* KSH = BIG, *VSH = BIG + (size_t)M * 1024, *QY = BIG + (size_t)2 * M * 1024, *OG = BIG + (size_t)3 * M * 1024;
    const float* A0 = ADA, *A1 = ADA + 6144, *AKV = ADA + 12288;
    float* SSQ2 = (float*)(ws + WS_SSQ2);
    bf16_t* XB = (bf16_t*)a.out;
    bf16_t* XB2 = HKV;
    LAS float* wscr = (LAS float*)(lds + WSCR_OFF);

#ifndef EXTRA_P0
#define EXTRA_P0 0
#endif
    for (int rep = EXTRA_P0; rep >= 0; --rep) { phase0(a, lds, tid, lane, wave); __syncthreads(); }
    GSYNC_CG();
    norm_rows(a.x, a.nmg, A0, A0 + 1024, HN, lane, wave);
    { float* B2 = (float*)(ws + WS_BIAS2);
      bias2_rows((const bf16_t*)(ws + WS_WM1_0), FF, A0 + 3072, B2 + B2_MLP0, FF, lane, wave);
      bias2_rows((const bf16_t*)(ws + WS_WM1_1), FF, A1 + 3072, B2 + B2_MLP1, FF, lane, wave);
      bias2_rows((const bf16_t*)(ws + WS_WKV), 2 * D + 256, AKV, B2 + B2_KV, 2 * D + 256, lane, wave);
      bias2_rows((const bf16_t*)(ws + WS_WFIN), 2 * D, A1, B2 + B2_FOX, 2 * D, lane, wave); }
    GSYNC();
    { pg8::Gemm g{HN, (const bf16_t*)(ws + WS_WRIN), M, RIN, D}; pg8::StaticOrder S; S.init(M, RIN, G, bx);
      pg8::EpiRetIn E{RQ, RK, RV, RG, (const float*)(ws + WS_TAB)};
      pg8::gemm_phase<pg8::EpiRetIn, pg8::StaticOrder, true, true>(lds, g, S, E, tid); }
    GSYNC();
#ifndef EXTRA_P3
#define EXTRA_P3 0
#endif
    for (int rep = EXTRA_P3; rep >= 0; --rep)
    for (int u = vcu; u < BATCH * RH * 8; u += G) ret::unit(RQ, RK, RV, RG, SSQ, a.ret_ng, u >> 5, (u >> 3) & 3, u & 7, lds, tid, lane, wave, rep > 0 && G < 100000);
    GSYNC();
    { pg8::Gemm g{RG, (const bf16_t*)(ws + WS_WROUT), M, D, RVW}; pg8::StaticOrder S; S.init(M, D, G, bx);
      LAS float* rtab = (LAS float*)(lds + RTAB_OFF);
      pg8::Unit u;
      for (int i = 0; S.next(i, u); ++i) {
          __syncthreads();
          { const int r = tid >> 1, h0 = (tid & 1) * 2; const float* sp = SSQ + ((size_t)(u.pm * 256 + r) * 4 + h0) * 16;
#pragma unroll
            for (int hh = 0; hh < 2; ++hh) { float s = 0.f;
#pragma unroll
                for (int k = 0; k < 4; ++k) { const f32x4 v = *(const f32x4*)(sp + hh * 16 + 4 * k); s += (v[0] + v[1]) + (v[2] + v[3]); }
                rtab[r * 4 + h0 + hh] = rsqrtf(s * (1.f / RDV) + EPS); } }
          __syncthreads();
          pg8::OneUnit S1{u}; pg8::EpiRes<true, 1, false, true> E{a.x, XB, A0 + 2048, ADA_LD, rtab, {HN, nullptr}, {a.nlg, nullptr}, {A0 + 4096, nullptr}, SSQ2};
          pg8::gemm_phase<pg8::EpiRes<true, 1, false, true>, pg8::OneUnit, false, true>(lds, g, S1, E, tid);
      } }
    GSYNC();
#if defined(STOP_AFTER) && STOP_AFTER == 4
    return;
#endif
#ifndef EXTRA_P6
#define EXTRA_P6 0
#endif
#ifndef EXTRA_NORM
#define EXTRA_NORM 0
#endif
#ifndef EXTRA_SYNC
#define EXTRA_SYNC 0
#endif
#define MLP_IN(WM1, B2OFF) do { \
    { pg8::Gemm g{HN, (const bf16_t*)(ws + (WM1)), M, FF, D}; pg8::StaticOrder S; S.init(M, FF, G, bx); pg8::EpiSqRelu E{HID, SSQ2, (const float*)(ws + WS_BIAS2) + (B2OFF), wscr}; \
      pg8::gemm_phase<pg8::EpiSqRelu, pg8::StaticOrder, true, true>(lds, g, S, E, tid); } \
    GSYNC(); } while (0)
    MLP_IN(WS_WM1_0, B2_MLP0);
    { pg8::Gemm g{HID, (const bf16_t*)(ws + WS_WM2_0), M, D, FF}; pg8::StaticOrder S; S.init(M, D, G, bx);
      pg8::EpiRes<false, 2, true, true> E{XB, XB, A0 + 5120, ADA_LD, nullptr, {HKV, HN}, {a.kv_ng, a.nmg + D}, {AKV + 1024, A1 + 1024}, SSQ2};
      pg8::gemm_phase<pg8::EpiRes<false, 2, true, true>, pg8::StaticOrder, true, true>(lds, g, S, E, tid); }
    GSYNC();
#if defined(STOP_AFTER) && STOP_AFTER == 7
    return;
#endif
    logf_rows(HKV, (const bf16_t*)(ws + WS_WKV) + (size_t)2048 * D, SSQ2, (const float*)(ws + WS_BIAS2) + B2_KV + 2048, 2 * D + 256, a.fbias, LOGF, lds, tid, lane, wave);
    { pg8::Gemm g{HKV, (const bf16_t*)(ws + WS_WKV), M, 2 * D, D}; pg8::StaticOrder S; S.init(M, 2 * D, G, bx);
      pg8::EpiHeads<0> E{KSH, VSH, a.k_ng, 1.f, LOGF, a.fbias, SSQ2, (const float*)(ws + WS_BIAS2) + B2_KV, 2 * D + 256, wscr};
      pg8::gemm_phase<pg8::EpiHeads<0>, pg8::StaticOrder, true, true>(lds, g, S, E, tid); }
    FENCE();
    { pg8::Gemm g{HN, (const bf16_t*)(ws + WS_WFIN), M, 2 * D, D}; pg8::StaticOrder S; S.init(M, 2 * D, G, bx);
      pg8::EpiHeads<1> E{QY, OG, a.q_ng, QSCALE, nullptr, nullptr, SSQ2, (const float*)(ws + WS_BIAS2) + B2_FOX, 2 * D, wscr};
      pg8::gemm_phase<pg8::EpiHeads<1>, pg8::StaticOrder, true, true>(lds, g, S, E, tid); }
    GSYNC();
#ifndef SKIP_ATTN
#ifndef EXTRA_P10
#define EXTRA_P10 0
#endif
    float qk_bound;
    { float gq = fabsf(a.q_ng[lane]), gk = fabsf(a.k_ng[lane]);
#pragma unroll
      for (int o = 1; o < 64; o <<= 1) { gq = fmaxf(gq, __shfl_xor(gq, o)); gk = fmaxf(gk, __shfl_xor(gk, o)); }
      qk_bound = 64.f * gq * gk * QSCALE * 1.02f; }
    for (int rep = EXTRA_P10; rep >= 0; --rep)
    for (int it = vcu; it < 256; it += G) {
        const int bh = it >> 1;
        fox::prep(LOGF, bh >> 4, bh & 15, lds, tid, lane, wave);
#pragma unroll 1
        for (int i = 0; i < 4; ++i) { const int s = (i >> 1) ? 3 - (it & 1) : (it & 1), qb = (i & 1) ? 7 - s : s;
            fox::unit(QY, KSH, VSH, OG, qk_bound, bh >> 4, bh & 15, qb, lds, tid, lane, wave, rep > 0 && G < 100000); }
    }
#endif
    GSYNC();
    { pg8::Gemm g{QY, (const bf16_t*)(ws + WS_WFOUT), M, D, D}; pg8::StaticOrder S; S.init(M, D, G, bx); pg8::EpiRes<false, 1, true, true> E{XB, XB2, A1 + 2048, ADA_LD, nullptr, {HN, nullptr}, {a.nlg + D, nullptr}, {A1 + 4096, nullptr}, SSQ2};
      pg8::gemm_phase<pg8::EpiRes<false, 1, true, true>, pg8::StaticOrder, true, true>(lds, g, S, E, tid); }
    GSYNC();
#if defined(STOP_AFTER) && STOP_AFTER == 11
    return;
#endif
    MLP_IN(WS_WM1_1, B2_MLP1);
    { pg8::Gemm g{HID, (const bf16_t*)(ws + WS_WM2_1), M, D, FF}; pg8::StaticOrder S; S.init(M, D, G, bx);
      pg8::EpiRes<false, 0, true, false> E{XB2, a.out, A1 + 5120, ADA_LD, nullptr, {nullptr, nullptr}, {nullptr, nullptr}, {nullptr, nullptr}, nullptr};
      pg8::gemm_phase<pg8::EpiRes<false, 0, true, false>, pg8::StaticOrder, true, true>(lds, g, S, E, tid); }
#undef MLP_IN
}

extern "C" void kernel_launch(void* const* d_in, const int* in_sizes, int n_in, void* d_out, int out_size, void* d_ws, size_t ws_size, hipStream_t stream) {
    static int grid = 0;
    if (grid == 0) {
        if (n_in != 21 || in_sizes[0] != M * D || out_size != M * D || ws_size < WS_END) { fprintf(stderr, "kernel_launch: unexpected shapes (n_in %d, x %d, out %d, ws %zu)\n", n_in, n_in > 0 ? in_sizes[0] : -1, out_size, ws_size); grid = -1; return; }
        int dev = 0, cus = 0, per_cu = 0;
        if (hipGetDevice(&dev) != hipSuccess || hipDeviceGetAttribute(&cus, hipDeviceAttributeMultiprocessorCount, dev) != hipSuccess) { grid = -1; return; }
        if (hipFuncSetAttribute((const void*)yoco_fwd, hipFuncAttributeMaxDynamicSharedMemorySize, LDS_BYTES) != hipSuccess) { fprintf(stderr, "kernel_launch: hipFuncSetAttribute failed\n"); grid = -1; return; }
        if (hipOccupancyMaxActiveBlocksPerMultiprocessor(&per_cu, (const void*)yoco_fwd, 512, LDS_BYTES) != hipSuccess || per_cu < 1) per_cu = 1;
        (void)hipGetLastError();
        grid = cus * per_cu; if (grid > 256) grid = 256;
    }
    if (grid < 0) return;
    Args p{};
    p.x = (const float*)d_in[0]; p.c = (const float*)d_in[1]; p.pos = (const int*)d_in[2];
    p.nmg = (const float*)d_in[3]; p.nlg = (const float*)d_in[4]; p.w_ada = (const float*)d_in[5]; p.b_ada = (const float*)d_in[6];
    p.w_mlp_in = (const float*)d_in[7]; p.w_mlp_out = (const float*)d_in[8]; p.ret_w_in = (const float*)d_in[9]; p.ret_ng = (const float*)d_in[10];
    p.ret_w_out = (const float*)d_in[11]; p.kv_ng = (const float*)d_in[12]; p.kv_w_ada = (const float*)d_in[13]; p.kv_b_ada = (const float*)d_in[14];
    p.kv_w = (const float*)d_in[15]; p.fbias = (const float*)d_in[16]; p.k_ng = (const float*)d_in[17]; p.fox_w_in = (const float*)d_in[18];
    p.q_ng = (const float*)d_in[19]; p.fox_w_out = (const float*)d_in[20];
    p.out = (float*)d_out; p.ws = (unsigned char*)d_ws;
    if (hipMemsetAsync((char*)d_ws + WS_CTL, 0, CTL_ZERO_BYTES, stream) != hipSuccess) { fprintf(stderr, "kernel_launch: memset failed\n"); return; }
    void* args[] = {&p};
    const hipError_t e = hipLaunchCooperativeKernel((const void*)yoco_fwd, dim3(grid), dim3(512), args, LDS_BYTES, stream);
    if (e != hipSuccess) fprintf(stderr, "kernel_launch: cooperative launch failed: %s (grid %d)\n", hipGetErrorString(e), grid);
}
```

```cpp
#include <hip/hip_runtime.h>
#include <hip/hip_cooperative_groups.h>
#include <cstdio>
#include <cstdint>
namespace cg = cooperative_groups;

namespace pg8 {
#define PG8_LAS __attribute__((address_space(3)))
typedef unsigned short bf16_t;
typedef short bf16x8 __attribute__((ext_vector_type(8)));
typedef float f32x4 __attribute__((ext_vector_type(4)));
typedef unsigned u32x4 __attribute__((ext_vector_type(4)));
constexpr int BM = 256, BK = 64, HALF = 128, HTB = HALF * BK * 2  , STAGE_BYTES = 8 * HTB, NXCD = 8, WGM = 8;

__host__ __device__ __forceinline__ int lds_byte(int r, int c) { const int st = (r >> 4) * 2 + (c >> 5), rr = r & 15, cc = c & 31, ob = rr * 64 + cc * 2; return st * 1024 + (ob ^ (((ob >> 9) & 1) << 5)); }
__host__ __device__ __forceinline__ void stage_rc(int b, int& R, int& C) { const int st = b / 1024, sb = b % 1024, swz = sb ^ (((sb >> 9) & 1) << 5); R = (st >> 1) * 16 + swz / 64; C = (st & 1) * 32 + (swz % 64) / 2; }
__host__ __device__ __forceinline__ int perm32(int rho) { const int n = rho >> 4, i = rho & 15; return 8 * (i >> 2) + 4 * n + (i & 3); }

struct Unit { int pm, pn; };
struct Gemm { const bf16_t* A; const bf16_t* Bt; int M, N, K; };

struct StaticOrder {
    int nM, nN, nwg, G, c;
    __host__ __device__ void init(int M, int N, int G_, int c_) { nM = M / BM; nN = N / BM; nwg = nM * nN; G = G_; c = c_; }
    __host__ __device__ bool next(int i, Unit& u) const {
        const long L = (long)i * G + c; if (L >= nwg) return false;
        int wgid = (int)L; { const int q = nwg / NXCD, r = nwg % NXCD, xcd = wgid % NXCD, off = wgid / NXCD; wgid = (xcd < r ? xcd * (q + 1) : r * (q + 1) + (xcd - r) * q) + off; }
        const int nig = WGM * nN, gid = wgid / nig, fm = gid * WGM, gsz = (nM - fm) < WGM ? (nM - fm) : WGM;
        u.pm = fm + ((wgid % nig) % gsz); u.pn = (wgid % nig) / gsz; return true;
    }
    __device__ __forceinline__ void a_ready(const Unit&) const {}
    __device__ __forceinline__ void done(const Unit&) const {}
};

typedef float f32x2 __attribute__((ext_vector_type(2)));
typedef __bf16 bf16x2_t __attribute__((ext_vector_type(2)));
__device__ __forceinline__ unsigned cvt_pk_bf16(float lo, float hi) { const f32x2 v = {lo, hi}; const bf16x2_t b = __builtin_convertvector(v, bf16x2_t); return __builtin_bit_cast(unsigned, b); }
typedef unsigned u32x2 __attribute__((ext_vector_type(2)));
__device__ __forceinline__ u32x4 pack8(f32x4 v0, f32x4 v1) { u32x4 w; w.x = cvt_pk_bf16(v0[0], v0[1]); w.y = cvt_pk_bf16(v0[2], v0[3]); w.z = cvt_pk_bf16(v1[0], v1[1]); w.w = cvt_pk_bf16(v1[2], v1[3]); return w; }
__device__ __forceinline__ float fast_sigmoid(float v) { return __builtin_amdgcn_rcpf(1.f + __expf(-v)); }

struct EpiRetIn {
    static constexpr bool PERM = true, AFTER_DRAIN = false, KHOOK = false;
    bf16_t *Q, *Kr, *V, *G; const float* tab; const int* pos;
    __device__ __forceinline__ void operator()(const f32x4 (&acc)[2][2][4][2], const Unit& u, int wr, int wc, int fr, int fq) const {
        const int row0 = u.pm * BM + wr * 64 + fr, cw = wc * 32 + 8 * fq;
        if (u.pn < 8) {
            const bool isk = u.pn >= 4; bf16_t* base = (isk ? Kr : Q) + (u.pn & 3) * 256 + cw; const float sc = isk ? 0.0625f : 1.f;
            f32x4 fh[2], fl[2];
            fh[0] = *(const f32x4*)(tab + cw); fh[1] = *(const f32x4*)(tab + cw + 4); fl[0] = *(const f32x4*)(tab + 128 + cw); fl[1] = *(const f32x4*)(tab + 128 + cw + 4);
            int pv[8];
#pragma unroll
            for (int i = 0; i < 8; ++i) pv[i] = pos[row0 + (i >> 2) * HALF + (i & 3) * 16];
#pragma unroll
            for (int ai = 0; ai < 2; ++ai) {
#pragma unroll
                for (int m = 0; m < 4; ++m) {
                    const int row = row0 + ai * HALF + m * 16;
                    const float pf = (float)pv[ai * 4 + m];
                    f32x4 tcs[4];
#pragma unroll
                    for (int e = 0; e < 8; ++e) { const float hi_ = fh[e >> 2][e & 3], lo_ = fl[e >> 2][e & 3];
                        const float a = pf * hi_, er = fmaf(pf, hi_, -a);
                        const float rev = (a - floorf(a)) + fmaf(pf, lo_, er);
                        tcs[e >> 1][2 * (e & 1)] = __builtin_amdgcn_cosf(rev); tcs[e >> 1][2 * (e & 1) + 1] = __builtin_amdgcn_sinf(rev); }
                    const f32x4 t0 = tcs[0], t1 = tcs[1], t2 = tcs[2], t3 = tcs[3];
                    const f32x4 xa = acc[ai][0][m][0] * sc, xb = acc[ai][0][m][1] * sc, ya = acc[ai][1][m][0] * sc, yb = acc[ai][1][m][1] * sc;
                    f32x4 o1a, o1b, o2a, o2b;
                    o1a[0] = xa[0] * t0[0] - ya[0] * t0[1]; o2a[0] = xa[0] * t0[1] + ya[0] * t0[0];
                    o1a[1] = xa[1] * t0[2] - ya[1] * t0[3]; o2a[1] = xa[1] * t0[3] + ya[1] * t0[2];
                    o1a[2] = xa[2] * t1[0] - ya[2] * t1[1]; o2a[2] = xa[2] * t1[1] + ya[2] * t1[0];
                    o1a[3] = xa[3] * t1[2] - ya[3] * t1[3]; o2a[3] = xa[3] * t1[3] + ya[3] * t1[2];
                    o1b[0] = xb[0] * t2[0] - yb[0] * t2[1]; o2b[0] = xb[0] * t2[1] + yb[0] * t2[0];
                    o1b[1] = xb[1] * t2[2] - yb[1] * t2[3]; o2b[1] = xb[1] * t2[3] + yb[1] * t2[2];
                    o1b[2] = xb[2] * t3[0] - yb[2] * t3[1]; o2b[2] = xb[2] * t3[1] + yb[2] * t3[0];
                    o1b[3] = xb[3] * t3[2] - yb[3] * t3[3]; o2b[3] = xb[3] * t3[3] + yb[3] * t3[2];
                    if (isk) { bf16_t* rp = base + (size_t)row * 1024;
                        *(u32x4*)(rp) = pack8(o1a, o1b); *(u32x4*)(rp + 128) = pack8(o2a, o2b); }
                    else {
                        bf16_t* rp = Q + ((size_t)((row >> 11) * 4 + (u.pn & 3)) * 64 + ((row >> 5) & 63)) * 8192 + (cw >> 4) * 512 + ((cw >> 3) & 1) * 256 + (row & 31) * 8;
                        *(u32x4*)(rp) = pack8(o1a, o1b); *(u32x4*)(rp + 8 * 512) = pack8(o2a, o2b); }
                }
                asm volatile("" ::: "memory");
            }
        } else if (u.pn < 16) {
            const int ct = u.pn - 8, hd = ct >> 1;
            const float lg = log2f(1.f - exp2f(-5.f - (float)hd));
#pragma unroll
            for (int ai = 0; ai < 2; ++ai)
#pragma unroll
                for (int m = 0; m < 4; ++m) {
                    const int row = row0 + ai * HALF + m * 16, tok = row & 127;
                    const float kd = exp2f((float)(127 - tok) * lg);
#pragma unroll
                    for (int bj = 0; bj < 2; ++bj) {
                        const int c0 = ct * 256 + bj * HALF + cw;
                        bf16_t* rp = V + ((((size_t)((row >> 11) * 4 + hd) * 8 + ((c0 >> 6) & 7)) * 16 + ((row >> 7) & 15)) * 8 + ((c0 >> 3) & 7)) * 1024 + tok * 8;
                        *(u32x4*)rp = pack8(acc[ai][bj][m][0] * kd, acc[ai][bj][m][1] * kd);
                    }
                }
        } else {
            const bool isg = true; bf16_t* base = G + (u.pn - 16) * 256 + cw;
#pragma unroll
            for (int ai = 0; ai < 2; ++ai)
#pragma unroll
                for (int m = 0; m < 4; ++m) {
                    bf16_t* rp = base + (size_t)(row0 + ai * HALF + m * 16) * 2048;
#pragma unroll
                    for (int bj = 0; bj < 2; ++bj) {
                        f32x4 v0 = acc[ai][bj][m][0], v1 = acc[ai][bj][m][1];
                        if (isg) {
#pragma unroll
                            for (int j = 0; j < 4; ++j) { v0[j] = v0[j] * fast_sigmoid(v0[j]); v1[j] = v1[j] * fast_sigmoid(v1[j]); }
                        }
                        *(u32x4*)(rp + bj * HALF) = pack8(v0, v1);
                    }
                }
        }
    }
};

template <bool HOOK, int NOUT, bool RIN16, bool ROUT16> struct EpiRes {
    static constexpr bool PERM = true, AFTER_DRAIN = false, KHOOK = HOOK;
    const void* resid; void* out; const float* gate; int gate_ld; const PG8_LAS float* rtab;
    bf16_t* hout[2]; const float* hgain[2]; const float* hscale[2]; float* ssq2;
    __device__ __forceinline__ void khook(f32x4 (&acc)[2][2][4][2], int seg, int wr, int fr) const {
#pragma unroll
        for (int ai = 0; ai < 2; ++ai)
#pragma unroll
            for (int m = 0; m < 4; ++m) {
                const int r = ai * HALF + wr * 64 + m * 16 + fr;
                const float f = rtab[r * 4 + seg] / rtab[r * 4 + seg + 1];
#pragma unroll
                for (int bj = 0; bj < 2; ++bj)
#pragma unroll
                    for (int n = 0; n < 2; ++n) acc[ai][bj][m][n] = acc[ai][bj][m][n] * f;
            }
    }
    __device__ __forceinline__ void operator()(const f32x4 (&acc)[2][2][4][2], const Unit& u, int wr, int wc, int fr, int fq) const {
        const int b = u.pm >> 3, col0 = u.pn * BM + wc * 32 + 8 * fq;
        f32x4 gv[2][2]; f32x4 gs[NOUT > 0 ? NOUT : 1][2][2];
#pragma unroll
        for (int bj = 0; bj < 2; ++bj)
#pragma unroll
            for (int n = 0; n < 2; ++n) { const int c = col0 + bj * HALF + 4 * n;
                gv[bj][n] = *(const f32x4*)(gate + (size_t)b * gate_ld + c);
#pragma unroll
                for (int i = 0; i < NOUT; ++i) gs[i][bj][n] = *(const f32x4*)(hgain[i] + c) * (*(const f32x4*)(hscale[i] + (size_t)b * gate_ld + c) + 1.f); }
#pragma unroll
        for (int ai = 0; ai < 2; ++ai) {
            constexpr int MB = RIN16 ? 2 : 1;
#pragma unroll
            for (int mb = 0; mb < 4; mb += MB) {
                u32x4 raw[MB][2][RIN16 ? 1 : 2];
#pragma unroll
                for (int mm = 0; mm < MB; ++mm) {
                    const size_t off = (size_t)(u.pm * BM + ai * HALF + wr * 64 + (mb + mm) * 16 + fr) * 1024 + col0;
#pragma unroll
                    for (int bj = 0; bj < 2; ++bj) {
                        if (RIN16) raw[mm][bj][0] = __builtin_nontemporal_load((const u32x4*)((const bf16_t*)resid + off + bj * HALF));
                        else { raw[mm][bj][0] = __builtin_nontemporal_load((const u32x4*)((const float*)resid + off + bj * HALF)); raw[mm][bj][RIN16 ? 0 : 1] = __builtin_nontemporal_load((const u32x4*)((const float*)resid + off + bj * HALF + 4)); }
                    }
                }
#pragma unroll
                for (int mm = 0; mm < MB; ++mm) {
                    const int m = mb + mm;
                    const int rl = ai * HALF + wr * 64 + m * 16 + fr;
                    float rs = 1.f; if (HOOK) rs = rtab[rl * 4 + 3];
                    const size_t off = (size_t)(u.pm * BM + rl) * 1024 + col0;
                    float ss = 0.f;
#pragma unroll
                    for (int bj = 0; bj < 2; ++bj) {
                        f32x4 r[2];
                        if (RIN16) { const u32x4 rw = raw[mm][bj][0];
                            r[0] = (f32x4){__uint_as_float(rw.x << 16), __uint_as_float(rw.x & 0xffff0000u), __uint_as_float(rw.y << 16), __uint_as_float(rw.y & 0xffff0000u)};
                            r[1] = (f32x4){__uint_as_float(rw.z << 16), __uint_as_float(rw.z & 0xffff0000u), __uint_as_float(rw.w << 16), __uint_as_float(rw.w & 0xffff0000u)}; }
                        else { r[0] = __builtin_bit_cast(f32x4, raw[mm][bj][0]); r[1] = __builtin_bit_cast(f32x4, raw[mm][bj][RIN16 ? 0 : 1]); }
                        f32x4 o[2];
#pragma unroll
                        for (int n = 0; n < 2; ++n) {
                            o[n] = r[n] + gv[bj][n] * (acc[ai][bj][m][n] * rs);
                            if (!ROUT16) *(f32x4*)((float*)out + off + bj * HALF + 4 * n) = o[n];
                            if (NOUT > 0) ss += (o[n][0] * o[n][0] + o[n][1] * o[n][1]) + (o[n][2] * o[n][2] + o[n][3] * o[n][3]);
                        }
                        if (ROUT16) *(u32x4*)((bf16_t*)out + off + bj * HALF) = pack8(o[0], o[1]);
#pragma unroll
                        for (int i = 0; i < NOUT; ++i) *(u32x4*)(hout[i] + off + bj * HALF) = pack8(o[0] * gs[i][bj][0], o[1] * gs[i][bj][1]);
                    }
                    if (NOUT > 0) { ss += __shfl_xor(ss, 16); ss += __shfl_xor(ss, 32);
                        if (fq == 0) ssq2[(size_t)(u.pm * BM + rl) * 16 + u.pn * 4 + wc] = ss; }
                }
                asm volatile("" ::: "memory");
            }
        }
    }
};

__device__ __forceinline__ void wave_rstd(const float* ssq2, PG8_LAS float* scr, int pm, int wr, int lane) {
#pragma unroll
    for (int t = 0; t < 2; ++t) { const int e = lane + 64 * t; const size_t row = (size_t)pm * BM + HALF * t + 64 * wr + lane;
        const f32x4* p = (const f32x4*)(ssq2 + row * 16); const f32x4 a = p[0], b = p[1], c = p[2], d = p[3];
        const float s = ((a[0] + a[1]) + (a[2] + a[3])) + ((b[0] + b[1]) + (b[2] + b[3])) + ((c[0] + c[1]) + (c[2] + c[3])) + ((d[0] + d[1]) + (d[2] + d[3]));
        scr[e] = rsqrtf(s * (1.f / 1024.f) + 1e-6f); }
    asm volatile("s_waitcnt lgkmcnt(0)" ::: "memory");
}

struct EpiSqRelu {
    static constexpr bool PERM = true, AFTER_DRAIN = false, KHOOK = false;
    bf16_t* O; const float* ssq2; const float* bias2; PG8_LAS float* scr0;
    __device__ __forceinline__ void operator()(const f32x4 (&acc)[2][2][4][2], const Unit& u, int wr, int wc, int fr, int fq) const {
        const int row0 = u.pm * BM + wr * 64 + fr, col0 = u.pn * BM + wc * 32 + 8 * fq;
        PG8_LAS float* scr = scr0 + (wr * 4 + wc) * 128;
        wave_rstd(ssq2, scr, u.pm, wr, fq * 16 + fr);
        f32x4 bv[2][2];
#pragma unroll
        for (int bj = 0; bj < 2; ++bj)
#pragma unroll
            for (int n = 0; n < 2; ++n) bv[bj][n] = *(const f32x4*)(bias2 + (size_t)(u.pm >> 3) * 4096 + col0 + bj * HALF + 4 * n);
#pragma unroll
        for (int ai = 0; ai < 2; ++ai)
#pragma unroll
            for (int m = 0; m < 4; ++m) {
                bf16_t* rp = O + (size_t)(row0 + ai * HALF + m * 16) * 4096 + col0;
                const float rstd = scr[ai * 64 + m * 16 + fr];
#pragma unroll
                for (int bj = 0; bj < 2; ++bj) {
                    f32x4 v0 = acc[ai][bj][m][0] * rstd + bv[bj][0], v1 = acc[ai][bj][m][1] * rstd + bv[bj][1];
#pragma unroll
                    for (int j = 0; j < 4; ++j) { const float a = fmaxf(v0[j], 0.f), c = fmaxf(v1[j], 0.f); v0[j] = a * a; v1[j] = c * c; }
                    *(u32x4*)(rp + bj * HALF) = pack8(v0, v1);
                }
            }
    }
};

template <int MODE1> struct EpiHeads {
    static constexpr bool PERM = true, AFTER_DRAIN = false, KHOOK = false;
    bf16_t *O0, *O1; const float* gain; float scale0; float* logf; const float* fbias;
    const float* ssq2; const float* bias2; int bias_ld; PG8_LAS float* scr0;
    __device__ __forceinline__ void operator()(const f32x4 (&acc0)[2][2][4][2], const Unit& u, int wr, int wc, int fr, int fq) const {
        const int row0 = u.pm * BM + wr * 64 + fr;
        PG8_LAS float* scr = scr0 + (wr * 4 + wc) * 128;
        wave_rstd(ssq2, scr, u.pm, wr, fq * 16 + fr);
        f32x4 acc[2][2][4][2];
        { f32x4 bv[2][2];
#pragma unroll
          for (int bj = 0; bj < 2; ++bj)
#pragma unroll
              for (int n = 0; n < 2; ++n) bv[bj][n] = *(const f32x4*)(bias2 + (size_t)(u.pm >> 3) * bias_ld + u.pn * BM + bj * HALF + wc * 32 + 8 * fq + 4 * n);
#pragma unroll
          for (int ai = 0; ai < 2; ++ai)
#pragma unroll
              for (int m = 0; m < 4; ++m) { const float rstd = scr[ai * 64 + m * 16 + fr];
#pragma unroll
                  for (int bj = 0; bj < 2; ++bj)
#pragma unroll
                      for (int n = 0; n < 2; ++n) acc[ai][bj][m][n] = acc0[ai][bj][m][n] * rstd + bv[bj][n]; } }
        if (u.pn < 4) {
            f32x4 gk[2][2];
#pragma unroll
            for (int bj = 0; bj < 2; ++bj)
#pragma unroll
                for (int n = 0; n < 2; ++n) gk[bj][n] = *(const f32x4*)(gain + 32 * bj + 8 * fq + 4 * n) * scale0;
#pragma unroll
            for (int ai = 0; ai < 2; ++ai)
#pragma unroll
                for (int m = 0; m < 4; ++m) {
                    float ss = 0.f;
#pragma unroll
                    for (int bj = 0; bj < 2; ++bj)
#pragma unroll
                        for (int n = 0; n < 2; ++n) { const f32x4 x = acc[ai][bj][m][n]; ss += (x[0] * x[0] + x[1] * x[1]) + (x[2] * x[2] + x[3] * x[3]); }
                    ss += __shfl_xor(ss, 16); ss += __shfl_xor(ss, 32);
                    const float rstd = rsqrtf(ss * (1.f / 64.f) + 1e-6f);
                    bf16_t* rp = O0 + (size_t)(row0 + ai * HALF + m * 16) * 1024 + u.pn * 256 + wc * 64 + 8 * fq;
#pragma unroll
                    for (int bj = 0; bj < 2; ++bj) *(u32x4*)(rp + 32 * bj) = pack8(acc[ai][bj][m][0] * rstd * gk[bj][0], acc[ai][bj][m][1] * rstd * gk[bj][1]);
                }
        } else if (u.pn < 8) {
#pragma unroll
            for (int ai = 0; ai < 2; ++ai)
#pragma unroll
                for (int m = 0; m < 4; ++m) {
                    bf16_t* rp = O1 + (size_t)(row0 + ai * HALF + m * 16) * 1024 + (u.pn - 4) * 256 + wc * 64 + 8 * fq;
#pragma unroll
                    for (int bj = 0; bj < 2; ++bj) {
                        f32x4 v0 = acc[ai][bj][m][0], v1 = acc[ai][bj][m][1];
                        if (MODE1 == 1) {
#pragma unroll
                            for (int j = 0; j < 4; ++j) { v0[j] = fast_sigmoid(v0[j]); v1[j] = fast_sigmoid(v1[j]); }
                        }
                        *(u32x4*)(rp + 32 * bj) = pack8(v0, v1);
                    }
                }
        } else {
            if (wc == 0 && fq < 2) {
                const f32x4 b0 = *(const f32x4*)(fbias + 8 * fq), b1 = *(const f32x4*)(fbias + 8 * fq + 4);
#pragma unroll
                for (int ai = 0; ai < 2; ++ai)
#pragma unroll
                    for (int m = 0; m < 4; ++m) {
                        f32x4 z0 = acc[ai][0][m][0] + b0, z1 = acc[ai][0][m][1] + b1;
#pragma unroll
                        for (int j = 0; j < 4; ++j) { z0[j] = fminf(z0[j], 0.f) - log1pf(__expf(-fabsf(z0[j]))); z1[j] = fminf(z1[j], 0.f) - log1pf(__expf(-fabsf(z1[j]))); }
                        float* lp = logf + (size_t)(row0 + ai * HALF + m * 16) * 16 + 8 * fq;
                        *(f32x4*)lp = z0; *(f32x4*)(lp + 4) = z1;
                    }
            }
        }
    }
};

struct OneUnit {
    Unit u;
    __device__ __forceinline__ bool next(int i, Unit& o) const { if (i) return false; o = u; return true; }
    __device__ __forceinline__ void a_ready(const Unit&) const {}
    __device__ __forceinline__ void done(const Unit&) const {}
};
template <class Epi, class Sched, bool ALIGN_EPI = false, bool SP2 = false>
__device__ __forceinline__ void gemm_phase(PG8_LAS unsigned char* lds, const Gemm g, const Sched& S, const Epi& E, const int tid) {
    const int wid = __builtin_amdgcn_readfirstlane(tid >> 6), lane = tid & 63, wr = wid >> 2, wc = wid & 3, fr = lane & 15, fq = lane >> 4;
    const int K = g.K, nt = K / BK;
    unsigned voffA[2], voffB[2];
#pragma unroll
    for (int i = 0; i < 2; ++i) { int R, C; stage_rc(tid * 16 + i * 8192, R, C); const int Rb = Epi::PERM ? ((R & ~31) + perm32(R & 31)) : R;
        voffA[i] = (unsigned)(R * K + C) * 2u; voffB[i] = (unsigned)(Rb * K + C) * 2u; }
    const size_t kstep = (size_t)(BK * 2);
    const size_t hstep = (size_t)HALF * K * 2;
    const size_t tstep = 2 * hstep;
    const unsigned ldsw = (unsigned)wid * 1024u;
    const int aoff = lds_byte(wr * 64 + fr, fq * 8), boff = lds_byte(wc * 32 + fr, fq * 8);
#define PG8_SA(b, h) (((b) * 2 + (h)) * HTB)
#define PG8_SB(b, h) ((4 + (b) * 2 + (h)) * HTB)
#define PG8_STAGE(bufoff, gbase, voff) do { _Pragma("unroll") for (int _i = 0; _i < 2; ++_i) \
        __builtin_amdgcn_global_load_lds((const unsigned*)((const char*)(gbase) + (voff)[_i]), (PG8_LAS unsigned*)(lds + (bufoff) + ldsw + _i * 8192), 16, 0, 0); } while (0)
#define PG8_LDA(dst, b, h) do { _Pragma("unroll") for (int m = 0; m < 4; ++m) _Pragma("unroll") for (int k = 0; k < 2; ++k) dst[m][k] = *(const PG8_LAS bf16x8*)(lds + PG8_SA(b, h) + aoff + m * 2048 + k * 1024); } while (0)
#define PG8_LDB(dst, b, h) do { _Pragma("unroll") for (int n = 0; n < 2; ++n) _Pragma("unroll") for (int k = 0; k < 2; ++k) dst[n][k] = *(const PG8_LAS bf16x8*)(lds + PG8_SB(b, h) + boff + n * 2048 + k * 1024); } while (0)
#define PG8_MMA(ai, bj, At, Bt) do { __builtin_amdgcn_s_setprio(1); _Pragma("unroll") for (int m = 0; m < 4; ++m) _Pragma("unroll") for (int n = 0; n < 2; ++n) _Pragma("unroll") for (int k = 0; k < 2; ++k) \
        acc[ai][bj][m][n] = __builtin_amdgcn_mfma_f32_16x16x32_bf16(Bt[n][k], At[m][k], acc[ai][bj][m][n], 0, 0, 0); __builtin_amdgcn_s_setprio(0); } while (0)
#define PG8_WAIT_V(n) asm volatile("s_waitcnt vmcnt(" #n ")" ::: "memory")
#define PG8_WAIT_L(n) asm volatile("s_waitcnt lgkmcnt(" #n ")" ::: "memory")
#define PG8_BAR __builtin_amdgcn_s_barrier()
#define PG8_SCHED __builtin_amdgcn_sched_barrier(0)
    Unit cur, nxt; int ui = 0;
    if (!S.next(0, cur)) return;
    f32x4 acc[2][2][4][2];
#pragma unroll
    for (int a = 0; a < 2; ++a)
#pragma unroll
        for (int b = 0; b < 2; ++b)
#pragma unroll
            for (int m = 0; m < 4; ++m)
#pragma unroll
                for (int n = 0; n < 2; ++n) acc[a][b][m][n] = (f32x4){0.f, 0.f, 0.f, 0.f};
    bf16x8 At[4][2], B0[2][2], B1[2][2];
    const char* cA = (const char*)g.A + (size_t)cur.pm * tstep; const char* cB = (const char*)g.Bt + (size_t)cur.pn * tstep;
    S.a_ready(cur);
    if constexpr (SP2) {
        PG8_STAGE(PG8_SB(0, 0), cB, voffB); PG8_STAGE(PG8_SB(0, 1), cB + hstep, voffB); PG8_STAGE(PG8_SA(0, 0), cA, voffA); PG8_STAGE(PG8_SA(0, 1), cA + hstep, voffA);
        if (wr == 1) PG8_BAR;
        PG8_WAIT_V(2); PG8_BAR;
        PG8_STAGE(PG8_SB(1, 0), cB + kstep, voffB); PG8_STAGE(PG8_SA(1, 0), cA + kstep, voffA); PG8_STAGE(PG8_SB(1, 1), cB + hstep + kstep, voffB);
        PG8_WAIT_V(6); PG8_BAR;
    } else {
        PG8_STAGE(PG8_SB(0, 0), cB, voffB); PG8_STAGE(PG8_SA(0, 0), cA, voffA); PG8_STAGE(PG8_SB(0, 1), cB + hstep, voffB); PG8_STAGE(PG8_SA(0, 1), cA + hstep, voffA);
        if (wr == 1) PG8_BAR;
        PG8_WAIT_V(4); PG8_BAR;
        PG8_STAGE(PG8_SB(1, 0), cB + kstep, voffB); PG8_STAGE(PG8_SA(1, 0), cA + kstep, voffA); PG8_STAGE(PG8_SB(1, 1), cB + hstep + kstep, voffB);
        PG8_WAIT_V(6); PG8_BAR;
    }
    for (;;) {
        const bool has_next = S.next(ui + 1, nxt);
        const char* nA = has_next ? (const char*)g.A + (size_t)nxt.pm * tstep : cA; const char* nB = has_next ? (const char*)g.Bt + (size_t)nxt.pn * tstep : cB;
        for (int t = 0; t < nt; t += 2) {
            const bool last = (t == nt - 2);
            const char* a1 = cA + (size_t)(t + 1) * kstep;
            const char* a2 = last ? nA : cA + (size_t)(t + 2) * kstep; const char* b2 = last ? nB : cB + (size_t)(t + 2) * kstep;
            const char* a3 = a2 + kstep; const char* b3 = b2 + kstep;
            if (last && has_next) S.a_ready(nxt);
            if constexpr (SP2) {
            PG8_LDB(B0, 0, 0); PG8_LDB(B1, 0, 1); PG8_SCHED; PG8_LDA(At, 0, 0); PG8_STAGE(PG8_SA(1, 1), a1 + hstep, voffA);
            PG8_WAIT_V(8); PG8_WAIT_L(0); PG8_BAR; PG8_MMA(0, 0, At, B0); PG8_MMA(0, 1, At, B1); PG8_BAR; PG8_SCHED;
            PG8_LDA(At, 0, 1); PG8_STAGE(PG8_SB(0, 0), b2, voffB); PG8_STAGE(PG8_SB(0, 1), b2 + hstep, voffB); PG8_STAGE(PG8_SA(0, 0), a2, voffA);
            PG8_WAIT_V(8); PG8_WAIT_L(0); PG8_BAR; PG8_MMA(1, 0, At, B0); PG8_MMA(1, 1, At, B1); PG8_BAR; PG8_SCHED;
            PG8_LDB(B0, 1, 0); PG8_LDB(B1, 1, 1); PG8_SCHED; PG8_LDA(At, 1, 0); PG8_STAGE(PG8_SA(0, 1), a2 + hstep, voffA);
            PG8_WAIT_V(8); PG8_WAIT_L(0); PG8_BAR; PG8_MMA(0, 0, At, B0); PG8_MMA(0, 1, At, B1); PG8_BAR; PG8_SCHED;
            PG8_LDA(At, 1, 1); PG8_STAGE(PG8_SB(1, 0), b3, voffB); PG8_STAGE(PG8_SB(1, 1), b3 + hstep, voffB); PG8_STAGE(PG8_SA(1, 0), a3, voffA);
            PG8_WAIT_V(8); PG8_WAIT_L(0); PG8_BAR; PG8_MMA(1, 0, At, B0); PG8_MMA(1, 1, At, B1); PG8_BAR; PG8_SCHED;
            if constexpr (Epi::KHOOK) { if ((((t + 2) & 7) == 0) && (t + 2 < nt)) E.khook(acc, ((t + 2) >> 3) - 1, wr, fr); }
            } else {
            PG8_LDB(B0, 0, 0); PG8_SCHED; PG8_LDA(At, 0, 0); PG8_STAGE(PG8_SA(1, 1), a1 + hstep, voffA);
            PG8_WAIT_L(8); PG8_BAR; PG8_WAIT_L(0); PG8_MMA(0, 0, At, B0); PG8_BAR; PG8_SCHED;
            PG8_LDB(B1, 0, 1); PG8_STAGE(PG8_SB(0, 0), b2, voffB);
            PG8_BAR; PG8_WAIT_L(0); PG8_MMA(0, 1, At, B1); PG8_BAR;
            PG8_LDA(At, 0, 1); PG8_STAGE(PG8_SA(0, 0), a2, voffA);
            PG8_BAR; PG8_WAIT_L(0); PG8_MMA(1, 0, At, B0); PG8_BAR; PG8_SCHED;
            PG8_STAGE(PG8_SB(0, 1), b2 + hstep, voffB);
            PG8_WAIT_V(6); PG8_BAR; PG8_MMA(1, 1, At, B1); PG8_BAR;
            PG8_LDB(B0, 1, 0); PG8_SCHED; PG8_LDA(At, 1, 0); PG8_STAGE(PG8_SA(0, 1), a2 + hstep, voffA);
            PG8_WAIT_L(8); PG8_BAR; PG8_WAIT_L(0); PG8_MMA(0, 0, At, B0); PG8_BAR; PG8_SCHED;
            PG8_LDB(B1, 1, 1); PG8_STAGE(PG8_SB(1, 0), b3, voffB);
            PG8_BAR; PG8_WAIT_L(0); PG8_MMA(0, 1, At, B1); PG8_BAR;
            PG8_LDA(At, 1, 1); PG8_STAGE(PG8_SA(1, 0), a3, voffA);
            PG8_BAR; PG8_WAIT_L(0); PG8_MMA(1, 0, At, B0); PG8_BAR; PG8_SCHED;
            PG8_STAGE(PG8_SB(1, 1), b3 + hstep, voffB);
            PG8_WAIT_V(6); PG8_BAR; PG8_MMA(1, 1, At, B1); PG8_BAR;
            }
        }
        if constexpr (ALIGN_EPI) { if (wr == 0) PG8_BAR; }
        if constexpr (!Epi::AFTER_DRAIN) { E(acc, cur, wr, wc, fr, fq); S.done(cur); }
        if (!has_next) break;
#pragma unroll
        for (int a = 0; a < 2; ++a)
#pragma unroll
            for (int b = 0; b < 2; ++b)
#pragma unroll
                for (int m = 0; m < 4; ++m)
#pragma unroll
                    for (int n = 0; n < 2; ++n) acc[a][b][m][n] = (f32x4){0.f, 0.f, 0.f, 0.f};
        cur = nxt; cA = nA; cB = nB; ++ui;
        if constexpr (ALIGN_EPI) { if (wr == 1) PG8_BAR; }
    }
    PG8_WAIT_V(0);
    if constexpr (!ALIGN_EPI) { if (wr == 0) PG8_BAR; }
    PG8_BAR;
    if constexpr (Epi::AFTER_DRAIN) { E.fused(acc, cur, wr, wc, fr, fq, lds, wid, lane); S.done(cur); }
#undef PG8_SA
#undef PG8_SB
#undef PG8_STAGE
#undef PG8_LDA
#undef PG8_LDB
#undef PG8_MMA
#undef PG8_WAIT_V
#undef PG8_WAIT_L
#undef PG8_BAR
#undef PG8_SCHED
}
}

using pg8::bf16_t; using pg8::bf16x8; using pg8::f32x4; using pg8::u32x4; using pg8::u32x2; using pg8::cvt_pk_bf16;
#define LAS __attribute__((address_space(3)))
typedef float f32x16 __attribute__((ext_vector_type(16)));
typedef short s16x4 __attribute__((ext_vector_type(4)));

constexpr int BATCH = 8, SEQ = 2048, D = 1024, M = BATCH * SEQ, FF = 4096;
constexpr int RH = 4, RDK = 256, RDV = 512, RVW = RH * RDV, RIN = 6144, RC = 128, NCH = SEQ / RC;
constexpr int FH = 16, FD = 64;
constexpr int ADA_LD = 14336;
constexpr float EPS = 1e-6f;
constexpr float LOG2E = 1.4426950408889634f;
constexpr float QSCALE = 0.125f * LOG2E;

constexpr size_t MiB = 1u << 20;
constexpr size_t WS_ADA = 1 * MiB, WS_LOGF = 2 * MiB, WS_SSQ = 4 * MiB;
constexpr size_t WS_SSQ2 = 3 * MiB;
constexpr size_t WS_BIAS2 = 1 * MiB + 512 * 1024;
constexpr size_t B2_MLP0 = 0, B2_MLP1 = 8 * 4096, B2_KV = 16 * 4096, B2_FOX = 16 * 4096 + 8 * 2304;
constexpr size_t WS_WRIN = 8 * MiB, WS_WROUT = 20 * MiB, WS_WM1_0 = 24 * MiB;
constexpr size_t WS_TAB = 32 * MiB;
constexpr size_t WS_HKV = 8 * MiB;
constexpr size_t WS_WM2_0 = 48 * MiB, WS_WM1_1 = 56 * MiB, WS_WM2_1 = 64 * MiB, WS_WKV = 72 * MiB, WS_WFIN = 77 * MiB, WS_WFOUT = 81 * MiB;
constexpr size_t WS_HN = 83 * MiB;
constexpr size_t WS_BIG = 115 * MiB;
constexpr size_t WS_END = 243 * MiB;

constexpr int LDS_BYTES = 155648;
constexpr int RING_BYTES = 131072;
constexpr int RTAB_OFF = 132096;
constexpr int WSCR_OFF = 136192;
constexpr int XBST_OFF = LDS_BYTES - 64;
constexpr size_t WS_CTL = 0, CTL_ZERO_BYTES = 16384;

__device__ __forceinline__ float bf2f(unsigned b) { return __uint_as_float(b << 16); }
__device__ __forceinline__ unsigned f2bf(float f) { unsigned u = __float_as_uint(f); return (u + 0x7fffu + ((u >> 16) & 1u)) >> 16; }
__device__ __forceinline__ unsigned pk2(float lo, float hi) { return f2bf(lo) | (f2bf(hi) << 16); }
__device__ __forceinline__ float wave_sum(float v) {
#pragma unroll
    for (int o = 1; o < 64; o <<= 1) v += __shfl_xor(v, o);
    return v;
}
#define LDS_WAIT() asm volatile("s_waitcnt lgkmcnt(0)" ::: "memory")

struct Args {
    const float* x; const float* c; const int* pos;
    const float *nmg, *nlg, *w_ada, *b_ada, *w_mlp_in, *w_mlp_out, *ret_w_in, *ret_ng, *ret_w_out, *kv_ng, *kv_w_ada, *kv_b_ada, *kv_w, *fbias, *k_ng, *fox_w_in, *q_ng, *fox_w_out;
    float* out; unsigned char* ws;
};

__device__ __forceinline__ int perm_row(int n) { return (n & ~255) + 128 * ((n >> 5) & 1) + 32 * ((n >> 6) & 3) + (n & 31); }
struct TDesc { const float* W; int ldw, K, nblk; bf16_t* WT; int permute, r; };
__device__ __forceinline__ void transpose_load(const TDesc& d, f32x4 (&wv)[16], int lane) {
    const int kb = d.r / d.nblk, nb = d.r % d.nblk;
    const float* wp = d.W + (size_t)(64 * kb + (lane >> 4)) * d.ldw + 64 * nb + 4 * (lane & 15);
#pragma unroll
    for (int i = 0; i < 16; ++i) wv[i] = __builtin_nontemporal_load((const f32x4*)(wp + (size_t)(4 * i) * d.ldw));
}
__device__ __forceinline__ void transpose_to_lds(const f32x4 (&wv)[16], LAS float* scr, int lane) {
#pragma unroll
    for (int i = 0; i < 16; ++i) { LAS float* sp = scr + (4 * i + (lane >> 4)) * 65 + 4 * (lane & 15); sp[0] = wv[i][0]; sp[1] = wv[i][1]; sp[2] = wv[i][2]; sp[3] = wv[i][3]; }
    LDS_WAIT(); asm volatile("" ::: "memory");
}
__device__ __forceinline__ void transpose_store(const TDesc& d, LAS float* scr, int lane) {
    const int kb = d.r / d.nblk, nb = d.r % d.nblk, k0 = 64 * kb, n0 = 64 * nb;
    const int c = lane & 7;
#pragma unroll
    for (int j = 0; j < 8; ++j) { const int n = (lane >> 3) + 8 * j; const LAS float* s = scr + (8 * c) * 65 + n;
        u32x4 o; o.x = pk2(s[0 * 65], s[1 * 65]); o.y = pk2(s[2 * 65], s[3 * 65]); o.z = pk2(s[4 * 65], s[5 * 65]); o.w = pk2(s[6 * 65], s[7 * 65]);
        const int r = d.permute ? perm_row(n0 + n) : n0 + n;
        *(u32x4*)(d.WT + (size_t)r * d.K + k0 + 8 * c) = o; }
    LDS_WAIT(); asm volatile("" ::: "memory");
}

__device__ __forceinline__ void phase0(const Args& a, LAS unsigned char* lds, int tid, int lane, int wave) {
    unsigned char* ws = a.ws;
    const int G = gridDim.x, bx = blockIdx.x;
    LAS float* cact = (LAS float*)lds;
    LAS float* red = (LAS float*)(lds + 32768);
    float* ADA = (float*)(ws + WS_ADA);
    for (int it = bx; it < ADA_LD / 64; it += G) {
        __syncthreads();
        for (int i = tid; i < BATCH * D; i += 512) { const int b = i >> 10, k = i & 1023; const float v = a.c[i]; cact[k * 8 + b] = v * pg8::fast_sigmoid(v); }
        __syncthreads();
        const int n0 = it * 64;
        const float* W; const float* bias; int ldw, nn;
        if (n0 < 6144) { W = a.w_ada; bias = a.b_ada; ldw = 6144; nn = n0; }
        else if (n0 < 12288) { W = a.w_ada + (size_t)D * 6144; bias = a.b_ada + 6144; ldw = 6144; nn = n0 - 6144; }
        else { W = a.kv_w_ada; bias = a.kv_b_ada; ldw = 2048; nn = n0 - 12288; }
        float acc[8];
#pragma unroll
        for (int b = 0; b < 8; ++b) acc[b] = 0.f;
        const float* wp = W + (size_t)(wave * 128) * ldw + nn + lane;
        for (int kb = 0; kb < 128; kb += 16) {
            float wv[16];
#pragma unroll
            for (int i = 0; i < 16; ++i) wv[i] = __builtin_nontemporal_load(wp + (size_t)(kb + i) * ldw);
            __builtin_amdgcn_sched_barrier(0);
#pragma unroll
            for (int i = 0; i < 16; ++i) {
                const float w = wv[i];
                const f32x4 c0 = *(const LAS f32x4*)(cact + (wave * 128 + kb + i) * 8), c1 = *(const LAS f32x4*)(cact + (wave * 128 + kb + i) * 8 + 4);
                acc[0] += c0[0] * w; acc[1] += c0[1] * w; acc[2] += c0[2] * w; acc[3] += c0[3] * w;
                acc[4] += c1[0] * w; acc[5] += c1[1] * w; acc[6] += c1[2] * w; acc[7] += c1[3] * w;
            }
            __builtin_amdgcn_sched_barrier(0);
        }
#pragma unroll
        for (int b = 0; b < 8; ++b) red[(wave * 8 + b) * 64 + lane] = acc[b];
        __syncthreads();
        { const int b = tid >> 6; float s = bias[nn + lane];
#pragma unroll
          for (int w = 0; w < 8; ++w) s += red[(w * 8 + b) * 64 + lane];
          ADA[(size_t)b * ADA_LD + n0 + lane] = s; }
    }
    __syncthreads();
    {
        LAS float* scr = (LAS float*)(lds + wave * 16640);
        const int gw = bx * 8 + wave, NGW = G * 8;
        constexpr int I0 = 16 * 96, I1 = 32 * 16, I2 = 16 * 64, I3 = 64 * 16, I4 = 16 * 32, I5 = 16 * 32, I6 = 16 * 16;
        constexpr int NITEMS = I0 + I1 + 2 * I2 + 2 * I3 + I4 + I5 + I6;
        auto desc = [&](int it) -> TDesc {
            int r = it;
            if (r < I0) return TDesc{a.ret_w_in, RIN, D, 96, (bf16_t*)(ws + WS_WRIN), 0, r}; r -= I0;
            if (r < I1) return TDesc{a.ret_w_out, D, RVW, 16, (bf16_t*)(ws + WS_WROUT), 0, r}; r -= I1;
            if (r < I2) return TDesc{a.w_mlp_in, FF, D, 64, (bf16_t*)(ws + WS_WM1_0), 0, r}; r -= I2;
            if (r < I2) return TDesc{a.w_mlp_in + (size_t)D * FF, FF, D, 64, (bf16_t*)(ws + WS_WM1_1), 0, r}; r -= I2;
            if (r < I3) return TDesc{a.w_mlp_out, D, FF, 16, (bf16_t*)(ws + WS_WM2_0), 0, r}; r -= I3;
            if (r < I3) return TDesc{a.w_mlp_out + (size_t)FF * D, D, FF, 16, (bf16_t*)(ws + WS_WM2_1), 0, r}; r -= I3;
            if (r < I4) return TDesc{a.kv_w, 2 * D + FH, D, 32, (bf16_t*)(ws + WS_WKV), 1, r}; r -= I4;
            if (r < I5) return TDesc{a.fox_w_in, 2 * D, D, 32, (bf16_t*)(ws + WS_WFIN), 1, r}; r -= I5;
            return TDesc{a.fox_w_out, D, D, 16, (bf16_t*)(ws + WS_WFOUT), 0, r};
        };
        f32x4 wv[16];
        int it = gw;
        TDesc cur{}; if (it < NITEMS) { cur = desc(it); transpose_load(cur, wv, lane); }
        while (it < NITEMS) {
            transpose_to_lds(wv, scr, lane);
            const int nx = it + NGW; TDesc nd{};
            if (nx < NITEMS) { nd = desc(nx); transpose_load(nd, wv, lane); }
            transpose_store(cur, scr, lane);
            cur = nd; it = nx;
        }
    }
    const int gt = bx * 512 + tid, NT = G * 512;
    {
        bf16_t* wkv = (bf16_t*)(ws + WS_WKV) + (size_t)2048 * D;
        for (int i = gt; i < 256 * (D / 8); i += NT) {
            const int row = i >> 7, c8 = i & 127; u32x4 o = (u32x4){0u, 0u, 0u, 0u};
            if (row < FH) { float v[8];
#pragma unroll
                for (int e = 0; e < 8; ++e) v[e] = a.kv_w[(size_t)(8 * c8 + e) * (2 * D + FH) + 2 * D + row];
                o.x = pk2(v[0], v[1]); o.y = pk2(v[2], v[3]); o.z = pk2(v[4], v[5]); o.w = pk2(v[6], v[7]); }
            *(u32x4*)(wkv + (size_t)row * D + 8 * c8) = o;
        }
    }
    if (gt < 128) {
        float* tab = (float*)(ws + WS_TAB);
        double invf = 1.0; { const double r = 0.93057204092969897;
            for (int k = 0; k < gt; ++k) invf *= r; }
        const double v = invf * 0.15915494309189535;
        const float hi = (float)v;
        tab[gt] = hi; tab[128 + gt] = (float)(v - (double)hi);
    }
}

__device__ __forceinline__ void norm_rows(const float* xs, const float* gain, const float* shift, const float* scale, bf16_t* out, int lane, int wave) {
    const int gw = blockIdx.x * 8 + wave, NGW = gridDim.x * 8;
    const int per = (M + NGW - 1) / NGW, r0 = gw * per, r1 = (r0 + per < M) ? r0 + per : M;
    if (r0 >= r1) return;
    f32x4 gs[4], sh[4]; int bcur = -1;
    f32x4 vn[4];
    { const f32x4* xr = (const f32x4*)(xs + (size_t)r0 * D) + lane;
#pragma unroll
      for (int j = 0; j < 4; ++j) vn[j] = __builtin_nontemporal_load(xr + 64 * j); }
    for (int row = r0; row < r1; ++row) {
        f32x4 v[4];
#pragma unroll
        for (int j = 0; j < 4; ++j) v[j] = vn[j];
        if (row + 1 < r1) { const f32x4* xr = (const f32x4*)(xs + (size_t)(row + 1) * D) + lane;
#pragma unroll
            for (int j = 0; j < 4; ++j) vn[j] = __builtin_nontemporal_load(xr + 64 * j); }
        const int b = row >> 11;
        if (b != bcur) { bcur = b;
#pragma unroll
            for (int j = 0; j < 4; ++j) { const int col = 4 * lane + 256 * j;
                gs[j] = *(const f32x4*)(gain + col) * (*(const f32x4*)(scale + (size_t)b * ADA_LD + col) + 1.f); sh[j] = *(const f32x4*)(shift + (size_t)b * ADA_LD + col); } }
        float ss = 0.f;
#pragma unroll
        for (int j = 0; j < 4; ++j) ss += (v[j][0] * v[j][0] + v[j][1] * v[j][1]) + (v[j][2] * v[j][2] + v[j][3] * v[j][3]);
        const float rstd = rsqrtf(wave_sum(ss) * (1.f / D) + EPS);
#pragma unroll
        for (int j = 0; j < 4; ++j) {
            const f32x4 o = v[j] * rstd * gs[j] + sh[j];
            u32x2 w; w.x = cvt_pk_bf16(o[0], o[1]); w.y = cvt_pk_bf16(o[2], o[3]);
            *(u32x2*)(out + (size_t)row * D + 4 * lane + 256 * j) = w;
        }
    }
}

__device__ __forceinline__ void bias2_rows(const bf16_t* Wt, int nrows, const float* shift  , float* out, int out_ld, int lane, int wave) {
    const int gw = blockIdx.x * 8 + wave, NGW = gridDim.x * 8;
    if (gw >= nrows) return;
    float sh[8][16];
#pragma unroll
    for (int b = 0; b < 8; ++b)
#pragma unroll
        for (int q = 0; q < 4; ++q) { const f32x4 v = *(const f32x4*)(shift + (size_t)b * ADA_LD + 16 * lane + 4 * q); sh[b][4 * q] = v[0]; sh[b][4 * q + 1] = v[1]; sh[b][4 * q + 2] = v[2]; sh[b][4 * q + 3] = v[3]; }
    u32x4 n0 = *(const u32x4*)(Wt + (size_t)gw * D + 16 * lane), n1 = *(const u32x4*)(Wt + (size_t)gw * D + 16 * lane + 8);
    for (int r = gw; r < nrows; r += NGW) {
        const u32x4 w0 = n0, w1 = n1;
        if (r + NGW < nrows) { n0 = *(const u32x4*)(Wt + (size_t)(r + NGW) * D + 16 * lane); n1 = *(const u32x4*)(Wt + (size_t)(r + NGW) * D + 16 * lane + 8); }
        const unsigned ww[8] = {w0.x, w0.y, w0.z, w0.w, w1.x, w1.y, w1.z, w1.w};
        float wf[16];
#pragma unroll
        for (int i = 0; i < 8; ++i) { wf[2 * i] = bf2f(ww[i] & 0xffffu); wf[2 * i + 1] = bf2f(ww[i] >> 16); }
        float res = 0.f;
#pragma unroll
        for (int b = 0; b < 8; ++b) { float s = 0.f;
#pragma unroll
            for (int i = 0; i < 16; ++i) s += sh[b][i] * wf[i];
            s = wave_sum(s); if (lane == b) res = s; }
        if (lane < 8) out[(size_t)lane * out_ld + r] = res;
    }
}

__device__ __forceinline__ void logf_rows(const bf16_t* HKV, const bf16_t* Wf, const float* ssq2, const float* bias, int bias_ld, const float* fbias, float* logf, LAS unsigned char* lds, int tid, int lane, int w) {
    const int r32 = lane & 31, hh = lane >> 5;
    LAS float* part = (LAS float*)lds;
    for (int rt = blockIdx.x; rt < M / 64; rt += gridDim.x) {
        const size_t row0 = (size_t)rt * 64;
        f32x16 acc[2];
#pragma unroll
        for (int i = 0; i < 16; ++i) { acc[0][i] = 0.f; acc[1][i] = 0.f; }
        const bf16_t* ap = HKV + (row0 + r32) * 1024 + 128 * w + 8 * hh;
        const bf16_t* bp = Wf + (size_t)r32 * 1024 + 128 * w + 8 * hh;
#pragma unroll
        for (int ks = 0; ks < 8; ++ks) { const bf16x8 bf = *(const bf16x8*)(bp + 16 * ks);
#pragma unroll
            for (int rb = 0; rb < 2; ++rb) { const bf16x8 af = *(const bf16x8*)(ap + (size_t)rb * 32 * 1024 + 16 * ks); acc[rb] = __builtin_amdgcn_mfma_f32_32x32x16_bf16(af, bf, acc[rb], 0, 0, 0); } }
        __syncthreads();
        if (r32 < 16) {
#pragma unroll
            for (int rb = 0; rb < 2; ++rb)
#pragma unroll
                for (int i = 0; i < 16; ++i) part[(w * 64 + 32 * rb + (i & 3) + 8 * (i >> 2) + 4 * hh) * 16 + r32] = acc[rb][i];
        }
        __syncthreads();
        for (int o = tid; o < 1024; o += 512) {
            const int row = o >> 4, hd = o & 15;
            float s = 0.f;
#pragma unroll
            for (int ww = 0; ww < 8; ++ww) s += part[(ww * 64 + row) * 16 + hd];
            const f32x4* sp = (const f32x4*)(ssq2 + (row0 + row) * 16); const f32x4 a = sp[0], b = sp[1], c = sp[2], d = sp[3];
            const float q = ((a[0] + a[1]) + (a[2] + a[3])) + ((b[0] + b[1]) + (b[2] + b[3])) + ((c[0] + c[1]) + (c[2] + c[3])) + ((d[0] + d[1]) + (d[2] + d[3]));
            const float z = s * rsqrtf(q * (1.f / 1024.f) + EPS) + bias[(row0 >> 11) * bias_ld + hd] + fbias[hd];
            logf[(row0 + row) * 16 + hd] = fminf(z, 0.f) - log1pf(__expf(-fabsf(z)));
        }
    }
    __syncthreads();
}

#ifndef RET_PREF_K
#define RET_PREF_K 1
#endif
namespace ret {
constexpr int KP = 528, VP = 272, PP = 272, RP = 528;
constexpr int L_KC = 0, L_VT = 128 * KP, L_PS = L_VT + 64 * VP, L_RB = L_PS + 128 * PP, L_DEC = L_RB + 64 * RP, L_END = L_DEC + 1024;
static_assert(L_END <= XBST_OFF, "retention LDS");
__device__ __forceinline__ s16x4 tr_read(const LAS unsigned char* p) { return __builtin_bit_cast(s16x4, __builtin_amdgcn_ds_read_tr16_b64_v4i16((LAS s16x4*)p)); }

template <int CTRL, int RMASK> __device__ __forceinline__ float dpp_add(float v) { return v + __int_as_float(__builtin_amdgcn_update_dpp(0, __float_as_int(v), CTRL, RMASK, 0xf, true)); }
__device__ __forceinline__ float half_sum_hi(float v) { v = dpp_add<0x111, 0xf>(v); v = dpp_add<0x112, 0xf>(v); v = dpp_add<0x114, 0xf>(v); v = dpp_add<0x118, 0xf>(v); return dpp_add<0x142, 0xa>(v); }

__device__ __forceinline__ void unit(const bf16_t* Q, const bf16_t* Kr, const bf16_t* V, bf16_t* G, float* SSQ, const float* rgain, int b, int h, int vs, LAS unsigned char* lds, int tid, int lane, int w, bool dry = false) {
    const int r32 = lane & 31, hh = lane >> 5, rb = w & 3, cx = w >> 2;
    const float gam = 1.f - exp2f(-5.f - (float)h), lg = log2f(gam), gC = exp2f(128.f * lg);
    LAS float* kd = (LAS float*)(lds + L_DEC);
    LAS float* rs1 = (LAS float*)(lds + L_DEC + 512);
    __syncthreads();
    if (tid < 128) { kd[tid] = exp2f((float)(127 - tid) * lg); rs1[tid] = exp2f((float)(tid - 127) * lg); }
    f32x16 racc[2];
#pragma unroll
    for (int i = 0; i < 16; ++i) { racc[0][i] = 0.f; racc[1][i] = 0.f; }
    const int col = h * RDV + vs * 64 + cx * 32 + r32;
    const float gn = rgain[col];
    const int trrow = 8 * (lane >> 5) + ((lane & 15) >> 2), trcol = 16 * ((lane >> 4) & 1) + 4 * (lane & 3);
    const size_t row0 = (size_t)b * SEQ;
    const bf16_t* kg = Kr + (row0 + (tid >> 5)) * 1024 + h * RDK + 8 * (tid & 31);
    const bf16_t* vg = V + ((size_t)((b * 4 + h) * 8 + vs) * 16) * 8192 + (size_t)(tid >> 7) * 1024 + (tid & 127) * 8;
    const bf16_t* qg = Q + ((size_t)(b * 4 + h) * 64 + rb) * 8192 + hh * 256 + r32 * 8;
    u32x4 kreg[8], vreg[2]; bf16x8 qf[16];
#pragma unroll
    for (int i = 0; i < 8; ++i) kreg[i] = *(const u32x4*)(kg + (size_t)(16 * i) * 1024);
#pragma unroll
    for (int i = 0; i < 2; ++i) vreg[i] = __builtin_nontemporal_load((const u32x4*)(vg + (size_t)(4 * i) * 1024));
#pragma unroll
    for (int ks = 0; ks < 16; ++ks) qf[ks] = *(const bf16x8*)(qg + 512 * ks);
    for (int ch = 0; ch < NCH; ++ch) {
        const size_t rowbase = row0 + (size_t)ch * RC;
        const bool more = ch + 1 < NCH;
        __syncthreads();
#if !RET_PREF_K
        if (ch > 0) {
#pragma unroll
            for (int i = 0; i < 8; ++i) kreg[i] = *(const u32x4*)(kg + (size_t)(ch * RC + 16 * i) * 1024);
#pragma unroll
            for (int i = 0; i < 2; ++i) vreg[i] = *(const u32x4*)(vg + (size_t)(ch * RC + 64 * i) * RVW);
        }
#endif
#pragma unroll
        for (int i = 0; i < 8; ++i) *(LAS u32x4*)(lds + L_KC + ((tid >> 5) + 16 * i) * KP + 16 * (tid & 31)) = kreg[i];
#pragma unroll
        for (int i = 0; i < 2; ++i) { const int tok = tid & 127, c8 = (tid >> 7) + 4 * i;
            const unsigned wv[4] = {vreg[i].x, vreg[i].y, vreg[i].z, vreg[i].w};
#pragma unroll
            for (int e = 0; e < 4; ++e) {
                *(LAS unsigned short*)(lds + L_VT + (8 * c8 + 2 * e) * VP + tok * 2) = (unsigned short)(wv[e] & 0xffffu);
                *(LAS unsigned short*)(lds + L_VT + (8 * c8 + 2 * e + 1) * VP + tok * 2) = (unsigned short)(wv[e] >> 16);
            } }
#pragma unroll
        for (int vt = 0; vt < 2; ++vt) {
#pragma unroll
            for (int i = 0; i < 16; ++i) racc[vt][i] *= gC;
#pragma unroll
            for (int g = 0; g < 4; ++g) { u32x2 o; o.x = cvt_pk_bf16(racc[vt][4 * g], racc[vt][4 * g + 1]); o.y = cvt_pk_bf16(racc[vt][4 * g + 2], racc[vt][4 * g + 3]);
                *(LAS u32x2*)(lds + L_RB + (32 * vt + r32) * RP + (32 * w + 8 * g + 4 * hh) * 2) = o; }
        }
#if RET_PREF_K
        if (more) {
#pragma unroll
            for (int i = 0; i < 8; ++i) kreg[i] = *(const u32x4*)(kg + (size_t)((ch + 1) * RC + 16 * i) * 1024);
#pragma unroll
            for (int i = 0; i < 2; ++i) vreg[i] = __builtin_nontemporal_load((const u32x4*)(vg + (size_t)(ch + 1) * 8192 + (size_t)(4 * i) * 1024));
        }
#endif
        __syncthreads();
        __builtin_amdgcn_sched_barrier(0);
#pragma unroll
        for (int t = 0; t < 2; ++t) {
            const int cb = 2 * cx + t;
            if (cb <= rb) {
                f32x16 s;
#pragma unroll
                for (int i = 0; i < 16; ++i) s[i] = 0.f;
                const LAS unsigned char* kp = lds + L_KC + (32 * cb + r32) * KP + 16 * hh;
#pragma unroll
                for (int ks = 0; ks < 16; ++ks) { const bf16x8 kf = *(const LAS bf16x8*)(kp + 32 * ks); s = __builtin_amdgcn_mfma_f32_32x32x16_bf16(kf, qf[ks], s, 0, 0, 0); }
                if (cb == rb) {
#pragma unroll
                    for (int i = 0; i < 16; ++i) { const int key = (i & 3) + 8 * (i >> 2) + 4 * hh; if (key > r32) s[i] = 0.f; }
                }
#pragma unroll
                for (int g = 0; g < 4; ++g) { u32x2 o; o.x = cvt_pk_bf16(s[4 * g], s[4 * g + 1]); o.y = cvt_pk_bf16(s[4 * g + 2], s[4 * g + 3]);
                    *(LAS u32x2*)(lds + L_PS + (32 * rb + r32) * PP + (32 * cb + 8 * g + 4 * hh) * 2) = o; }
            }
        }
        __syncthreads();
        f32x16 o;
#pragma unroll
        for (int i = 0; i < 16; ++i) o[i] = 0.f;
        { const LAS unsigned char* rp = lds + L_RB + (32 * cx + r32) * RP + 16 * hh;
#pragma unroll
          for (int ks = 0; ks < 16; ++ks) { const bf16x8 rf = *(const LAS bf16x8*)(rp + 32 * ks); o = __builtin_amdgcn_mfma_f32_32x32x16_bf16(qf[ks], rf, o, 0, 0, 0); } }
        __builtin_amdgcn_sched_barrier(0);
        if (more) {
#pragma unroll
            for (int ks = 0; ks < 16; ++ks) qf[ks] = *(const bf16x8*)(qg + (size_t)(ch + 1) * 4 * 8192 + 512 * ks);
        }
        __builtin_amdgcn_sched_barrier(0);
        { const LAS unsigned char* pp = lds + L_PS + (32 * rb + r32) * PP + 16 * hh;
          const LAS unsigned char* vp = lds + L_VT + (32 * cx + r32) * VP + 16 * hh;
          const int nks = 2 * (rb + 1);
          for (int ks = 0; ks < nks; ++ks) { const bf16x8 pf = *(const LAS bf16x8*)(pp + 32 * ks), vf = *(const LAS bf16x8*)(vp + 32 * ks); o = __builtin_amdgcn_mfma_f32_32x32x16_bf16(pf, vf, o, 0, 0, 0); } }
#pragma unroll
        for (int ks = 0; ks < 8; ++ks) {
            const LAS unsigned char* kt = lds + L_KC + (16 * ks + trrow) * KP + (32 * w + trcol) * 2;
            const s16x4 lo = tr_read(kt), hi = tr_read(kt + 4 * KP);
            const bf16x8 af = (bf16x8){lo[0], lo[1], lo[2], lo[3], hi[0], hi[1], hi[2], hi[3]};
#pragma unroll
            for (int vt = 0; vt < 2; ++vt) { const bf16x8 vf = *(const LAS bf16x8*)(lds + L_VT + (32 * vt + r32) * VP + (16 * ks + 8 * hh) * 2);
                racc[vt] = __builtin_amdgcn_mfma_f32_32x32x16_bf16(af, vf, racc[vt], 0, 0, 0); }
        }
#pragma unroll
        for (int gb = 0; gb < 2; ++gb) {
            unsigned gz[8];
#pragma unroll
            for (int i = 0; i < 8; ++i) gz[i] = (unsigned)G[(rowbase + 32 * rb + (i & 3) + 8 * (2 * gb + (i >> 2)) + 4 * hh) * RVW + col];
#pragma unroll
            for (int g2 = 0; g2 < 2; ++g2) {
                const int g = 2 * gb + g2;
                const f32x4 rs = *(const LAS f32x4*)(rs1 + 32 * rb + 8 * g + 4 * hh);
#pragma unroll
                for (int j = 0; j < 4; ++j) {
                    const int q = 32 * rb + 8 * g + 4 * hh + j;
                    const float y = o[4 * g + j] * rs[j];
                    const float sq = half_sum_hi(y * y);
                    if (r32 == 31 && !dry) SSQ[(rowbase + q) * 64 + h * 16 + vs * 2 + cx] = sq;
                    const bf16_t ov = (bf16_t)f2bf(y * bf2f(gz[4 * g2 + j]) * gn);
                    if (!dry) G[(rowbase + q) * RVW + col] = ov;
                }
            }
        }
    }
}
}

namespace fox {
constexpr int TP = 144;
constexpr int L_K = 0, L_V = 2 * 128 * TP, L_KB = 4 * 128 * TP, L_WS = L_KB + SEQ * 4, L_SC = L_WS + 8 * 32 * 4, L_END = L_SC + 96;
__device__ __forceinline__ int crow(int r, int hi) { return (r & 3) + 8 * (r >> 2) + 4 * hi; }

__device__ __forceinline__ void prep(const float* logf, int b, int h, LAS unsigned char* lds, int tid, int lane, int w) {
    const size_t rowbase = (size_t)b * SEQ;
    LAS float* kb2 = (LAS float*)(lds + L_KB);
    LAS float* wsum = (LAS float*)(lds + L_SC);
    __syncthreads();
    float a[4];
#pragma unroll
    for (int i = 0; i < 4; ++i) a[i] = logf[(rowbase + 4 * tid + i) * 16 + h];
    a[1] += a[0]; a[2] += a[1]; a[3] += a[2];
    float x = a[3];
#pragma unroll
    for (int off = 1; off < 64; off <<= 1) { const float t = __shfl_up(x, off); if (lane >= off) x += t; }
    if (lane == 63) wsum[w] = x;
    __syncthreads();
    float pre = 0.f;
    for (int i = 0; i < w; ++i) pre += wsum[i];
    const float ex = pre + x - a[3];
    *(LAS f32x4*)(kb2 + 4 * tid) = (f32x4){-LOG2E * (ex + a[0]), -LOG2E * (ex + a[1]), -LOG2E * (ex + a[2]), -LOG2E * (ex + a[3])};
    __syncthreads();
}

__device__ __forceinline__ void unit(bf16_t* QY, const bf16_t* K, const bf16_t* V, const bf16_t* OG, float qk_bound, int b, int h, int qb, LAS unsigned char* lds, int tid, int lane, int w, bool dry = false) {
    const int r32 = lane & 31, hh = lane >> 5;
    const size_t rowbase = (size_t)b * SEQ; const int q0 = qb * 256;
    LAS float* kb2 = (LAS float*)(lds + L_KB);
    LAS float* wsf = (LAS float*)(lds + L_WS) + w * 32;
    LAS unsigned* flags = (LAS unsigned*)(lds + L_SC + 32);
    __syncthreads();
    bf16x8 qr[4];
    { const bf16_t* qp = QY + (rowbase + q0 + 32 * w + r32) * 1024 + h * FD + 8 * hh;
#pragma unroll
      for (int ks = 0; ks < 4; ++ks) qr[ks] = *(const bf16x8*)(qp + 16 * ks); }
    const int NT = 4 * (qb + 1), NP = NT / 2;
    const int srow = tid >> 3, sc8 = tid & 7;
    const bf16_t* kg = K + (rowbase + srow) * 1024 + h * FD + 8 * sc8;
    const bf16_t* vg = V + (rowbase + srow) * 1024 + h * FD + 8 * sc8;
    u32x4 kreg[2], vreg[2];
#pragma unroll
    for (int i = 0; i < 2; ++i) { kreg[i] = *(const u32x4*)(kg + (size_t)((NP - 1) * 128 + 64 * i) * 1024); vreg[i] = *(const u32x4*)(vg + (size_t)((NP - 1) * 128 + 64 * i) * 1024); }
#pragma unroll
    for (int i = 0; i < 2; ++i) { *(LAS u32x4*)(lds + L_K + (srow + 64 * i) * TP + 16 * sc8) = kreg[i]; *(LAS u32x4*)(lds + L_V + (srow + 64 * i) * TP + 16 * sc8) = vreg[i]; }
    __syncthreads();
    float m_run = -INFINITY, l_run = 0.f;
    f32x16 o[2];
#pragma unroll
    for (int i = 0; i < 16; ++i) { o[0][i] = 0.f; o[1][i] = 0.f; }
    const int qmin = q0 + 32 * w, query = qmin + r32;
    const int trrow = 4 * (lane >> 5) + ((lane & 15) >> 2), trcol = 16 * ((lane >> 4) & 1) + 4 * (lane & 3);
    bool wdone = false;
    int buf = 0;
#define FOX_TILE(t, kbuf, vbuf) do { \
        if (!wdone && 64 * t <= qmin + 31) { \
            f32x16 p[2]; \
_Pragma("unroll") \
            for (int half = 0; half < 2; ++half) { \
_Pragma("unroll") \
                for (int g = 0; g < 4; ++g) { const f32x4 kb = *(const LAS f32x4*)(kb2 + 64 * t + 32 * half + 8 * g + 4 * hh); \
                    p[half][4 * g] = kb[0]; p[half][4 * g + 1] = kb[1]; p[half][4 * g + 2] = kb[2]; p[half][4 * g + 3] = kb[3]; } \
_Pragma("unroll") \
                for (int ks = 0; ks < 4; ++ks) { const bf16x8 kf = *(const LAS bf16x8*)(kbuf + (32 * half + r32) * TP + (16 * ks + 8 * hh) * 2); \
                    p[half] = __builtin_amdgcn_mfma_f32_32x32x16_bf16(kf, qr[ks], p[half], 0, 0, 0); } \
            } \
            if (64 * t + 63 > qmin) { \
_Pragma("unroll") \
                for (int half = 0; half < 2; ++half) \
_Pragma("unroll") \
                    for (int i = 0; i < 16; ++i) { const int key = 64 * t + 32 * half + crow(i, hh); if (key > query) p[half][i] = -INFINITY; } \
            } \
            float mx = __builtin_fmaxf(__builtin_fmaxf(p[0][0], p[0][1]), p[1][0]); \
_Pragma("unroll") \
            for (int i = 2; i < 16; i += 2) mx = __builtin_fmaxf(__builtin_fmaxf(mx, p[0][i]), p[0][i + 1]); \
_Pragma("unroll") \
            for (int i = 1; i < 15; i += 2) mx = __builtin_fmaxf(__builtin_fmaxf(mx, p[1][i]), p[1][i + 1]); \
            mx = __builtin_fmaxf(mx, p[1][15]); \
            mx = fmaxf(mx, __shfl_xor(mx, 32)); \
            const float m_new = fmaxf(m_run, mx); \
            const float alpha = __builtin_amdgcn_exp2f(m_run - m_new); \
            const bool resc = __any(m_new > m_run); \
            m_run = m_new; \
            float ls = 0.f; \
_Pragma("unroll") \
            for (int half = 0; half < 2; ++half) \
_Pragma("unroll") \
                for (int i = 0; i < 16; ++i) { p[half][i] = __builtin_amdgcn_exp2f(p[half][i] - m_new); ls += p[half][i]; } \
            ls += __shfl_xor(ls, 32); \
            l_run = l_run * alpha + ls; \
            if (resc) { \
                if (hh == 0) wsf[r32] = alpha; \
                LDS_WAIT(); asm volatile("" ::: "memory"); \
_Pragma("unroll") \
                for (int g = 0; g < 4; ++g) { const f32x4 al = *(const LAS f32x4*)(wsf + 8 * g + 4 * hh); \
_Pragma("unroll") \
                    for (int j = 0; j < 4; ++j) { o[0][4 * g + j] *= al[j]; o[1][4 * g + j] *= al[j]; } } \
            } \
 \
_Pragma("unroll") \
            for (int half = 0; half < 2; ++half) \
_Pragma("unroll") \
                for (int s = 0; s < 2; ++s) { \
                    u32x4 pw; pw.x = cvt_pk_bf16(p[half][8 * s], p[half][8 * s + 1]); pw.y = cvt_pk_bf16(p[half][8 * s + 2], p[half][8 * s + 3]); \
                    pw.z = cvt_pk_bf16(p[half][8 * s + 4], p[half][8 * s + 5]); pw.w = cvt_pk_bf16(p[half][8 * s + 6], p[half][8 * s + 7]); \
                    const bf16x8 pf = __builtin_bit_cast(bf16x8, pw); \
                    const int kbase = 32 * half + 16 * s; \
_Pragma("unroll") \
                    for (int dt = 0; dt < 2; ++dt) { \
                        const LAS unsigned char* vp = vbuf + (kbase + trrow) * TP + (32 * dt + trcol) * 2; \
                        const s16x4 lo = ret::tr_read(vp), hi = ret::tr_read(vp + 8 * TP); \
                        const bf16x8 vf = (bf16x8){lo[0], lo[1], lo[2], lo[3], hi[0], hi[1], hi[2], hi[3]}; \
                        o[dt] = __builtin_amdgcn_mfma_f32_32x32x16_bf16(pf, vf, o[dt], 0, 0, 0); \
                    } \
                } \
 \
            if (t > 0) { const float nxt = kb2[64 * t - 1] + qk_bound + 64.f; \
                if (__all(nxt < m_run)) wdone = true; } \
        } \
    } while (0)
    for (int tp = NP - 1; tp >= 0; --tp, buf ^= 1) {
        if (tp > 0) {
#pragma unroll
            for (int i = 0; i < 2; ++i) { kreg[i] = *(const u32x4*)(kg + (size_t)((tp - 1) * 128 + 64 * i) * 1024); vreg[i] = *(const u32x4*)(vg + (size_t)((tp - 1) * 128 + 64 * i) * 1024); } }
        { const LAS unsigned char* kb1 = lds + L_K + (buf * 128 + 64) * TP; const LAS unsigned char* vb1 = lds + L_V + (buf * 128 + 64) * TP;
          const int t1 = 2 * tp + 1; FOX_TILE(t1, kb1, vb1); }
        { const LAS unsigned char* kb0 = lds + L_K + (buf * 128) * TP; const LAS unsigned char* vb0 = lds + L_V + (buf * 128) * TP;
          const int t0 = 2 * tp; FOX_TILE(t0, kb0, vb0); }
        if (lane == 0) flags[(tp & 1) * 8 + w] = wdone ? 1u : 0u;
        if (tp > 0) {
#pragma unroll
            for (int i = 0; i < 2; ++i) { *(LAS u32x4*)(lds + L_K + ((buf ^ 1) * 128 + srow + 64 * i) * TP + 16 * sc8) = kreg[i]; *(LAS u32x4*)(lds + L_V + ((buf ^ 1) * 128 + srow + 64 * i) * TP + 16 * sc8) = vreg[i]; } }
        __syncthreads();
        { const u32x4 f0 = *(const LAS u32x4*)(flags + (tp & 1) * 8), f1 = *(const LAS u32x4*)(flags + (tp & 1) * 8 + 4);
          if ((f0.x & f0.y & f0.z & f0.w & f1.x & f1.y & f1.z & f1.w) != 0u) break; }
    }
#undef FOX_TILE
    if (hh == 0) wsf[r32] = 1.f / l_run;
    LDS_WAIT(); asm volatile("" ::: "memory");
    unsigned ogv[2][16];
#pragma unroll
    for (int i = 0; i < 16; ++i)
#pragma unroll
        for (int dt = 0; dt < 2; ++dt) ogv[dt][i] = (unsigned)OG[(rowbase + q0 + 32 * w + (i & 3) + 8 * (i >> 2) + 4 * hh) * 1024 + h * FD + 32 * dt + r32];
#pragma unroll
    for (int g = 0; g < 4; ++g) { const f32x4 rl = *(const LAS f32x4*)(wsf + 8 * g + 4 * hh);
#pragma unroll
        for (int j = 0; j < 4; ++j) {
            const size_t row = rowbase + q0 + 32 * w + 8 * g + 4 * hh + j;
#pragma unroll
            for (int dt = 0; dt < 2; ++dt) { const size_t off = row * 1024 + h * FD + 32 * dt + r32;
                const bf16_t yv = (bf16_t)f2bf(o[dt][4 * g + j] * rl[j] * bf2f(ogv[dt][4 * g + j])); if (!dry) QY[off] = yv; }
        } }
}
}

#define XB_TMO      128
#define XB_XCNT(j)  (256  + 64 * (j))
#define XB_XSUB(j)  (1280 + 64 * (j))
#define XB_XGEN(j)  (2304 + 64 * (j))
#define XB_TOP      3328
#define XB_TOPGEN   3392
#define XCD_BAR_WORDS 3456
#define XB_SPIN_CAP (1u << 18)

__device__ __forceinline__ unsigned xb_ld(unsigned* p)              { return __hip_atomic_load(p, __ATOMIC_RELAXED, __HIP_MEMORY_SCOPE_AGENT); }
__device__ __forceinline__ unsigned xb_add(unsigned* p, unsigned v) { return __hip_atomic_fetch_add(p, v, __ATOMIC_RELAXED, __HIP_MEMORY_SCOPE_AGENT); }
__device__ __forceinline__ unsigned xb_xcc_id() { return (unsigned)__builtin_amdgcn_s_getreg((3 << 11) | 20) & 0xFu; }
#define XB_SPIN(cond, bar) do { unsigned _sp = 0; while (cond) { __builtin_amdgcn_s_sleep(1); \
    if ((++_sp & 255u) == 0u) { if (xb_ld(&(bar)[XB_TMO])) break; if (_sp > XB_SPIN_CAP) { atomicAdd(&(bar)[XB_TMO], 1u); break; } } } } while (0)

struct XcdBarrier {
    unsigned* bar; unsigned x;
    volatile LAS unsigned* st;
};

__device__ __forceinline__ XcdBarrier xcd_barrier_post(unsigned* bar, volatile LAS unsigned* st) {
    XcdBarrier b; b.bar = bar; b.x = xb_xcc_id(); b.st = st;
    if (threadIdx.x == 0) (void)xb_add(&bar[XB_XCNT(b.x)], 1u);
    return b;
}
__device__ __forceinline__ void xcd_barrier_complete(unsigned* bar, unsigned x, unsigned& nloc, unsigned& nx) {
    const unsigned G = gridDim.x * gridDim.y * gridDim.z;
    unsigned sum, cnt, mine, sp = 0u;
    for (;;) {
        sum = 0u; cnt = 0u; mine = 0u;
#pragma unroll
        for (unsigned j = 0; j < 16; ++j) { const unsigned c = xb_ld(&bar[XB_XCNT(j)]); sum += c; cnt += (c > 0u) ? 1u : 0u; mine = (j == x) ? c : mine; }
        if (sum == G) break;
        __builtin_amdgcn_s_sleep(1);
        if ((++sp & 255u) == 0u) { if (xb_ld(&bar[XB_TMO])) break; if (sp > XB_SPIN_CAP) { atomicAdd(&bar[XB_TMO], 1u); break; } }
    }
    nloc = mine > 0u ? mine : 1u; nx = cnt > 0u ? cnt : 1u;
}

__device__ __forceinline__ void xcd_barrier(const XcdBarrier& b) {
    asm volatile("s_waitcnt vmcnt(0)" ::: "memory");
    __syncthreads();
    if (threadIdx.x == 0) {
        unsigned* bar = b.bar;
        __builtin_amdgcn_s_waitcnt(0);
        unsigned nloc = b.st[0], nx = b.st[1];
        if (nloc == 0u) { xcd_barrier_complete(bar, b.x, nloc, nx); b.st[0] = nloc; b.st[1] = nx; }
        const unsigned old = xb_add(&bar[XB_XSUB(b.x)], 1u);
        const unsigned gen = old / nloc;
        if (old + 1u == (gen + 1u) * nloc) {
            __builtin_amdgcn_fence(__ATOMIC_RELEASE, "agent");
            asm volatile("s_waitcnt vmcnt(0)" ::: "memory");
            const unsigned og = xb_add(&bar[XB_TOP], 1u);
            const unsigned tg = og / nx;
            if (og + 1u == (tg + 1u) * nx) xb_add(&bar[XB_TOPGEN], 1u);
            else XB_SPIN(xb_ld(&bar[XB_TOPGEN]) == tg, bar);
            __builtin_amdgcn_fence(__ATOMIC_ACQUIRE, "agent");
            xb_add(&bar[XB_XGEN(b.x)], 1u);
            asm volatile("s_waitcnt vmcnt(0)" ::: "memory");
        } else {
            XB_SPIN(xb_ld(&bar[XB_XGEN(b.x)]) == gen, bar);
            __builtin_amdgcn_fence(__ATOMIC_ACQUIRE, "agent");
            asm volatile("s_waitcnt vmcnt(0)" ::: "memory");
        }
    }
    __syncthreads();
}

__global__ void __launch_bounds__(512, 2) yoco_fwd(Args a) {
    extern __shared__ __attribute__((aligned(16))) unsigned char lds_raw[];
    LAS unsigned char* lds = (LAS unsigned char*)lds_raw;
    cg::grid_group grid = cg::this_grid();
    int tid = threadIdx.x, lane = tid & 63, wave = __builtin_amdgcn_readfirstlane(tid >> 6);
#define FENCE() do { asm volatile("" : "+v"(tid)); lane = tid & 63; wave = __builtin_amdgcn_readfirstlane(tid >> 6); } while (0)
#define GSYNC_CG() do { if (G > (1 << 20)) grid.sync(); xcd_barrier(xbar); FENCE(); } while (0)
#define GSYNC() do { xcd_barrier(xbar); FENCE(); } while (0)
    const int G = gridDim.x, bx = blockIdx.x;
    const int vcu = (G % 8 == 0) ? (bx % 8) * (G / 8) + bx / 8 : bx;
    unsigned char* ws = a.ws;
    volatile LAS unsigned* bst = (volatile LAS unsigned*)(lds + XBST_OFF);
    if (tid < 2) bst[tid] = 0u;
    __syncthreads();
    const XcdBarrier xbar = xcd_barrier_post((unsigned*)(ws + WS_CTL), bst);
    float* ADA = (float*)(ws + WS_ADA);
    float* LOGF = (float*)(ws + WS_LOGF);
    float* SSQ = (float*)(ws + WS_SSQ);
    bf16_t* HN = (bf16_t*)(ws + WS_HN);
    bf16_t* HKV = (bf16_t*)(ws + WS_HKV);
    bf16_t* BIG = (bf16_t*)(ws + WS_BIG);
    bf16_t* RQ = (bf16_t*)a.out;
    bf16_t* RK = RQ + (size_t)M * 1024;
    bf16_t* RV = BIG;
    bf16_t* RG = BIG + (size_t)M * 2048;
    bf16_t* HID = BIG;
    bf16_t* KSH = BIG, *VSH = BIG + (size_t)M * 1024, *QY = BIG + (size_t)2 * M * 1024, *OG = BIG + (size_t)3 * M * 1024;
    const float* A0 = ADA, *A1 = ADA + 6144, *AKV = ADA + 12288;
    float* SSQ2 = (float*)(ws + WS_SSQ2);
    bf16_t* XB = (bf16_t*)a.out;
    bf16_t* XB2 = HKV;
    LAS float* wscr = (LAS float*)(lds + WSCR_OFF);

#ifndef EXTRA_P0
#define EXTRA_P0 0
#endif
    for (int rep = EXTRA_P0; rep >= 0; --rep) { phase0(a, lds, tid, lane, wave); __syncthreads(); }
    GSYNC_CG();
    norm_rows(a.x, a.nmg, A0, A0 + 1024, HN, lane, wave);
    { float* B2 = (float*)(ws + WS_BIAS2);
      bias2_rows((const bf16_t*)(ws + WS_WM1_0), FF, A0 + 3072, B2 + B2_MLP0, FF, lane, wave);
      bias2_rows((const bf16_t*)(ws + WS_WM1_1), FF, A1 + 3072, B2 + B2_MLP1, FF, lane, wave);
      bias2_rows((const bf16_t*)(ws + WS_WKV), 2 * D + 256, AKV, B2 + B2_KV, 2 * D + 256, lane, wave);
      bias2_rows((const bf16_t*)(ws + WS_WFIN), 2 * D, A1, B2 + B2_FOX, 2 * D, lane, wave); }
    GSYNC();
    { pg8::Gemm g{HN, (const bf16_t*)(ws + WS_WRIN), M, RIN, D}; pg8::StaticOrder S; S.init(M, RIN, G, bx);
      pg8::EpiRetIn E{RQ, RK, RV, RG, (const float*)(ws + WS_TAB), a.pos};
      pg8::gemm_phase<pg8::EpiRetIn, pg8::StaticOrder, true, true>(lds, g, S, E, tid); }
    GSYNC();
#ifndef EXTRA_P3
#define EXTRA_P3 0
#endif
    for (int rep = EXTRA_P3; rep >= 0; --rep)
    for (int u = vcu; u < BATCH * RH * 8; u += G) ret::unit(RQ, RK, RV, RG, SSQ, a.ret_ng, u >> 5, (u >> 3) & 3, u & 7, lds, tid, lane, wave, rep > 0 && G < 100000);
    GSYNC();
    { pg8::Gemm g{RG, (const bf16_t*)(ws + WS_WROUT), M, D, RVW}; pg8::StaticOrder S; S.init(M, D, G, bx);
      LAS float* rtab = (LAS float*)(lds + RTAB_OFF);
      pg8::Unit u;
      for (int i = 0; S.next(i, u); ++i) {
          __syncthreads();
          { const int r = tid >> 1, h0 = (tid & 1) * 2; const float* sp = SSQ + ((size_t)(u.pm * 256 + r) * 4 + h0) * 16;
#pragma unroll
            for (int hh = 0; hh < 2; ++hh) { float s = 0.f;
#pragma unroll
                for (int k = 0; k < 4; ++k) { const f32x4 v = *(const f32x4*)(sp + hh * 16 + 4 * k); s += (v[0] + v[1]) + (v[2] + v[3]); }
                rtab[r * 4 + h0 + hh] = rsqrtf(s * (1.f / RDV) + EPS); } }
          __syncthreads();
          pg8::OneUnit S1{u}; pg8::EpiRes<true, 1, false, true> E{a.x, XB, A0 + 2048, ADA_LD, rtab, {HN, nullptr}, {a.nlg, nullptr}, {A0 + 4096, nullptr}, SSQ2};
          pg8::gemm_phase<pg8::EpiRes<true, 1, false, true>, pg8::OneUnit, false, true>(lds, g, S1, E, tid);
      } }
    GSYNC();
#if defined(STOP_AFTER) && STOP_AFTER == 4
    return;
#endif
#ifndef EXTRA_P6
#define EXTRA_P6 0
#endif
#ifndef EXTRA_NORM
#define EXTRA_NORM 0
#endif
#ifndef EXTRA_SYNC
#define EXTRA_SYNC 0
#endif
#define MLP_IN(WM1, B2OFF) do { \
    { pg8::Gemm g{HN, (const bf16_t*)(ws + (WM1)), M, FF, D}; pg8::StaticOrder S; S.init(M, FF, G, bx); pg8::EpiSqRelu E{HID, SSQ2, (const float*)(ws + WS_BIAS2) + (B2OFF), wscr}; \
      pg8::gemm_phase<pg8::EpiSqRelu, pg8::StaticOrder, true, true>(lds, g, S, E, tid); } \
    GSYNC(); } while (0)
    MLP_IN(WS_WM1_0, B2_MLP0);
    { pg8::Gemm g{HID, (const bf16_t*)(ws + WS_WM2_0), M, D, FF}; pg8::StaticOrder S; S.init(M, D, G, bx);
      pg8::EpiRes<false, 2, true, true> E{XB, XB, A0 + 5120, ADA_LD, nullptr, {HKV, HN}, {a.kv_ng, a.nmg + D}, {AKV + 1024, A1 + 1024}, SSQ2};
      pg8::gemm_phase<pg8::EpiRes<false, 2, true, true>, pg8::StaticOrder, true, true>(lds, g, S, E, tid); }
    GSYNC();
#if defined(STOP_AFTER) && STOP_AFTER == 7
    return;
#endif
    logf_rows(HKV, (const bf16_t*)(ws + WS_WKV) + (size_t)2048 * D, SSQ2, (const float*)(ws + WS_BIAS2) + B2_KV + 2048, 2 * D + 256, a.fbias, LOGF, lds, tid, lane, wave);
    { pg8::Gemm g{HKV, (const bf16_t*)(ws + WS_WKV), M, 2 * D, D}; pg8::StaticOrder S; S.init(M, 2 * D, G, bx);
      pg8::EpiHeads<0> E{KSH, VSH, a.k_ng, 1.f, LOGF, a.fbias, SSQ2, (const float*)(ws + WS_BIAS2) + B2_KV, 2 * D + 256, wscr};
      pg8::gemm_phase<pg8::EpiHeads<0>, pg8::StaticOrder, true, true>(lds, g, S, E, tid); }
    FENCE();
    { pg8::Gemm g{HN, (const bf16_t*)(ws + WS_WFIN), M, 2 * D, D}; pg8::StaticOrder S; S.init(M, 2 * D, G, bx);
      pg8::EpiHeads<1> E{QY, OG, a.q_ng, QSCALE, nullptr, nullptr, SSQ2, (const float*)(ws + WS_BIAS2) + B2_FOX, 2 * D, wscr};
      pg8::gemm_phase<pg8::EpiHeads<1>, pg8::StaticOrder, true, true>(lds, g, S, E, tid); }
    GSYNC();
#ifndef SKIP_ATTN
#ifndef EXTRA_P10
#define EXTRA_P10 0
#endif
    float qk_bound;
    { float gq = fabsf(a.q_ng[lane]), gk = fabsf(a.k_ng[lane]);
#pragma unroll
      for (int o = 1; o < 64; o <<= 1) { gq = fmaxf(gq, __shfl_xor(gq, o)); gk = fmaxf(gk, __shfl_xor(gk, o)); }
      qk_bound = 64.f * gq * gk * QSCALE * 1.02f; }
    for (int rep = EXTRA_P10; rep >= 0; --rep)
    for (int it = vcu; it < 256; it += G) {
        const int bh = it >> 1;
        fox::prep(LOGF, bh >> 4, bh & 15, lds, tid, lane, wave);
#pragma unroll 1
        for (int i = 0; i < 4; ++i) { const int s = (i >> 1) ? 3 - (it & 1) : (it & 1), qb = (i & 1) ? 7 - s : s;
            fox::unit(QY, KSH, VSH, OG, qk_bound, bh >> 4, bh & 15, qb, lds, tid, lane, wave, rep > 0 && G < 100000); }
    }
#endif
    GSYNC();
    { pg8::Gemm g{QY, (const bf16_t*)(ws + WS_WFOUT), M, D, D}; pg8::StaticOrder S; S.init(M, D, G, bx); pg8::EpiRes<false, 1, true, true> E{XB, XB2, A1 + 2048, ADA_LD, nullptr, {HN, nullptr}, {a.nlg + D, nullptr}, {A1 + 4096, nullptr}, SSQ2};
      pg8::gemm_phase<pg8::EpiRes<false, 1, true, true>, pg8::StaticOrder, true, true>(lds, g, S, E, tid); }
    GSYNC();
#if defined(STOP_AFTER) && STOP_AFTER == 11
    return;
#endif
    MLP_IN(WS_WM1_1, B2_MLP1);
    { pg8::Gemm g{HID, (const bf16_t*)(ws + WS_WM2_1), M, D, FF}; pg8::StaticOrder S; S.init(M, D, G, bx);
      pg8::EpiRes<false, 0, true, false> E{XB2, a.out, A1 + 5120, ADA_LD, nullptr, {nullptr, nullptr}, {nullptr, nullptr}, {nullptr, nullptr}, nullptr};
      pg8::gemm_phase<pg8::EpiRes<false, 0, true, false>, pg8::StaticOrder, true, true>(lds, g, S, E, tid); }
#undef MLP_IN
}

extern "C" void kernel_launch(void* const* d_in, const int* in_sizes, int n_in, void* d_out, int out_size, void* d_ws, size_t ws_size, hipStream_t stream) {
    static int grid = 0;
    if (grid == 0) {
        if (n_in != 21 || in_sizes[0] != M * D || out_size != M * D || ws_size < WS_END) { fprintf(stderr, "kernel_launch: unexpected shapes (n_in %d, x %d, out %d, ws %zu)\n", n_in, n_in > 0 ? in_sizes[0] : -1, out_size, ws_size); grid = -1; return; }
        int dev = 0, cus = 0, per_cu = 0;
        if (hipGetDevice(&dev) != hipSuccess || hipDeviceGetAttribute(&cus, hipDeviceAttributeMultiprocessorCount, dev) != hipSuccess) { grid = -1; return; }
        if (hipFuncSetAttribute((const void*)yoco_fwd, hipFuncAttributeMaxDynamicSharedMemorySize, LDS_BYTES) != hipSuccess) { fprintf(stderr, "kernel_launch: hipFuncSetAttribute failed\n"); grid = -1; return; }
        if (hipOccupancyMaxActiveBlocksPerMultiprocessor(&per_cu, (const void*)yoco_fwd, 512, LDS_BYTES) != hipSuccess || per_cu < 1) per_cu = 1;
        (void)hipGetLastError();
        grid = cus * per_cu; if (grid > 256) grid = 256;
    }
    if (grid < 0) return;
    Args p{};
    p.x = (const float*)d_in[0]; p.c = (const float*)d_in[1]; p.pos = (const int*)d_in[2];
    p.nmg = (const float*)d_in[3]; p.nlg = (const float*)d_in[4]; p.w_ada = (const float*)d_in[5]; p.b_ada = (const float*)d_in[6];
    p.w_mlp_in = (const float*)d_in[7]; p.w_mlp_out = (const float*)d_in[8]; p.ret_w_in = (const float*)d_in[9]; p.ret_ng = (const float*)d_in[10];
    p.ret_w_out = (const float*)d_in[11]; p.kv_ng = (const float*)d_in[12]; p.kv_w_ada = (const float*)d_in[13]; p.kv_b_ada = (const float*)d_in[14];
    p.kv_w = (const float*)d_in[15]; p.fbias = (const float*)d_in[16]; p.k_ng = (const float*)d_in[17]; p.fox_w_in = (const float*)d_in[18];
    p.q_ng = (const float*)d_in[19]; p.fox_w_out = (const float*)d_in[20];
    p.out = (float*)d_out; p.ws = (unsigned char*)d_ws;
    if (hipMemsetAsync((char*)d_ws + WS_CTL, 0, CTL_ZERO_BYTES, stream) != hipSuccess) { fprintf(stderr, "kernel_launch: memset failed\n"); return; }
    void* args[] = {&p};
    const hipError_t e = hipLaunchCooperativeKernel((const void*)yoco_fwd, dim3(grid), dim3(512), args, LDS_BYTES, stream);
    if (e != hipSuccess) fprintf(stderr, "kernel_launch: cooperative launch failed: %s (grid %d)\n", hipGetErrorString(e), grid);
}
```

```cpp
#include <hip/hip_runtime.h>
#include <hip/hip_cooperative_groups.h>
#include <cstdio>
#include <cstdint>
namespace cg = cooperative_groups;

namespace pg8 {
#define PG8_LAS __attribute__((address_space(3)))
typedef unsigned short bf16_t;
typedef short bf16x8 __attribute__((ext_vector_type(8)));
typedef float f32x4 __attribute__((ext_vector_type(4)));
typedef unsigned u32x4 __attribute__((ext_vector_type(4)));
constexpr int BM = 256, BK = 64, HALF = 128, HTB = HALF * BK * 2  , STAGE_BYTES = 8 * HTB, NXCD = 8, WGM = 8;

__host__ __device__ __forceinline__ int lds_byte(int r, int c) { const int st = (r >> 4) * 2 + (c >> 5), rr = r & 15, cc = c & 31, ob = rr * 64 + cc * 2; return st * 1024 + (ob ^ (((ob >> 9) & 1) << 5)); }
__host__ __device__ __forceinline__ void stage_rc(int b, int& R, int& C) { const int st = b / 1024, sb = b % 1024, swz = sb ^ (((sb >> 9) & 1) << 5); R = (st >> 1) * 16 + swz / 64; C = (st & 1) * 32 + (swz % 64) / 2; }
__host__ __device__ __forceinline__ int perm32(int rho) { const int n = rho >> 4, i = rho & 15; return 8 * (i >> 2) + 4 * n + (i & 3); }

struct Unit { int pm, pn; };
struct Gemm { const bf16_t* A; const bf16_t* Bt; int M, N, K; };

struct StaticOrder {
    int nM, nN, nwg, G, c;
    __host__ __device__ void init(int M, int N, int G_, int c_) { nM = M / BM; nN = N / BM; nwg = nM * nN; G = G_; c = c_; }
    __host__ __device__ bool next(int i, Unit& u) const {
        const long L = (long)i * G + c; if (L >= nwg) return false;
        int wgid = (int)L; { const int q = nwg / NXCD, r = nwg % NXCD, xcd = wgid % NXCD, off = wgid / NXCD; wgid = (xcd < r ? xcd * (q + 1) : r * (q + 1) + (xcd - r) * q) + off; }
        const int nig = WGM * nN, gid = wgid / nig, fm = gid * WGM, gsz = (nM - fm) < WGM ? (nM - fm) : WGM;
        u.pm = fm + ((wgid % nig) % gsz); u.pn = (wgid % nig) / gsz; return true;
    }
    __device__ __forceinline__ void a_ready(const Unit&) const {}
    __device__ __forceinline__ void done(const Unit&) const {}
};

typedef float f32x2 __attribute__((ext_vector_type(2)));
typedef __bf16 bf16x2_t __attribute__((ext_vector_type(2)));
__device__ __forceinline__ unsigned cvt_pk_bf16(float lo, float hi) { const f32x2 v = {lo, hi}; const bf16x2_t b = __builtin_convertvector(v, bf16x2_t); return __builtin_bit_cast(unsigned, b); }
typedef unsigned u32x2 __attribute__((ext_vector_type(2)));
__device__ __forceinline__ u32x4 pack8(f32x4 v0, f32x4 v1) { u32x4 w; w.x = cvt_pk_bf16(v0[0], v0[1]); w.y = cvt_pk_bf16(v0[2], v0[3]); w.z = cvt_pk_bf16(v1[0], v1[1]); w.w = cvt_pk_bf16(v1[2], v1[3]); return w; }
__device__ __forceinline__ float fast_sigmoid(float v) { return __builtin_amdgcn_rcpf(1.f + __expf(-v)); }

struct EpiRetIn {
    static constexpr bool PERM = true, AFTER_DRAIN = false, KHOOK = false;
    bf16_t *Q, *Kr, *V, *G; const float* tab; const int* pos;
    __device__ __forceinline__ void operator()(const f32x4 (&acc)[2][2][4][2], const Unit& u, int wr, int wc, int fr, int fq) const {
        const int row0 = u.pm * BM + wr * 64 + fr, cw = wc * 32 + 8 * fq;
        if (u.pn < 8) {
            const bool isk = u.pn >= 4; bf16_t* base = (isk ? Kr : Q) + (u.pn & 3) * 256 + cw; const float sc = isk ? 0.0625f : 1.f;
            f32x4 fh[2], fl[2];
            fh[0] = *(const f32x4*)(tab + cw); fh[1] = *(const f32x4*)(tab + cw + 4); fl[0] = *(const f32x4*)(tab + 128 + cw); fl[1] = *(const f32x4*)(tab + 128 + cw + 4);
            int pv[8];
#pragma unroll
            for (int i = 0; i < 8; ++i) pv[i] = pos[row0 + (i >> 2) * HALF + (i & 3) * 16];
#pragma unroll
            for (int ai = 0; ai < 2; ++ai) {
#pragma unroll
                for (int m = 0; m < 4; ++m) {
                    const int row = row0 + ai * HALF + m * 16;
                    const float pf = (float)pv[ai * 4 + m];
                    f32x4 tcs[4];
#pragma unroll
                    for (int e = 0; e < 8; ++e) { const float hi_ = fh[e >> 2][e & 3], lo_ = fl[e >> 2][e & 3];
                        const float a = pf * hi_, er = fmaf(pf, hi_, -a);
                        const float rev = (a - floorf(a)) + fmaf(pf, lo_, er);
                        tcs[e >> 1][2 * (e & 1)] = __builtin_amdgcn_cosf(rev); tcs[e >> 1][2 * (e & 1) + 1] = __builtin_amdgcn_sinf(rev); }
                    const f32x4 t0 = tcs[0], t1 = tcs[1], t2 = tcs[2], t3 = tcs[3];
                    const f32x4 xa = acc[ai][0][m][0] * sc, xb = acc[ai][0][m][1] * sc, ya = acc[ai][1][m][0] * sc, yb = acc[ai][1][m][1] * sc;
                    f32x4 o1a, o1b, o2a, o2b;
                    o1a[0] = xa[0] * t0[0] - ya[0] * t0[1]; o2a[0] = xa[0] * t0[1] + ya[0] * t0[0];
                    o1a[1] = xa[1] * t0[2] - ya[1] * t0[3]; o2a[1] = xa[1] * t0[3] + ya[1] * t0[2];
                    o1a[2] = xa[2] * t1[0] - ya[2] * t1[1]; o2a[2] = xa[2] * t1[1] + ya[2] * t1[0];
                    o1a[3] = xa[3] * t1[2] - ya[3] * t1[3]; o2a[3] = xa[3] * t1[3] + ya[3] * t1[2];
                    o1b[0] = xb[0] * t2[0] - yb[0] * t2[1]; o2b[0] = xb[0] * t2[1] + yb[0] * t2[0];
                    o1b[1] = xb[1] * t2[2] - yb[1] * t2[3]; o2b[1] = xb[1] * t2[3] + yb[1] * t2[2];
                    o1b[2] = xb[2] * t3[0] - yb[2] * t3[1]; o2b[2] = xb[2] * t3[1] + yb[2] * t3[0];
                    o1b[3] = xb[3] * t3[2] - yb[3] * t3[3]; o2b[3] = xb[3] * t3[3] + yb[3] * t3[2];
                    if (isk) { bf16_t* rp = base + (size_t)row * 1024;
                        *(u32x4*)(rp) = pack8(o1a, o1b); *(u32x4*)(rp + 128) = pack8(o2a, o2b); }
                    else {
                        bf16_t* rp = Q + ((size_t)((row >> 11) * 4 + (u.pn & 3)) * 64 + ((row >> 5) & 63)) * 8192 + (cw >> 4) * 512 + ((cw >> 3) & 1) * 256 + (row & 31) * 8;
                        *(u32x4*)(rp) = pack8(o1a, o1b); *(u32x4*)(rp + 8 * 512) = pack8(o2a, o2b); }
                }
                asm volatile("" ::: "memory");
            }
        } else if (u.pn < 16) {
            const int ct = u.pn - 8, hd = ct >> 1;
            const float lg = log2f(1.f - exp2f(-5.f - (float)hd));
#pragma unroll
            for (int ai = 0; ai < 2; ++ai)
#pragma unroll
                for (int m = 0; m < 4; ++m) {
                    const int row = row0 + ai * HALF + m * 16, tok = row & 127;
                    const float kd = exp2f((float)(127 - tok) * lg);
#pragma unroll
                    for (int bj = 0; bj < 2; ++bj) {
                        const int c0 = ct * 256 + bj * HALF + cw;
                        bf16_t* rp = V + ((((size_t)((row >> 11) * 4 + hd) * 8 + ((c0 >> 6) & 7)) * 16 + ((row >> 7) & 15)) * 8 + ((c0 >> 3) & 7)) * 1024 + tok * 8;
                        *(u32x4*)rp = pack8(acc[ai][bj][m][0] * kd, acc[ai][bj][m][1] * kd);
                    }
                }
        } else {
            const bool isg = true; bf16_t* base = G + (u.pn - 16) * 256 + cw;
#pragma unroll
            for (int ai = 0; ai < 2; ++ai)
#pragma unroll
                for (int m = 0; m < 4; ++m) {
                    bf16_t* rp = base + (size_t)(row0 + ai * HALF + m * 16) * 2048;
#pragma unroll
                    for (int bj = 0; bj < 2; ++bj) {
                        f32x4 v0 = acc[ai][bj][m][0], v1 = acc[ai][bj][m][1];
                        if (isg) {
#pragma unroll
                            for (int j = 0; j < 4; ++j) { v0[j] = v0[j] * fast_sigmoid(v0[j]); v1[j] = v1[j] * fast_sigmoid(v1[j]); }
                        }
                        *(u32x4*)(rp + bj * HALF) = pack8(v0, v1);
                    }
                }
        }
    }
};

template <bool HOOK, int NOUT, bool RIN16, bool ROUT16> struct EpiRes {
    static constexpr bool PERM = true, AFTER_DRAIN = false, KHOOK = HOOK;
    const void* resid; void* out; const float* gate; int gate_ld; const PG8_LAS float* rtab;
    bf16_t* hout[2]; const float* hgain[2]; const float* hscale[2]; float* ssq2;
    __device__ __forceinline__ void khook(f32x4 (&acc)[2][2][4][2], int seg, int wr, int fr) const {
#pragma unroll
        for (int ai = 0; ai < 2; ++ai)
#pragma unroll
            for (int m = 0; m < 4; ++m) {
                const int r = ai * HALF + wr * 64 + m * 16 + fr;
                const float f = rtab[r * 4 + seg] / rtab[r * 4 + seg + 1];
#pragma unroll
                for (int bj = 0; bj < 2; ++bj)
#pragma unroll
                    for (int n = 0; n < 2; ++n) acc[ai][bj][m][n] = acc[ai][bj][m][n] * f;
            }
    }
    __device__ __forceinline__ void operator()(const f32x4 (&acc)[2][2][4][2], const Unit& u, int wr, int wc, int fr, int fq) const {
        const int b = u.pm >> 3, col0 = u.pn * BM + wc * 32 + 8 * fq;
        f32x4 gv[2][2]; f32x4 gs[NOUT > 0 ? NOUT : 1][2][2];
#pragma unroll
        for (int bj = 0; bj < 2; ++bj)
#pragma unroll
            for (int n = 0; n < 2; ++n) { const int c = col0 + bj * HALF + 4 * n;
                gv[bj][n] = *(const f32x4*)(gate + (size_t)b * gate_ld + c);
#pragma unroll
                for (int i = 0; i < NOUT; ++i) gs[i][bj][n] = *(const f32x4*)(hgain[i] + c) * (*(const f32x4*)(hscale[i] + (size_t)b * gate_ld + c) + 1.f); }
#pragma unroll
        for (int ai = 0; ai < 2; ++ai) {
            constexpr int MB = RIN16 ? 2 : 1;
#pragma unroll
            for (int mb = 0; mb < 4; mb += MB) {
                u32x4 raw[MB][2][RIN16 ? 1 : 2];
#pragma unroll
                for (int mm = 0; mm < MB; ++mm) {
                    const size_t off = (size_t)(u.pm * BM + ai * HALF + wr * 64 + (mb + mm) * 16 + fr) * 1024 + col0;
#pragma unroll
                    for (int bj = 0; bj < 2; ++bj) {
                        if (RIN16) raw[mm][bj][0] = __builtin_nontemporal_load((const u32x4*)((const bf16_t*)resid + off + bj * HALF));
                        else { raw[mm][bj][0] = __builtin_nontemporal_load((const u32x4*)((const float*)resid + off + bj * HALF)); raw[mm][bj][RIN16 ? 0 : 1] = __builtin_nontemporal_load((const u32x4*)((const float*)resid + off + bj * HALF + 4)); }
                    }
                }
#pragma unroll
                for (int mm = 0; mm < MB; ++mm) {
                    const int m = mb + mm;
                    const int rl = ai * HALF + wr * 64 + m * 16 + fr;
                    float rs = 1.f; if (HOOK) rs = rtab[rl * 4 + 3];
                    const size_t off = (size_t)(u.pm * BM + rl) * 1024 + col0;
                    float ss = 0.f;
#pragma unroll
                    for (int bj = 0; bj < 2; ++bj) {
                        f32x4 r[2];
                        if (RIN16) { const u32x4 rw = raw[mm][bj][0];
                            r[0] = (f32x4){__uint_as_float(rw.x << 16), __uint_as_float(rw.x & 0xffff0000u), __uint_as_float(rw.y << 16), __uint_as_float(rw.y & 0xffff0000u)};
                            r[1] = (f32x4){__uint_as_float(rw.z << 16), __uint_as_float(rw.z & 0xffff0000u), __uint_as_float(rw.w << 16), __uint_as_float(rw.w & 0xffff0000u)}; }
                        else { r[0] = __builtin_bit_cast(f32x4, raw[mm][bj][0]); r[1] = __builtin_bit_cast(f32x4, raw[mm][bj][RIN16 ? 0 : 1]); }
                        f32x4 o[2];
#pragma unroll
                        for (int n = 0; n < 2; ++n) {
                            o[n] = r[n] + gv[bj][n] * (acc[ai][bj][m][n] * rs);
                            if (!ROUT16) *(f32x4*)((float*)out + off + bj * HALF + 4 * n) = o[n];
                            if (NOUT > 0) ss += (o[n][0] * o[n][0] + o[n][1] * o[n][1]) + (o[n][2] * o[n][2] + o[n][3] * o[n][3]);
                        }
                        if (ROUT16) *(u32x4*)((bf16_t*)out + off + bj * HALF) = pack8(o[0], o[1]);
#pragma unroll
                        for (int i = 0; i < NOUT; ++i) *(u32x4*)(hout[i] + off + bj * HALF) = pack8(o[0] * gs[i][bj][0], o[1] * gs[i][bj][1]);
                    }
                    if (NOUT > 0) { ss += __shfl_xor(ss, 16); ss += __shfl_xor(ss, 32);
                        if (fq == 0) ssq2[(size_t)(u.pm * BM + rl) * 16 + u.pn * 4 + wc] = ss; }
                }
                asm volatile("" ::: "memory");
            }
        }
    }
};

__device__ __forceinline__ void wave_rstd(const float* ssq2, PG8_LAS float* scr, int pm, int wr, int lane) {
#pragma unroll
    for (int t = 0; t < 2; ++t) { const int e = lane + 64 * t; const size_t row = (size_t)pm * BM + HALF * t + 64 * wr + lane;
        const f32x4* p = (const f32x4*)(ssq2 + row * 16); const f32x4 a = p[0], b = p[1], c = p[2], d = p[3];
        const float s = ((a[0] + a[1]) + (a[2] + a[3])) + ((b[0] + b[1]) + (b[2] + b[3])) + ((c[0] + c[1]) + (c[2] + c[3])) + ((d[0] + d[1]) + (d[2] + d[3]));
        scr[e] = rsqrtf(s * (1.f / 1024.f) + 1e-6f); }
    asm volatile("s_waitcnt lgkmcnt(0)" ::: "memory");
}

struct EpiSqRelu {
    static constexpr bool PERM = true, AFTER_DRAIN = false, KHOOK = false;
    bf16_t* O; const float* ssq2; const float* bias2; PG8_LAS float* scr0;
    __device__ __forceinline__ void operator()(const f32x4 (&acc)[2][2][4][2], const Unit& u, int wr, int wc, int fr, int fq) const {
        const int row0 = u.pm * BM + wr * 64 + fr, col0 = u.pn * BM + wc * 32 + 8 * fq;
        PG8_LAS float* scr = scr0 + (wr * 4 + wc) * 128;
        wave_rstd(ssq2, scr, u.pm, wr, fq * 16 + fr);
        f32x4 bv[2][2];
#pragma unroll
        for (int bj = 0; bj < 2; ++bj)
#pragma unroll
            for (int n = 0; n < 2; ++n) bv[bj][n] = *(const f32x4*)(bias2 + (size_t)(u.pm >> 3) * 4096 + col0 + bj * HALF + 4 * n);
#pragma unroll
        for (int ai = 0; ai < 2; ++ai)
#pragma unroll
            for (int m = 0; m < 4; ++m) {
                bf16_t* rp = O + (size_t)(row0 + ai * HALF + m * 16) * 4096 + col0;
                const float rstd = scr[ai * 64 + m * 16 + fr];
#pragma unroll
                for (int bj = 0; bj < 2; ++bj) {
                    f32x4 v0 = acc[ai][bj][m][0] * rstd + bv[bj][0], v1 = acc[ai][bj][m][1] * rstd + bv[bj][1];
#pragma unroll
                    for (int j = 0; j < 4; ++j) { const float a = fmaxf(v0[j], 0.f), c = fmaxf(v1[j], 0.f); v0[j] = a * a; v1[j] = c * c; }
                    *(u32x4*)(rp + bj * HALF) = pack8(v0, v1);
                }
            }
    }
};

template <int MODE1> struct EpiHeads {
    static constexpr bool PERM = true, AFTER_DRAIN = false, KHOOK = false;
    bf16_t *O0, *O1; const float* gain; float scale0; float* logf; const float* fbias;
    const float* ssq2; const float* bias2; int bias_ld; PG8_LAS float* scr0;
    __device__ __forceinline__ void operator()(const f32x4 (&acc0)[2][2][4][2], const Unit& u, int wr, int wc, int fr, int fq) const {
        const int row0 = u.pm * BM + wr * 64 + fr;
        PG8_LAS float* scr = scr0 + (wr * 4 + wc) * 128;
        wave_rstd(ssq2, scr, u.pm, wr, fq * 16 + fr);
        f32x4 acc[2][2][4][2];
        { f32x4 bv[2][2];
#pragma unroll
          for (int bj = 0; bj < 2; ++bj)
#pragma unroll
              for (int n = 0; n < 2; ++n) bv[bj][n] = *(const f32x4*)(bias2 + (size_t)(u.pm >> 3) * bias_ld + u.pn * BM + bj * HALF + wc * 32 + 8 * fq + 4 * n);
#pragma unroll
          for (int ai = 0; ai < 2; ++ai)
#pragma unroll
              for (int m = 0; m < 4; ++m) { const float rstd = scr[ai * 64 + m * 16 + fr];
#pragma unroll
                  for (int bj = 0; bj < 2; ++bj)
#pragma unroll
                      for (int n = 0; n < 2; ++n) acc[ai][bj][m][n] = acc0[ai][bj][m][n] * rstd + bv[bj][n]; } }
        if (u.pn < 4) {
            f32x4 gk[2][2];
#pragma unroll
            for (int bj = 0; bj < 2; ++bj)
#pragma unroll
                for (int n = 0; n < 2; ++n) gk[bj][n] = *(const f32x4*)(gain + 32 * bj + 8 * fq + 4 * n) * scale0;
#pragma unroll
            for (int ai = 0; ai < 2; ++ai)
#pragma unroll
                for (int m = 0; m < 4; ++m) {
                    float ss = 0.f;
#pragma unroll
                    for (int bj = 0; bj < 2; ++bj)
#pragma unroll
                        for (int n = 0; n < 2; ++n) { const f32x4 x = acc[ai][bj][m][n]; ss += (x[0] * x[0] + x[1] * x[1]) + (x[2] * x[2] + x[3] * x[3]); }
                    ss += __shfl_xor(ss, 16); ss += __shfl_xor(ss, 32);
                    const float rstd = rsqrtf(ss * (1.f / 64.f) + 1e-6f);
                    bf16_t* rp = O0 + (size_t)(row0 + ai * HALF + m * 16) * 1024 + u.pn * 256 + wc * 64 + 8 * fq;
#pragma unroll
                    for (int bj = 0; bj < 2; ++bj) *(u32x4*)(rp + 32 * bj) = pack8(acc[ai][bj][m][0] * rstd * gk[bj][0], acc[ai][bj][m][1] * rstd * gk[bj][1]);
                }
        } else if (u.pn < 8) {
#pragma unroll
            for (int ai = 0; ai < 2; ++ai)
#pragma unroll
                for (int m = 0; m < 4; ++m) {
                    bf16_t* rp = O1 + (size_t)(row0 + ai * HALF + m * 16) * 1024 + (u.pn - 4) * 256 + wc * 64 + 8 * fq;
#pragma unroll
                    for (int bj = 0; bj < 2; ++bj) {
                        f32x4 v0 = acc[ai][bj][m][0], v1 = acc[ai][bj][m][1];
                        if (MODE1 == 1) {
#pragma unroll
                            for (int j = 0; j < 4; ++j) { v0[j] = fast_sigmoid(v0[j]); v1[j] = fast_sigmoid(v1[j]); }
                        }
                        *(u32x4*)(rp + 32 * bj) = pack8(v0, v1);
                    }
                }
        } else {
            if (wc == 0 && fq < 2) {
                const f32x4 b0 = *(const f32x4*)(fbias + 8 * fq), b1 = *(const f32x4*)(fbias + 8 * fq + 4);
#pragma unroll
                for (int ai = 0; ai < 2; ++ai)
#pragma unroll
                    for (int m = 0; m < 4; ++m) {
                        f32x4 z0 = acc[ai][0][m][0] + b0, z1 = acc[ai][0][m][1] + b1;
#pragma unroll
                        for (int j = 0; j < 4; ++j) { z0[j] = fminf(z0[j], 0.f) - log1pf(__expf(-fabsf(z0[j]))); z1[j] = fminf(z1[j], 0.f) - log1pf(__expf(-fabsf(z1[j]))); }
                        float* lp = logf + (size_t)(row0 + ai * HALF + m * 16) * 16 + 8 * fq;
                        *(f32x4*)lp = z0; *(f32x4*)(lp + 4) = z1;
                    }
            }
        }
    }
};

struct OneUnit {
    Unit u;
    __device__ __forceinline__ bool next(int i, Unit& o) const { if (i) return false; o = u; return true; }
    __device__ __forceinline__ void a_ready(const Unit&) const {}
    __device__ __forceinline__ void done(const Unit&) const {}
};
template <class Epi, class Sched, bool ALIGN_EPI = false, bool SP2 = false>
__device__ __forceinline__ void gemm_phase(PG8_LAS unsigned char* lds, const Gemm g, const Sched& S, const Epi& E, const int tid) {
    const int wid = __builtin_amdgcn_readfirstlane(tid >> 6), lane = tid & 63, wr = wid >> 2, wc = wid & 3, fr = lane & 15, fq = lane >> 4;
    const int K = g.K, nt = K / BK;
    unsigned voffA[2], voffB[2];
#pragma unroll
    for (int i = 0; i < 2; ++i) { int R, C; stage_rc(tid * 16 + i * 8192, R, C); const int Rb = Epi::PERM ? ((R & ~31) + perm32(R & 31)) : R;
        voffA[i] = (unsigned)(R * K + C) * 2u; voffB[i] = (unsigned)(Rb * K + C) * 2u; }
    const size_t kstep = (size_t)(BK * 2);
    const size_t hstep = (size_t)HALF * K * 2;
    const size_t tstep = 2 * hstep;
    const unsigned ldsw = (unsigned)wid * 1024u;
    const int aoff = lds_byte(wr * 64 + fr, fq * 8), boff = lds_byte(wc * 32 + fr, fq * 8);
#define PG8_SA(b, h) (((b) * 2 + (h)) * HTB)
#define PG8_SB(b, h) ((4 + (b) * 2 + (h)) * HTB)
#define PG8_STAGE(bufoff, gbase, voff) do { _Pragma("unroll") for (int _i = 0; _i < 2; ++_i) \
        __builtin_amdgcn_global_load_lds((const unsigned*)((const char*)(gbase) + (voff)[_i]), (PG8_LAS unsigned*)(lds + (bufoff) + ldsw + _i * 8192), 16, 0, 0); } while (0)
#define PG8_LDA(dst, b, h) do { _Pragma("unroll") for (int m = 0; m < 4; ++m) _Pragma("unroll") for (int k = 0; k < 2; ++k) dst[m][k] = *(const PG8_LAS bf16x8*)(lds + PG8_SA(b, h) + aoff + m * 2048 + k * 1024); } while (0)
#define PG8_LDB(dst, b, h) do { _Pragma("unroll") for (int n = 0; n < 2; ++n) _Pragma("unroll") for (int k = 0; k < 2; ++k) dst[n][k] = *(const PG8_LAS bf16x8*)(lds + PG8_SB(b, h) + boff + n * 2048 + k * 1024); } while (0)
#define PG8_MMA(ai, bj, At, Bt) do { __builtin_amdgcn_s_setprio(1); _Pragma("unroll") for (int m = 0; m < 4; ++m) _Pragma("unroll") for (int n = 0; n < 2; ++n) _Pragma("unroll") for (int k = 0; k < 2; ++k) \
        acc[ai][bj][m][n] = __builtin_amdgcn_mfma_f32_16x16x32_bf16(Bt[n][k], At[m][k], acc[ai][bj][m][n], 0, 0, 0); __builtin_amdgcn_s_setprio(0); } while (0)
#define PG8_WAIT_V(n) asm volatile("s_waitcnt vmcnt(" #n ")" ::: "memory")
#define PG8_WAIT_L(n) asm volatile("s_waitcnt lgkmcnt(" #n ")" ::: "memory")
#define PG8_BAR __builtin_amdgcn_s_barrier()
#define PG8_SCHED __builtin_amdgcn_sched_barrier(0)
    Unit cur, nxt; int ui = 0;
    if (!S.next(0, cur)) return;
    f32x4 acc[2][2][4][2];
#pragma unroll
    for (int a = 0; a < 2; ++a)
#pragma unroll
        for (int b = 0; b < 2; ++b)
#pragma unroll
            for (int m = 0; m < 4; ++m)
#pragma unroll
                for (int n = 0; n < 2; ++n) acc[a][b][m][n] = (f32x4){0.f, 0.f, 0.f, 0.f};
    bf16x8 At[4][2], B0[2][2], B1[2][2];
    const char* cA = (const char*)g.A + (size_t)cur.pm * tstep; const char* cB = (const char*)g.Bt + (size_t)cur.pn * tstep;
    S.a_ready(cur);
    if constexpr (SP2) {
        PG8_STAGE(PG8_SB(0, 0), cB, voffB); PG8_STAGE(PG8_SB(0, 1), cB + hstep, voffB); PG8_STAGE(PG8_SA(0, 0), cA, voffA); PG8_STAGE(PG8_SA(0, 1), cA + hstep, voffA);
        if (wr == 1) PG8_BAR;
        PG8_WAIT_V(2); PG8_BAR;
        PG8_STAGE(PG8_SB(1, 0), cB + kstep, voffB); PG8_STAGE(PG8_SA(1, 0), cA + kstep, voffA); PG8_STAGE(PG8_SB(1, 1), cB + hstep + kstep, voffB);
        PG8_WAIT_V(6); PG8_BAR;
    } else {
        PG8_STAGE(PG8_SB(0, 0), cB, voffB); PG8_STAGE(PG8_SA(0, 0), cA, voffA); PG8_STAGE(PG8_SB(0, 1), cB + hstep, voffB); PG8_STAGE(PG8_SA(0, 1), cA + hstep, voffA);
        if (wr == 1) PG8_BAR;
        PG8_WAIT_V(4); PG8_BAR;
        PG8_STAGE(PG8_SB(1, 0), cB + kstep, voffB); PG8_STAGE(PG8_SA(1, 0), cA + kstep, voffA); PG8_STAGE(PG8_SB(1, 1), cB + hstep + kstep, voffB);
        PG8_WAIT_V(6); PG8_BAR;
    }
    for (;;) {
        const bool has_next = S.next(ui + 1, nxt);
        const char* nA = has_next ? (const char*)g.A + (size_t)nxt.pm * tstep : cA; const char* nB = has_next ? (const char*)g.Bt + (size_t)nxt.pn * tstep : cB;
        for (int t = 0; t < nt; t += 2) {
            const bool last = (t == nt - 2);
            const char* a1 = cA + (size_t)(t + 1) * kstep;
            const char* a2 = last ? nA : cA + (size_t)(t + 2) * kstep; const char* b2 = last ? nB : cB + (size_t)(t + 2) * kstep;
            const char* a3 = a2 + kstep; const char* b3 = b2 + kstep;
            if (last && has_next) S.a_ready(nxt);
            if constexpr (SP2) {
            PG8_LDB(B0, 0, 0); PG8_LDB(B1, 0, 1); PG8_SCHED; PG8_LDA(At, 0, 0); PG8_STAGE(PG8_SA(1, 1), a1 + hstep, voffA);
            PG8_WAIT_V(8); PG8_WAIT_L(0); PG8_BAR; PG8_MMA(0, 0, At, B0); PG8_MMA(0, 1, At, B1); PG8_BAR; PG8_SCHED;
            PG8_LDA(At, 0, 1); PG8_STAGE(PG8_SB(0, 0), b2, voffB); PG8_STAGE(PG8_SB(0, 1), b2 + hstep, voffB); PG8_STAGE(PG8_SA(0, 0), a2, voffA);
            PG8_WAIT_V(8); PG8_WAIT_L(0); PG8_BAR; PG8_MMA(1, 0, At, B0); PG8_MMA(1, 1, At, B1); PG8_BAR; PG8_SCHED;
            PG8_LDB(B0, 1, 0); PG8_LDB(B1, 1, 1); PG8_SCHED; PG8_LDA(At, 1, 0); PG8_STAGE(PG8_SA(0, 1), a2 + hstep, voffA);
            PG8_WAIT_V(8); PG8_WAIT_L(0); PG8_BAR; PG8_MMA(0, 0, At, B0); PG8_MMA(0, 1, At, B1); PG8_BAR; PG8_SCHED;
            PG8_LDA(At, 1, 1); PG8_STAGE(PG8_SB(1, 0), b3, voffB); PG8_STAGE(PG8_SB(1, 1), b3 + hstep, voffB); PG8_STAGE(PG8_SA(1, 0), a3, voffA);
            PG8_WAIT_V(8); PG8_WAIT_L(0); PG8_BAR; PG8_MMA(1, 0, At, B0); PG8_MMA(1, 1, At, B1); PG8_BAR; PG8_SCHED;
            if constexpr (Epi::KHOOK) { if ((((t + 2) & 7) == 0) && (t + 2 < nt)) E.khook(acc, ((t + 2) >> 3) - 1, wr, fr); }
            } else {
            PG8_LDB(B0, 0, 0); PG8_SCHED; PG8_LDA(At, 0, 0); PG8_STAGE(PG8_SA(1, 1), a1 + hstep, voffA);
            PG8_WAIT_L(8); PG8_BAR; PG8_WAIT_L(0); PG8_MMA(0, 0, At, B0); PG8_BAR; PG8_SCHED;
            PG8_LDB(B1, 0, 1); PG8_STAGE(PG8_SB(0, 0), b2, voffB);
            PG8_BAR; PG8_WAIT_L(0); PG8_MMA(0, 1, At, B1); PG8_BAR;
            PG8_LDA(At, 0, 1); PG8_STAGE(PG8_SA(0, 0), a2, voffA);
            PG8_BAR; PG8_WAIT_L(0); PG8_MMA(1, 0, At, B0); PG8_BAR; PG8_SCHED;
            PG8_STAGE(PG8_SB(0, 1), b2 + hstep, voffB);
            PG8_WAIT_V(6); PG8_BAR; PG8_MMA(1, 1, At, B1); PG8_BAR;
            PG8_LDB(B0, 1, 0); PG8_SCHED; PG8_LDA(At, 1, 0); PG8_STAGE(PG8_SA(0, 1), a2 + hstep, voffA);
            PG8_WAIT_L(8); PG8_BAR; PG8_WAIT_L(0); PG8_MMA(0, 0, At, B0); PG8_BAR; PG8_SCHED;
            PG8_LDB(B1, 1, 1); PG8_STAGE(PG8_SB(1, 0), b3, voffB);
            PG8_BAR; PG8_WAIT_L(0); PG8_MMA(0, 1, At, B1); PG8_BAR;
            PG8_LDA(At, 1, 1); PG8_STAGE(PG8_SA(1, 0), a3, voffA);
            PG8_BAR; PG8_WAIT_L(0); PG8_MMA(1, 0, At, B0); PG8_BAR; PG8_SCHED;
            PG8_STAGE(PG8_SB(1, 1), b3 + hstep, voffB);
            PG8_WAIT_V(6); PG8_BAR; PG8_MMA(1, 1, At, B1); PG8_BAR;
            }
        }
        if constexpr (ALIGN_EPI) { if (wr == 0) PG8_BAR; }
        if constexpr (!Epi::AFTER_DRAIN) { E(acc, cur, wr, wc, fr, fq); S.done(cur); }
        if (!has_next) break;
#pragma unroll
        for (int a = 0; a < 2; ++a)
#pragma unroll
            for (int b = 0; b < 2; ++b)
#pragma unroll
                for (int m = 0; m < 4; ++m)
#pragma unroll
                    for (int n = 0; n < 2; ++n) acc[a][b][m][n] = (f32x4){0.f, 0.f, 0.f, 0.f};
        cur = nxt; cA = nA; cB = nB; ++ui;
        if constexpr (ALIGN_EPI) { if (wr == 1) PG8_BAR; }
    }
    PG8_WAIT_V(0);
    if constexpr (!ALIGN_EPI) { if (wr == 0) PG8_BAR; }
    PG8_BAR;
    if constexpr (Epi::AFTER_DRAIN) { E.fused(acc, cur, wr, wc, fr, fq, lds, wid, lane); S.done(cur); }
#undef PG8_SA
#undef PG8_SB
#undef PG8_STAGE
#undef PG8_LDA
#undef PG8_LDB
#undef PG8_MMA
#undef PG8_WAIT_V
#undef PG8_WAIT_L
#undef PG8_BAR
#undef PG8_SCHED
}
}

using pg8::bf16_t; using pg8::bf16x8; using pg8::f32x4; using pg8::u32x4; using pg8::u32x2; using pg8::cvt_pk_bf16;
#define LAS __attribute__((address_space(3)))
typedef float f32x16 __attribute__((ext_vector_type(16)));
typedef short s16x4 __attribute__((ext_vector_type(4)));

constexpr int BATCH = 8, SEQ = 2048, D = 1024, M = BATCH * SEQ, FF = 4096;
constexpr int RH = 4, RDK = 256, RDV = 512, RVW = RH * RDV, RIN = 6144, RC = 128, NCH = SEQ / RC;
constexpr int FH = 16, FD = 64;
constexpr int ADA_LD = 14336;
constexpr float EPS = 1e-6f;
constexpr float LOG2E = 1.4426950408889634f;
constexpr float QSCALE = 0.125f * LOG2E;

constexpr size_t MiB = 1u << 20;
constexpr size_t WS_ADA = 1 * MiB, WS_LOGF = 2 * MiB, WS_SSQ = 4 * MiB;
constexpr size_t WS_SSQ2 = 3 * MiB;
constexpr size_t WS_BIAS2 = 1 * MiB + 512 * 1024;
constexpr size_t B2_MLP0 = 0, B2_MLP1 = 8 * 4096, B2_KV = 16 * 4096, B2_FOX = 16 * 4096 + 8 * 2304;
constexpr size_t WS_WRIN = 8 * MiB, WS_WROUT = 20 * MiB, WS_WM1_0 = 24 * MiB;
constexpr size_t WS_TAB = 32 * MiB;
constexpr size_t WS_HKV = 8 * MiB;
constexpr size_t WS_WM2_0 = 48 * MiB, WS_WM1_1 = 56 * MiB, WS_WM2_1 = 64 * MiB, WS_WKV = 72 * MiB, WS_WFIN = 77 * MiB, WS_WFOUT = 81 * MiB;
constexpr size_t WS_HN = 83 * MiB;
constexpr size_t WS_BIG = 115 * MiB;
constexpr size_t WS_END = 243 * MiB;

constexpr int LDS_BYTES = 155648;
constexpr int RING_BYTES = 131072;
constexpr int RTAB_OFF = 132096;
constexpr int WSCR_OFF = 136192;
constexpr int XBST_OFF = LDS_BYTES - 64;
constexpr size_t WS_CTL = 0, CTL_ZERO_BYTES = 16384;

__device__ __forceinline__ float bf2f(unsigned b) { return __uint_as_float(b << 16); }
__device__ __forceinline__ unsigned f2bf(float f) { unsigned u = __float_as_uint(f); return (u + 0x7fffu + ((u >> 16) & 1u)) >> 16; }
__device__ __forceinline__ unsigned pk2(float lo, float hi) { return f2bf(lo) | (f2bf(hi) << 16); }
__device__ __forceinline__ float wave_sum(float v) {
#pragma unroll
    for (int o = 1; o < 64; o <<= 1) v += __shfl_xor(v, o);
    return v;
}
#define LDS_WAIT() asm volatile("s_waitcnt lgkmcnt(0)" ::: "memory")
template <int CTRL, int RMASK> __device__ __forceinline__ float dpp_add_f(float v) { return v + __int_as_float(__builtin_amdgcn_update_dpp(0, __float_as_int(v), CTRL, RMASK, 0xf, true)); }
__device__ __forceinline__ float wave_sum_dpp(float v) {
    v = dpp_add_f<0x111, 0xf>(v); v = dpp_add_f<0x112, 0xf>(v); v = dpp_add_f<0x114, 0xf>(v); v = dpp_add_f<0x118, 0xf>(v); v = dpp_add_f<0x142, 0xa>(v);
    return __int_as_float(__builtin_amdgcn_readlane(__float_as_int(v), 31)) + __int_as_float(__builtin_amdgcn_readlane(__float_as_int(v), 63));
}

struct Args {
    const float* x; const float* c; const int* pos;
    const float *nmg, *nlg, *w_ada, *b_ada, *w_mlp_in, *w_mlp_out, *ret_w_in, *ret_ng, *ret_w_out, *kv_ng, *kv_w_ada, *kv_b_ada, *kv_w, *fbias, *k_ng, *fox_w_in, *q_ng, *fox_w_out;
    float* out; unsigned char* ws;
};

__device__ __forceinline__ int perm_row(int n) { return (n & ~255) + 128 * ((n >> 5) & 1) + 32 * ((n >> 6) & 3) + (n & 31); }
struct TDesc { const float* W; int ldw, K, nblk; bf16_t* WT; int permute, r; };
__device__ __forceinline__ void transpose_load(const TDesc& d, f32x4 (&wv)[16], int lane) {
    const int kb = d.r / d.nblk, nb = d.r % d.nblk;
    const float* wp = d.W + (size_t)(64 * kb + (lane >> 4)) * d.ldw + 64 * nb + 4 * (lane & 15);
#pragma unroll
    for (int i = 0; i < 16; ++i) wv[i] = __builtin_nontemporal_load((const f32x4*)(wp + (size_t)(4 * i) * d.ldw));
}
__device__ __forceinline__ void transpose_to_lds(const f32x4 (&wv)[16], LAS float* scr, int lane) {
#pragma unroll
    for (int i = 0; i < 16; ++i) { LAS float* sp = scr + (4 * i + (lane >> 4)) * 65 + 4 * (lane & 15); sp[0] = wv[i][0]; sp[1] = wv[i][1]; sp[2] = wv[i][2]; sp[3] = wv[i][3]; }
    LDS_WAIT(); asm volatile("" ::: "memory");
}
__device__ __forceinline__ void transpose_store(const TDesc& d, LAS float* scr, int lane) {
    const int kb = d.r / d.nblk, nb = d.r % d.nblk, k0 = 64 * kb, n0 = 64 * nb;
    const int c = lane & 7;
#pragma unroll
    for (int j = 0; j < 8; ++j) { const int n = (lane >> 3) + 8 * j; const LAS float* s = scr + (8 * c) * 65 + n;
        u32x4 o; o.x = pk2(s[0 * 65], s[1 * 65]); o.y = pk2(s[2 * 65], s[3 * 65]); o.z = pk2(s[4 * 65], s[5 * 65]); o.w = pk2(s[6 * 65], s[7 * 65]);
        const int r = d.permute ? perm_row(n0 + n) : n0 + n;
        *(u32x4*)(d.WT + (size_t)r * d.K + k0 + 8 * c) = o; }
    LDS_WAIT(); asm volatile("" ::: "memory");
}

__device__ __forceinline__ void phase0(const Args& a, LAS unsigned char* lds, int tid, int lane, int wave) {
    unsigned char* ws = a.ws;
    const int G = gridDim.x, bx = blockIdx.x;
    LAS float* cact = (LAS float*)lds;
    LAS float* red = (LAS float*)(lds + 32768);
    float* ADA = (float*)(ws + WS_ADA);
    for (int it = bx; it < ADA_LD / 64; it += G) {
        __syncthreads();
        for (int i = tid; i < BATCH * D; i += 512) { const int b = i >> 10, k = i & 1023; const float v = a.c[i]; cact[k * 8 + b] = v * pg8::fast_sigmoid(v); }
        __syncthreads();
        const int n0 = it * 64;
        const float* W; const float* bias; int ldw, nn;
        if (n0 < 6144) { W = a.w_ada; bias = a.b_ada; ldw = 6144; nn = n0; }
        else if (n0 < 12288) { W = a.w_ada + (size_t)D * 6144; bias = a.b_ada + 6144; ldw = 6144; nn = n0 - 6144; }
        else { W = a.kv_w_ada; bias = a.kv_b_ada; ldw = 2048; nn = n0 - 12288; }
        float acc[8];
#pragma unroll
        for (int b = 0; b < 8; ++b) acc[b] = 0.f;
        const float* wp = W + (size_t)(wave * 128) * ldw + nn + lane;
        for (int kb = 0; kb < 128; kb += 16) {
            float wv[16];
#pragma unroll
            for (int i = 0; i < 16; ++i) wv[i] = __builtin_nontemporal_load(wp + (size_t)(kb + i) * ldw);
            __builtin_amdgcn_sched_barrier(0);
#pragma unroll
            for (int i = 0; i < 16; ++i) {
                const float w = wv[i];
                const f32x4 c0 = *(const LAS f32x4*)(cact + (wave * 128 + kb + i) * 8), c1 = *(const LAS f32x4*)(cact + (wave * 128 + kb + i) * 8 + 4);
                acc[0] += c0[0] * w; acc[1] += c0[1] * w; acc[2] += c0[2] * w; acc[3] += c0[3] * w;
                acc[4] += c1[0] * w; acc[5] += c1[1] * w; acc[6] += c1[2] * w; acc[7] += c1[3] * w;
            }
            __builtin_amdgcn_sched_barrier(0);
        }
#pragma unroll
        for (int b = 0; b < 8; ++b) red[(wave * 8 + b) * 64 + lane] = acc[b];
        __syncthreads();
        { const int b = tid >> 6; float s = bias[nn + lane];
#pragma unroll
          for (int w = 0; w < 8; ++w) s += red[(w * 8 + b) * 64 + lane];
          ADA[(size_t)b * ADA_LD + n0 + lane] = s; }
    }
    __syncthreads();
    {
        LAS float* scr = (LAS float*)(lds + wave * 16640);
        const int gw = bx * 8 + wave, NGW = G * 8;
        constexpr int I0 = 16 * 96, I1 = 32 * 16, I2 = 16 * 64, I3 = 64 * 16, I4 = 16 * 32, I5 = 16 * 32, I6 = 16 * 16;
        constexpr int NITEMS = I0 + I1 + 2 * I2 + 2 * I3 + I4 + I5 + I6;
        auto desc = [&](int it) -> TDesc {
            int r = it;
            if (r < I0) return TDesc{a.ret_w_in, RIN, D, 96, (bf16_t*)(ws + WS_WRIN), 0, r}; r -= I0;
            if (r < I1) return TDesc{a.ret_w_out, D, RVW, 16, (bf16_t*)(ws + WS_WROUT), 0, r}; r -= I1;
            if (r < I2) return TDesc{a.w_mlp_in, FF, D, 64, (bf16_t*)(ws + WS_WM1_0), 0, r}; r -= I2;
            if (r < I2) return TDesc{a.w_mlp_in + (size_t)D * FF, FF, D, 64, (bf16_t*)(ws + WS_WM1_1), 0, r}; r -= I2;
            if (r < I3) return TDesc{a.w_mlp_out, D, FF, 16, (bf16_t*)(ws + WS_WM2_0), 0, r}; r -= I3;
            if (r < I3) return TDesc{a.w_mlp_out + (size_t)FF * D, D, FF, 16, (bf16_t*)(ws + WS_WM2_1), 0, r}; r -= I3;
            if (r < I4) return TDesc{a.kv_w, 2 * D + FH, D, 32, (bf16_t*)(ws + WS_WKV), 1, r}; r -= I4;
            if (r < I5) return TDesc{a.fox_w_in, 2 * D, D, 32, (bf16_t*)(ws + WS_WFIN), 1, r}; r -= I5;
            return TDesc{a.fox_w_out, D, D, 16, (bf16_t*)(ws + WS_WFOUT), 0, r};
        };
        f32x4 wv[16];
        int it = gw;
        TDesc cur{}; if (it < NITEMS) { cur = desc(it); transpose_load(cur, wv, lane); }
        while (it < NITEMS) {
            transpose_to_lds(wv, scr, lane);
            const int nx = it + NGW; TDesc nd{};
            if (nx < NITEMS) { nd = desc(nx); transpose_load(nd, wv, lane); }
            transpose_store(cur, scr, lane);
            cur = nd; it = nx;
        }
    }
    const int gt = bx * 512 + tid, NT = G * 512;
    {
        bf16_t* wkv = (bf16_t*)(ws + WS_WKV) + (size_t)2048 * D;
        for (int i = gt; i < 256 * (D / 8); i += NT) {
            const int row = i >> 7, c8 = i & 127; u32x4 o = (u32x4){0u, 0u, 0u, 0u};
            if (row < FH) { float v[8];
#pragma unroll
                for (int e = 0; e < 8; ++e) v[e] = a.kv_w[(size_t)(8 * c8 + e) * (2 * D + FH) + 2 * D + row];
                o.x = pk2(v[0], v[1]); o.y = pk2(v[2], v[3]); o.z = pk2(v[4], v[5]); o.w = pk2(v[6], v[7]); }
            *(u32x4*)(wkv + (size_t)row * D + 8 * c8) = o;
        }
    }
    if (gt < 128) {
        float* tab = (float*)(ws + WS_TAB);
        double invf = 1.0; { const double r = 0.93057204092969897;
            for (int k = 0; k < gt; ++k) invf *= r; }
        const double v = invf * 0.15915494309189535;
        const float hi = (float)v;
        tab[gt] = hi; tab[128 + gt] = (float)(v - (double)hi);
    }
}

__device__ __forceinline__ void norm_rows(const float* xs, const float* gain, const float* shift, const float* scale, bf16_t* out, int lane, int wave) {
    const int gw = blockIdx.x * 8 + wave, NGW = gridDim.x * 8;
    const int per = (M + NGW - 1) / NGW, r0 = gw * per, r1 = (r0 + per < M) ? r0 + per : M;
    if (r0 >= r1) return;
    f32x4 gs[4], sh[4]; int bcur = -1;
    f32x4 vn[4];
    { const f32x4* xr = (const f32x4*)(xs + (size_t)r0 * D) + lane;
#pragma unroll
      for (int j = 0; j < 4; ++j) vn[j] = __builtin_nontemporal_load(xr + 64 * j); }
    for (int row = r0; row < r1; ++row) {
        f32x4 v[4];
#pragma unroll
        for (int j = 0; j < 4; ++j) v[j] = vn[j];
        if (row + 1 < r1) { const f32x4* xr = (const f32x4*)(xs + (size_t)(row + 1) * D) + lane;
#pragma unroll
            for (int j = 0; j < 4; ++j) vn[j] = __builtin_nontemporal_load(xr + 64 * j); }
        const int b = row >> 11;
        if (b != bcur) { bcur = b;
#pragma unroll
            for (int j = 0; j < 4; ++j) { const int col = 4 * lane + 256 * j;
                gs[j] = *(const f32x4*)(gain + col) * (*(const f32x4*)(scale + (size_t)b * ADA_LD + col) + 1.f); sh[j] = *(const f32x4*)(shift + (size_t)b * ADA_LD + col); } }
        float ss = 0.f;
#pragma unroll
        for (int j = 0; j < 4; ++j) ss += (v[j][0] * v[j][0] + v[j][1] * v[j][1]) + (v[j][2] * v[j][2] + v[j][3] * v[j][3]);
        const float rstd = rsqrtf(wave_sum_dpp(ss) * (1.f / D) + EPS);
#pragma unroll
        for (int j = 0; j < 4; ++j) {
            const f32x4 o = v[j] * rstd * gs[j] + sh[j];
            u32x2 w; w.x = cvt_pk_bf16(o[0], o[1]); w.y = cvt_pk_bf16(o[2], o[3]);
            *(u32x2*)(out + (size_t)row * D + 4 * lane + 256 * j) = w;
        }
    }
}

__device__ __forceinline__ void bias2_rows(const bf16_t* Wt, int nrows, const float* shift  , float* out, int out_ld, int lane, int wave) {
    const int gw = blockIdx.x * 8 + wave, NGW = gridDim.x * 8;
    if (gw >= nrows) return;
    float sh[8][16];
#pragma unroll
    for (int b = 0; b < 8; ++b)
#pragma unroll
        for (int q = 0; q < 4; ++q) { const f32x4 v = *(const f32x4*)(shift + (size_t)b * ADA_LD + 16 * lane + 4 * q); sh[b][4 * q] = v[0]; sh[b][4 * q + 1] = v[1]; sh[b][4 * q + 2] = v[2]; sh[b][4 * q + 3] = v[3]; }
    u32x4 n0 = *(const u32x4*)(Wt + (size_t)gw * D + 16 * lane), n1 = *(const u32x4*)(Wt + (size_t)gw * D + 16 * lane + 8);
    for (int r = gw; r < nrows; r += NGW) {
        const u32x4 w0 = n0, w1 = n1;
        if (r + NGW < nrows) { n0 = *(const u32x4*)(Wt + (size_t)(r + NGW) * D + 16 * lane); n1 = *(const u32x4*)(Wt + (size_t)(r + NGW) * D + 16 * lane + 8); }
        const unsigned ww[8] = {w0.x, w0.y, w0.z, w0.w, w1.x, w1.y, w1.z, w1.w};
        float wf[16];
#pragma unroll
        for (int i = 0; i < 8; ++i) { wf[2 * i] = bf2f(ww[i] & 0xffffu); wf[2 * i + 1] = bf2f(ww[i] >> 16); }
        float res = 0.f;
#pragma unroll
        for (int b = 0; b < 8; ++b) { float s = 0.f;
#pragma unroll
            for (int i = 0; i < 16; ++i) s += sh[b][i] * wf[i];
            s = wave_sum_dpp(s); if (lane == b) res = s; }
        if (lane < 8) out[(size_t)lane * out_ld + r] = res;
    }
}

__device__ __forceinline__ void logf_rows(const bf16_t* HKV, const bf16_t* Wf, const float* ssq2, const float* bias, int bias_ld, const float* fbias, float* logf, LAS unsigned char* lds, int tid, int lane, int w) {
    const int r32 = lane & 31, hh = lane >> 5;
    LAS float* part = (LAS float*)lds;
    for (int rt = blockIdx.x; rt < M / 64; rt += gridDim.x) {
        const size_t row0 = (size_t)rt * 64;
        f32x16 acc[2];
#pragma unroll
        for (int i = 0; i < 16; ++i) { acc[0][i] = 0.f; acc[1][i] = 0.f; }
        const bf16_t* ap = HKV + (row0 + r32) * 1024 + 128 * w + 8 * hh;
        const bf16_t* bp = Wf + (size_t)r32 * 1024 + 128 * w + 8 * hh;
#pragma unroll
        for (int ks = 0; ks < 8; ++ks) { const bf16x8 bf = *(const bf16x8*)(bp + 16 * ks);
#pragma unroll
            for (int rb = 0; rb < 2; ++rb) { const bf16x8 af = *(const bf16x8*)(ap + (size_t)rb * 32 * 1024 + 16 * ks); acc[rb] = __builtin_amdgcn_mfma_f32_32x32x16_bf16(af, bf, acc[rb], 0, 0, 0); } }
        __syncthreads();
        if (r32 < 16) {
#pragma unroll
            for (int rb = 0; rb < 2; ++rb)
#pragma unroll
                for (int i = 0; i < 16; ++i) part[(w * 64 + 32 * rb + (i & 3) + 8 * (i >> 2) + 4 * hh) * 16 + r32] = acc[rb][i];
        }
        __syncthreads();
        for (int o = tid; o < 1024; o += 512) {
            const int row = o >> 4, hd = o & 15;
            float s = 0.f;
#pragma unroll
            for (int ww = 0; ww < 8; ++ww) s += part[(ww * 64 + row) * 16 + hd];
            const f32x4* sp = (const f32x4*)(ssq2 + (row0 + row) * 16); const f32x4 a = sp[0], b = sp[1], c = sp[2], d = sp[3];
            const float q = ((a[0] + a[1]) + (a[2] + a[3])) + ((b[0] + b[1]) + (b[2] + b[3])) + ((c[0] + c[1]) + (c[2] + c[3])) + ((d[0] + d[1]) + (d[2] + d[3]));
            const float z = s * rsqrtf(q * (1.f / 1024.f) + EPS) + bias[(row0 >> 11) * bias_ld + hd] + fbias[hd];
            logf[(row0 + row) * 16 + hd] = fminf(z, 0.f) - log1pf(__expf(-fabsf(z)));
        }
    }
    __syncthreads();
}

#ifndef RET_PREF_K
#define RET_PREF_K 1
#endif
namespace ret {
constexpr int KP = 528, VP = 272, PP = 272, RP = 528;
constexpr int L_KC = 0, L_VT = 128 * KP, L_PS = L_VT + 64 * VP, L_RB = L_PS + 128 * PP, L_DEC = L_RB + 64 * RP, L_END = L_DEC + 1024;
static_assert(L_END <= XBST_OFF, "retention LDS");
__device__ __forceinline__ s16x4 tr_read(const LAS unsigned char* p) { return __builtin_bit_cast(s16x4, __builtin_amdgcn_ds_read_tr16_b64_v4i16((LAS s16x4*)p)); }

template <int CTRL, int RMASK> __device__ __forceinline__ float dpp_add(float v) { return v + __int_as_float(__builtin_amdgcn_update_dpp(0, __float_as_int(v), CTRL, RMASK, 0xf, true)); }
__device__ __forceinline__ float half_sum_hi(float v) { v = dpp_add<0x111, 0xf>(v); v = dpp_add<0x112, 0xf>(v); v = dpp_add<0x114, 0xf>(v); v = dpp_add<0x118, 0xf>(v); return dpp_add<0x142, 0xa>(v); }

__device__ __forceinline__ void unit(const bf16_t* Q, const bf16_t* Kr, const bf16_t* V, bf16_t* G, float* SSQ, const float* rgain, int b, int h, int vs, LAS unsigned char* lds, int tid, int lane, int w, bool dry = false) {
    const int r32 = lane & 31, hh = lane >> 5, rb = w & 3, cx = w >> 2;
    const float gam = 1.f - exp2f(-5.f - (float)h), lg = log2f(gam), gC = exp2f(128.f * lg);
    LAS float* kd = (LAS float*)(lds + L_DEC);
    LAS float* rs1 = (LAS float*)(lds + L_DEC + 512);
    __syncthreads();
    if (tid < 128) { kd[tid] = exp2f((float)(127 - tid) * lg); rs1[tid] = exp2f((float)(tid - 127) * lg); }
    f32x16 racc[2];
#pragma unroll
    for (int i = 0; i < 16; ++i) { racc[0][i] = 0.f; racc[1][i] = 0.f; }
    const int col = h * RDV + vs * 64 + cx * 32 + r32;
    const float gn = rgain[col];
    const int trrow = 8 * (lane >> 5) + ((lane & 15) >> 2), trcol = 16 * ((lane >> 4) & 1) + 4 * (lane & 3);
    const size_t row0 = (size_t)b * SEQ;
    const bf16_t* kg = Kr + (row0 + (tid >> 5)) * 1024 + h * RDK + 8 * (tid & 31);
    const bf16_t* vg = V + ((size_t)((b * 4 + h) * 8 + vs) * 16) * 8192 + (size_t)(tid >> 7) * 1024 + (tid & 127) * 8;
    const bf16_t* qg = Q + ((size_t)(b * 4 + h) * 64 + rb) * 8192 + hh * 256 + r32 * 8;
    u32x4 kreg[8], vreg[2]; bf16x8 qf[16];
#pragma unroll
    for (int i = 0; i < 8; ++i) kreg[i] = *(const u32x4*)(kg + (size_t)(16 * i) * 1024);
#pragma unroll
    for (int i = 0; i < 2; ++i) vreg[i] = __builtin_nontemporal_load((const u32x4*)(vg + (size_t)(4 * i) * 1024));
#pragma unroll
    for (int ks = 0; ks < 16; ++ks) qf[ks] = *(const bf16x8*)(qg + 512 * ks);
    for (int ch = 0; ch < NCH; ++ch) {
        const size_t rowbase = row0 + (size_t)ch * RC;
        const bool more = ch + 1 < NCH;
        __syncthreads();
#if !RET_PREF_K
        if (ch > 0) {
#pragma unroll
            for (int i = 0; i < 8; ++i) kreg[i] = *(const u32x4*)(kg + (size_t)(ch * RC + 16 * i) * 1024);
#pragma unroll
            for (int i = 0; i < 2; ++i) vreg[i] = *(const u32x4*)(vg + (size_t)(ch * RC + 64 * i) * RVW);
        }
#endif
#pragma unroll
        for (int i = 0; i < 8; ++i) *(LAS u32x4*)(lds + L_KC + ((tid >> 5) + 16 * i) * KP + 16 * (tid & 31)) = kreg[i];
#pragma unroll
        for (int i = 0; i < 2; ++i) { const int tok = tid & 127, c8 = (tid >> 7) + 4 * i;
            const unsigned wv[4] = {vreg[i].x, vreg[i].y, vreg[i].z, vreg[i].w};
#pragma unroll
            for (int e = 0; e < 4; ++e) {
                *(LAS unsigned short*)(lds + L_VT + (8 * c8 + 2 * e) * VP + tok * 2) = (unsigned short)(wv[e] & 0xffffu);
                *(LAS unsigned short*)(lds + L_VT + (8 * c8 + 2 * e + 1) * VP + tok * 2) = (unsigned short)(wv[e] >> 16);
            } }
#pragma unroll
        for (int vt = 0; vt < 2; ++vt) {
#pragma unroll
            for (int i = 0; i < 16; ++i) racc[vt][i] *= gC;
#pragma unroll
            for (int g = 0; g < 4; ++g) { u32x2 o; o.x = cvt_pk_bf16(racc[vt][4 * g], racc[vt][4 * g + 1]); o.y = cvt_pk_bf16(racc[vt][4 * g + 2], racc[vt][4 * g + 3]);
                *(LAS u32x2*)(lds + L_RB + (32 * vt + r32) * RP + (32 * w + 8 * g + 4 * hh) * 2) = o; }
        }
#if RET_PREF_K
        if (more) {
#pragma unroll
            for (int i = 0; i < 8; ++i) kreg[i] = *(const u32x4*)(kg + (size_t)((ch + 1) * RC + 16 * i) * 1024);
#pragma unroll
            for (int i = 0; i < 2; ++i) vreg[i] = __builtin_nontemporal_load((const u32x4*)(vg + (size_t)(ch + 1) * 8192 + (size_t)(4 * i) * 1024));
        }
#endif
        __syncthreads();
        __builtin_amdgcn_sched_barrier(0);
#pragma unroll
        for (int t = 0; t < 2; ++t) {
            const int cb = 2 * cx + t;
            if (cb <= rb) {
                f32x16 s;
#pragma unroll
                for (int i = 0; i < 16; ++i) s[i] = 0.f;
                const LAS unsigned char* kp = lds + L_KC + (32 * cb + r32) * KP + 16 * hh;
#pragma unroll
                for (int ks = 0; ks < 16; ++ks) { const bf16x8 kf = *(const LAS bf16x8*)(kp + 32 * ks); s = __builtin_amdgcn_mfma_f32_32x32x16_bf16(kf, qf[ks], s, 0, 0, 0); }
                if (cb == rb) {
#pragma unroll
                    for (int i = 0; i < 16; ++i) { const int key = (i & 3) + 8 * (i >> 2) + 4 * hh; if (key > r32) s[i] = 0.f; }
                }
#pragma unroll
                for (int g = 0; g < 4; ++g) { u32x2 o; o.x = cvt_pk_bf16(s[4 * g], s[4 * g + 1]); o.y = cvt_pk_bf16(s[4 * g + 2], s[4 * g + 3]);
                    *(LAS u32x2*)(lds + L_PS + (32 * rb + r32) * PP + (32 * cb + 8 * g + 4 * hh) * 2) = o; }
            }
        }
        __syncthreads();
        f32x16 o;
#pragma unroll
        for (int i = 0; i < 16; ++i) o[i] = 0.f;
        { const LAS unsigned char* rp = lds + L_RB + (32 * cx + r32) * RP + 16 * hh;
#pragma unroll
          for (int ks = 0; ks < 16; ++ks) { const bf16x8 rf = *(const LAS bf16x8*)(rp + 32 * ks); o = __builtin_amdgcn_mfma_f32_32x32x16_bf16(qf[ks], rf, o, 0, 0, 0); } }
        __builtin_amdgcn_sched_barrier(0);
        if (more) {
#pragma unroll
            for (int ks = 0; ks < 16; ++ks) qf[ks] = *(const bf16x8*)(qg + (size_t)(ch + 1) * 4 * 8192 + 512 * ks);
        }
        __builtin_amdgcn_sched_barrier(0);
        { const LAS unsigned char* pp = lds + L_PS + (32 * rb + r32) * PP + 16 * hh;
          const LAS unsigned char* vp = lds + L_VT + (32 * cx + r32) * VP + 16 * hh;
          const int nks = 2 * (rb + 1);
          for (int ks = 0; ks < nks; ++ks) { const bf16x8 pf = *(const LAS bf16x8*)(pp + 32 * ks), vf = *(const LAS bf16x8*)(vp + 32 * ks); o = __builtin_amdgcn_mfma_f32_32x32x16_bf16(pf, vf, o, 0, 0, 0); } }
#pragma unroll
        for (int ks = 0; ks < 8; ++ks) {
            const LAS unsigned char* kt = lds + L_KC + (16 * ks + trrow) * KP + (32 * w + trcol) * 2;
            const s16x4 lo = tr_read(kt), hi = tr_read(kt + 4 * KP);
            const bf16x8 af = (bf16x8){lo[0], lo[1], lo[2], lo[3], hi[0], hi[1], hi[2], hi[3]};
#pragma unroll
            for (int vt = 0; vt < 2; ++vt) { const bf16x8 vf = *(const LAS bf16x8*)(lds + L_VT + (32 * vt + r32) * VP + (16 * ks + 8 * hh) * 2);
                racc[vt] = __builtin_amdgcn_mfma_f32_32x32x16_bf16(af, vf, racc[vt], 0, 0, 0); }
        }
#pragma unroll
        for (int gb = 0; gb < 2; ++gb) {
            unsigned gz[8];
#pragma unroll
            for (int i = 0; i < 8; ++i) gz[i] = (unsigned)G[(rowbase + 32 * rb + (i & 3) + 8 * (2 * gb + (i >> 2)) + 4 * hh) * RVW + col];
#pragma unroll
            for (int g2 = 0; g2 < 2; ++g2) {
                const int g = 2 * gb + g2;
                const f32x4 rs = *(const LAS f32x4*)(rs1 + 32 * rb + 8 * g + 4 * hh);
#pragma unroll
                for (int j = 0; j < 4; ++j) {
                    const int q = 32 * rb + 8 * g + 4 * hh + j;
                    const float y = o[4 * g + j] * rs[j];
                    const float sq = half_sum_hi(y * y);
                    if (r32 == 31 && !dry) SSQ[(rowbase + q) * 64 + h * 16 + vs * 2 + cx] = sq;
                    const bf16_t ov = (bf16_t)f2bf(y * bf2f(gz[4 * g2 + j]) * gn);
                    if (!dry) G[(rowbase + q) * RVW + col] = ov;
                }
            }
        }
    }
}
}

namespace fox {
constexpr int TP = 144;
constexpr int L_K = 0, L_V = 2 * 128 * TP, L_KB = 4 * 128 * TP, L_WS = L_KB + SEQ * 4, L_SC = L_WS + 8 * 32 * 4, L_END = L_SC + 96;
__device__ __forceinline__ int crow(int r, int hi) { return (r & 3) + 8 * (r >> 2) + 4 * hi; }

__device__ __forceinline__ void prep(const float* logf, int b, int h, LAS unsigned char* lds, int tid, int lane, int w) {
    const size_t rowbase = (size_t)b * SEQ;
    LAS float* kb2 = (LAS float*)(lds + L_KB);
    LAS float* wsum = (LAS float*)(lds + L_SC);
    __syncthreads();
    float a[4];
#pragma unroll
    for (int i = 0; i < 4; ++i) a[i] = logf[(rowbase + 4 * tid + i) * 16 + h];
    a[1] += a[0]; a[2] += a[1]; a[3] += a[2];
    float x = a[3];
#pragma unroll
    for (int off = 1; off < 64; off <<= 1) { const float t = __shfl_up(x, off); if (lane >= off) x += t; }
    if (lane == 63) wsum[w] = x;
    __syncthreads();
    float pre = 0.f;
    for (int i = 0; i < w; ++i) pre += wsum[i];
    const float ex = pre + x - a[3];
    *(LAS f32x4*)(kb2 + 4 * tid) = (f32x4){-LOG2E * (ex + a[0]), -LOG2E * (ex + a[1]), -LOG2E * (ex + a[2]), -LOG2E * (ex + a[3])};
    __syncthreads();
}

__device__ __forceinline__ void unit(bf16_t* QY, const bf16_t* K, const bf16_t* V, const bf16_t* OG, float qk_bound, int b, int h, int qb, LAS unsigned char* lds, int tid, int lane, int w, bool dry = false) {
    const int r32 = lane & 31, hh = lane >> 5;
    const size_t rowbase = (size_t)b * SEQ; const int q0 = qb * 256;
    LAS float* kb2 = (LAS float*)(lds + L_KB);
    LAS float* wsf = (LAS float*)(lds + L_WS) + w * 32;
    LAS unsigned* flags = (LAS unsigned*)(lds + L_SC + 32);
    __syncthreads();
    bf16x8 qr[4];
    { const bf16_t* qp = QY + (rowbase + q0 + 32 * w + r32) * 1024 + h * FD + 8 * hh;
#pragma unroll
      for (int ks = 0; ks < 4; ++ks) qr[ks] = *(const bf16x8*)(qp + 16 * ks); }
    const int NT = 4 * (qb + 1), NP = NT / 2;
    const int srow = tid >> 3, sc8 = tid & 7;
    const bf16_t* kg = K + (rowbase + srow) * 1024 + h * FD + 8 * sc8;
    const bf16_t* vg = V + (rowbase + srow) * 1024 + h * FD + 8 * sc8;
    u32x4 kreg[2], vreg[2];
#pragma unroll
    for (int i = 0; i < 2; ++i) { kreg[i] = *(const u32x4*)(kg + (size_t)((NP - 1) * 128 + 64 * i) * 1024); vreg[i] = *(const u32x4*)(vg + (size_t)((NP - 1) * 128 + 64 * i) * 1024); }
#pragma unroll
    for (int i = 0; i < 2; ++i) { *(LAS u32x4*)(lds + L_K + (srow + 64 * i) * TP + 16 * sc8) = kreg[i]; *(LAS u32x4*)(lds + L_V + (srow + 64 * i) * TP + 16 * sc8) = vreg[i]; }
    __syncthreads();
    float m_run = -INFINITY, l_run = 0.f;
    f32x16 o[2];
#pragma unroll
    for (int i = 0; i < 16; ++i) { o[0][i] = 0.f; o[1][i] = 0.f; }
    const int qmin = q0 + 32 * w, query = qmin + r32;
    const int trrow = 4 * (lane >> 5) + ((lane & 15) >> 2), trcol = 16 * ((lane >> 4) & 1) + 4 * (lane & 3);
    bool wdone = false;
    int buf = 0;
#define FOX_TILE(t, kbuf, vbuf) do { \
        if (!wdone && 64 * t <= qmin + 31) { \
            f32x16 p[2]; \
_Pragma("unroll") \
            for (int half = 0; half < 2; ++half) { \
_Pragma("unroll") \
                for (int g = 0; g < 4; ++g) { const f32x4 kb = *(const LAS f32x4*)(kb2 + 64 * t + 32 * half + 8 * g + 4 * hh); \
                    p[half][4 * g] = kb[0]; p[half][4 * g + 1] = kb[1]; p[half][4 * g + 2] = kb[2]; p[half][4 * g + 3] = kb[3]; } \
_Pragma("unroll") \
                for (int ks = 0; ks < 4; ++ks) { const bf16x8 kf = *(const LAS bf16x8*)(kbuf + (32 * half + r32) * TP + (16 * ks + 8 * hh) * 2); \
                    p[half] = __builtin_amdgcn_mfma_f32_32x32x16_bf16(kf, qr[ks], p[half], 0, 0, 0); } \
            } \
            if (64 * t + 63 > qmin) { \
_Pragma("unroll") \
                for (int half = 0; half < 2; ++half) \
_Pragma("unroll") \
                    for (int i = 0; i < 16; ++i) { const int key = 64 * t + 32 * half + crow(i, hh); if (key > query) p[half][i] = -INFINITY; } \
            } \
            float mx = __builtin_fmaxf(__builtin_fmaxf(p[0][0], p[0][1]), p[1][0]); \
_Pragma("unroll") \
            for (int i = 2; i < 16; i += 2) mx = __builtin_fmaxf(__builtin_fmaxf(mx, p[0][i]), p[0][i + 1]); \
_Pragma("unroll") \
            for (int i = 1; i < 15; i += 2) mx = __builtin_fmaxf(__builtin_fmaxf(mx, p[1][i]), p[1][i + 1]); \
            mx = __builtin_fmaxf(mx, p[1][15]); \
            mx = fmaxf(mx, __shfl_xor(mx, 32)); \
            const float m_new = fmaxf(m_run, mx); \
            const float alpha = __builtin_amdgcn_exp2f(m_run - m_new); \
            const bool resc = __any(m_new > m_run); \
            m_run = m_new; \
            float ls = 0.f; \
_Pragma("unroll") \
            for (int half = 0; half < 2; ++half) \
_Pragma("unroll") \
                for (int i = 0; i < 16; ++i) { p[half][i] = __builtin_amdgcn_exp2f(p[half][i] - m_new); ls += p[half][i]; } \
            ls += __shfl_xor(ls, 32); \
            l_run = l_run * alpha + ls; \
            if (resc) { \
                if (hh == 0) wsf[r32] = alpha; \
                LDS_WAIT(); asm volatile("" ::: "memory"); \
_Pragma("unroll") \
                for (int g = 0; g < 4; ++g) { const f32x4 al = *(const LAS f32x4*)(wsf + 8 * g + 4 * hh); \
_Pragma("unroll") \
                    for (int j = 0; j < 4; ++j) { o[0][4 * g + j] *= al[j]; o[1][4 * g + j] *= al[j]; } } \
            } \
 \
_Pragma("unroll") \
            for (int half = 0; half < 2; ++half) \
_Pragma("unroll") \
                for (int s = 0; s < 2; ++s) { \
                    u32x4 pw; pw.x = cvt_pk_bf16(p[half][8 * s], p[half][8 * s + 1]); pw.y = cvt_pk_bf16(p[half][8 * s + 2], p[half][8 * s + 3]); \
                    pw.z = cvt_pk_bf16(p[half][8 * s + 4], p[half][8 * s + 5]); pw.w = cvt_pk_bf16(p[half][8 * s + 6], p[half][8 * s + 7]); \
                    const bf16x8 pf = __builtin_bit_cast(bf16x8, pw); \
                    const int kbase = 32 * half + 16 * s; \
_Pragma("unroll") \
                    for (int dt = 0; dt < 2; ++dt) { \
                        const LAS unsigned char* vp = vbuf + (kbase + trrow) * TP + (32 * dt + trcol) * 2; \
                        const s16x4 lo = ret::tr_read(vp), hi = ret::tr_read(vp + 8 * TP); \
                        const bf16x8 vf = (bf16x8){lo[0], lo[1], lo[2], lo[3], hi[0], hi[1], hi[2], hi[3]}; \
                        o[dt] = __builtin_amdgcn_mfma_f32_32x32x16_bf16(pf, vf, o[dt], 0, 0, 0); \
                    } \
                } \
 \
            if (t > 0) { const float nxt = kb2[64 * t - 1] + qk_bound + 64.f; \
                if (__all(nxt < m_run)) wdone = true; } \
        } \
    } while (0)
    for (int tp = NP - 1; tp >= 0; --tp, buf ^= 1) {
        if (tp > 0) {
#pragma unroll
            for (int i = 0; i < 2; ++i) { kreg[i] = *(const u32x4*)(kg + (size_t)((tp - 1) * 128 + 64 * i) * 1024); vreg[i] = *(const u32x4*)(vg + (size_t)((tp - 1) * 128 + 64 * i) * 1024); } }
        { const LAS unsigned char* kb1 = lds + L_K + (buf * 128 + 64) * TP; const LAS unsigned char* vb1 = lds + L_V + (buf * 128 + 64) * TP;
          const int t1 = 2 * tp + 1; FOX_TILE(t1, kb1, vb1); }
        { const LAS unsigned char* kb0 = lds + L_K + (buf * 128) * TP; const LAS unsigned char* vb0 = lds + L_V + (buf * 128) * TP;
          const int t0 = 2 * tp; FOX_TILE(t0, kb0, vb0); }
        if (lane == 0) flags[(tp & 1) * 8 + w] = wdone ? 1u : 0u;
        if (tp > 0) {
#pragma unroll
            for (int i = 0; i < 2; ++i) { *(LAS u32x4*)(lds + L_K + ((buf ^ 1) * 128 + srow + 64 * i) * TP + 16 * sc8) = kreg[i]; *(LAS u32x4*)(lds + L_V + ((buf ^ 1) * 128 + srow + 64 * i) * TP + 16 * sc8) = vreg[i]; } }
        __syncthreads();
        { const u32x4 f0 = *(const LAS u32x4*)(flags + (tp & 1) * 8), f1 = *(const LAS u32x4*)(flags + (tp & 1) * 8 + 4);
          if ((f0.x & f0.y & f0.z & f0.w & f1.x & f1.y & f1.z & f1.w) != 0u) break; }
    }
#undef FOX_TILE
    if (hh == 0) wsf[r32] = 1.f / l_run;
    LDS_WAIT(); asm volatile("" ::: "memory");
    unsigned ogv[2][16];
#pragma unroll
    for (int i = 0; i < 16; ++i)
#pragma unroll
        for (int dt = 0; dt < 2; ++dt) ogv[dt][i] = (unsigned)OG[(rowbase + q0 + 32 * w + (i & 3) + 8 * (i >> 2) + 4 * hh) * 1024 + h * FD + 32 * dt + r32];
#pragma unroll
    for (int g = 0; g < 4; ++g) { const f32x4 rl = *(const LAS f32x4*)(wsf + 8 * g + 4 * hh);
#pragma unroll
        for (int j = 0; j < 4; ++j) {
            const size_t row = rowbase + q0 + 32 * w + 8 * g + 4 * hh + j;
#pragma unroll
            for (int dt = 0; dt < 2; ++dt) { const size_t off = row * 1024 + h * FD + 32 * dt + r32;
                const bf16_t yv = (bf16_t)f2bf(o[dt][4 * g + j] * rl[j] * bf2f(ogv[dt][4 * g + j])); if (!dry) QY[off] = yv; }
        } }
}
}

#define XB_TMO      128
#define XB_XCNT(j)  (256  + 64 * (j))
#define XB_XSUB(j)  (1280 + 64 * (j))
#define XB_XGEN(j)  (2304 + 64 * (j))
#define XB_TOP      3328
#define XB_TOPGEN   3392
#define XCD_BAR_WORDS 3456
#define XB_SPIN_CAP (1u << 18)

__device__ __forceinline__ unsigned xb_ld(unsigned* p)              { return __hip_atomic_load(p, __ATOMIC_RELAXED, __HIP_MEMORY_SCOPE_AGENT); }
__device__ __forceinline__ unsigned xb_add(unsigned* p, unsigned v) { return __hip_atomic_fetch_add(p, v, __ATOMIC_RELAXED, __HIP_MEMORY_SCOPE_AGENT); }
__device__ __forceinline__ unsigned xb_xcc_id() { return (unsigned)__builtin_amdgcn_s_getreg((3 << 11) | 20) & 0xFu; }
#define XB_SPIN(cond, bar) do { unsigned _sp = 0; while (cond) { __builtin_amdgcn_s_sleep(1); \
    if ((++_sp & 255u) == 0u) { if (xb_ld(&(bar)[XB_TMO])) break; if (_sp > XB_SPIN_CAP) { atomicAdd(&(bar)[XB_TMO], 1u); break; } } } } while (0)

struct XcdBarrier {
    unsigned* bar; unsigned x;
    volatile LAS unsigned* st;
};

__device__ __forceinline__ XcdBarrier xcd_barrier_post(unsigned* bar, volatile LAS unsigned* st) {
    XcdBarrier b; b.bar = bar; b.x = xb_xcc_id(); b.st = st;
    if (threadIdx.x == 0) (void)xb_add(&bar[XB_XCNT(b.x)], 1u);
    return b;
}
__device__ __forceinline__ void xcd_barrier_complete(unsigned* bar, unsigned x, unsigned& nloc, unsigned& nx) {
    const unsigned G = gridDim.x * gridDim.y * gridDim.z;
    unsigned sum, cnt, mine, sp = 0u;
    for (;;) {
        sum = 0u; cnt = 0u; mine = 0u;
#pragma unroll
        for (unsigned j = 0; j < 16; ++j) { const unsigned c = xb_ld(&bar[XB_XCNT(j)]); sum += c; cnt += (c > 0u) ? 1u : 0u; mine = (j == x) ? c : mine; }
        if (sum == G) break;
        __builtin_amdgcn_s_sleep(1);
        if ((++sp & 255u) == 0u) { if (xb_ld(&bar[XB_TMO])) break; if (sp > XB_SPIN_CAP) { atomicAdd(&bar[XB_TMO], 1u); break; } }
    }
    nloc = mine > 0u ? mine : 1u; nx = cnt > 0u ? cnt : 1u;
}

__device__ __forceinline__ void xcd_barrier(const XcdBarrier& b) {
    asm volatile("s_waitcnt vmcnt(0)" ::: "memory");
    __syncthreads();
    if (threadIdx.x == 0) {
        unsigned* bar = b.bar;
        __builtin_amdgcn_s_waitcnt(0);
        unsigned nloc = b.st[0], nx = b.st[1];
        if (nloc == 0u) { xcd_barrier_complete(bar, b.x, nloc, nx); b.st[0] = nloc; b.st[1] = nx; }
        const unsigned old = xb_add(&bar[XB_XSUB(b.x)], 1u);
        const unsigned gen = old / nloc;
        if (old + 1u == (gen + 1u) * nloc) {
            __builtin_amdgcn_fence(__ATOMIC_RELEASE, "agent");
            asm volatile("s_waitcnt vmcnt(0)" ::: "memory");
            const unsigned og = xb_add(&bar[XB_TOP], 1u);
            const unsigned tg = og / nx;
            if (og + 1u == (tg + 1u) * nx) xb_add(&bar[XB_TOPGEN], 1u);
            else XB_SPIN(xb_ld(&bar[XB_TOPGEN]) == tg, bar);
            __builtin_amdgcn_fence(__ATOMIC_ACQUIRE, "agent");
            xb_add(&bar[XB_XGEN(b.x)], 1u);
            asm volatile("s_waitcnt vmcnt(0)" ::: "memory");
        } else {
            XB_SPIN(xb_ld(&bar[XB_XGEN(b.x)]) == gen, bar);
            __builtin_amdgcn_fence(__ATOMIC_ACQUIRE, "agent");
            asm volatile("s_waitcnt vmcnt(0)" ::: "memory");
        }
    }
    __syncthreads();
}

__global__ void __launch_bounds__(512, 2) yoco_fwd(Args a) {
    extern __shared__ __attribute__((aligned(16))) unsigned char lds_raw[];
    LAS unsigned char* lds = (LAS unsigned char*)lds_raw;
    cg::grid_group grid = cg::this_grid();
    int tid = threadIdx.x, lane = tid & 63, wave = __builtin_amdgcn_readfirstlane(tid >> 6);
#define FENCE() do { asm volatile("" : "+v"(tid)); lane = tid & 63; wave = __builtin_amdgcn_readfirstlane(tid >> 6); } while (0)
#define GSYNC_CG() do { if (G > (1 << 20)) grid.sync(); xcd_barrier(xbar); FENCE(); } while (0)
#define GSYNC() do { xcd_barrier(xbar); FENCE(); } while (0)
    const int G = gridDim.x, bx = blockIdx.x;
    const int vcu = (G % 8 == 0) ? (bx % 8) * (G / 8) + bx / 8 : bx;
    unsigned char* ws = a.ws;
    volatile LAS unsigned* bst = (volatile LAS unsigned*)(lds + XBST_OFF);
    if (tid < 2) bst[tid] = 0u;
    __syncthreads();
    const XcdBarrier xbar = xcd_barrier_post((unsigned*)(ws + WS_CTL), bst);
    float* ADA = (float*)(ws + WS_ADA);
    float* LOGF = (float*)(ws + WS_LOGF);
    float* SSQ = (float*)(ws + WS_SSQ);
    bf16_t* HN = (bf16_t*)(ws + WS_HN);
    bf16_t* HKV = (bf16_t*)(ws + WS_HKV);
    bf16_t* BIG = (bf16_t*)(ws + WS_BIG);
    bf16_t* RQ = (bf16_t*)a.out;
    bf16_t* RK = RQ + (size_t)M * 1024;
    bf16_t* RV = BIG;
    bf16_t* RG = BIG + (size_t)M * 2048;
    bf16_t* HID = BIG;
    bf16_t* KSH = BIG, *VSH = BIG + (size_t)M * 1024, *QY = BIG + (size_t)2 * M * 1024, *OG = BIG + (size_t)3 * M * 1024;
    const float* A0 = ADA, *A1 = ADA + 6144, *AKV = ADA + 12288;
    float* SSQ2 = (float*)(ws + WS_SSQ2);
    bf16_t* XB = (bf16_t*)a.out;
    bf16_t* XB2 = HKV;
    LAS float* wscr = (LAS float*)(lds + WSCR_OFF);

#ifndef EXTRA_P0
#define EXTRA_P0 0
#endif
    for (int rep = EXTRA_P0; rep >= 0; --rep) { phase0(a, lds, tid, lane, wave); __syncthreads(); }
    GSYNC_CG();
    norm_rows(a.x, a.nmg, A0, A0 + 1024, HN, lane, wave);
    { float* B2 = (float*)(ws + WS_BIAS2);
      bias2_rows((const bf16_t*)(ws + WS_WM1_0), FF, A0 + 3072, B2 + B2_MLP0, FF, lane, wave);
      bias2_rows((const bf16_t*)(ws + WS_WM1_1), FF, A1 + 3072, B2 + B2_MLP1, FF, lane, wave);
      bias2_rows((const bf16_t*)(ws + WS_WKV), 2 * D + 256, AKV, B2 + B2_KV, 2 * D + 256, lane, wave);
      bias2_rows((const bf16_t*)(ws + WS_WFIN), 2 * D, A1, B2 + B2_FOX, 2 * D, lane, wave); }
    GSYNC();
    { pg8::Gemm g{HN, (const bf16_t*)(ws + WS_WRIN), M, RIN, D}; pg8::StaticOrder S; S.init(M, RIN, G, bx);
      pg8::EpiRetIn E{RQ, RK, RV, RG, (const float*)(ws + WS_TAB), a.pos};
      pg8::gemm_phase<pg8::EpiRetIn, pg8::StaticOrder, true, true>(lds, g, S, E, tid); }
    GSYNC();
#ifndef EXTRA_P3
#define EXTRA_P3 0
#endif
    for (int rep = EXTRA_P3; rep >= 0; --rep)
    for (int u = vcu; u < BATCH * RH * 8; u += G) ret::unit(RQ, RK, RV, RG, SSQ, a.ret_ng, u >> 5, (u >> 3) & 3, u & 7, lds, tid, lane, wave, rep > 0 && G < 100000);
    GSYNC();
    { pg8::Gemm g{RG, (const bf16_t*)(ws + WS_WROUT), M, D, RVW}; pg8::StaticOrder S; S.init(M, D, G, bx);
      LAS float* rtab = (LAS float*)(lds + RTAB_OFF);
      pg8::Unit u;
      for (int i = 0; S.next(i, u); ++i) {
          __syncthreads();
          { const int r = tid >> 1, h0 = (tid & 1) * 2; const float* sp = SSQ + ((size_t)(u.pm * 256 + r) * 4 + h0) * 16;
#pragma unroll
            for (int hh = 0; hh < 2; ++hh) { float s = 0.f;
#pragma unroll
                for (int k = 0; k < 4; ++k) { const f32x4 v = *(const f32x4*)(sp + hh * 16 + 4 * k); s += (v[0] + v[1]) + (v[2] + v[3]); }
                rtab[r * 4 + h0 + hh] = rsqrtf(s * (1.f / RDV) + EPS); } }
          __syncthreads();
          pg8::OneUnit S1{u}; pg8::EpiRes<true, 1, false, true> E{a.x, XB, A0 + 2048, ADA_LD, rtab, {HN, nullptr}, {a.nlg, nullptr}, {A0 + 4096, nullptr}, SSQ2};
          pg8::gemm_phase<pg8::EpiRes<true, 1, false, true>, pg8::OneUnit, false, true>(lds, g, S1, E, tid);
      } }
    GSYNC();
#if defined(STOP_AFTER) && STOP_AFTER == 4
    return;
#endif
#ifndef EXTRA_P6
#define EXTRA_P6 0
#endif
#ifndef EXTRA_NORM
#define EXTRA_NORM 0
#endif
#ifndef EXTRA_SYNC
#define EXTRA_SYNC 0
#endif
#define MLP_IN(WM1, B2OFF) do { \
    { pg8::Gemm g{HN, (const bf16_t*)(ws + (WM1)), M, FF, D}; pg8::StaticOrder S; S.init(M, FF, G, bx); pg8::EpiSqRelu E{HID, SSQ2, (const float*)(ws + WS_BIAS2) + (B2OFF), wscr}; \
      pg8::gemm_phase<pg8::EpiSqRelu, pg8::StaticOrder, true, true>(lds, g, S, E, tid); } \
    GSYNC(); } while (0)
    MLP_IN(WS_WM1_0, B2_MLP0);
    { pg8::Gemm g{HID, (const bf16_t*)(ws + WS_WM2_0), M, D, FF}; pg8::StaticOrder S; S.init(M, D, G, bx);
      pg8::EpiRes<false, 2, true, true> E{XB, XB, A0 + 5120, ADA_LD, nullptr, {HKV, HN}, {a.kv_ng, a.nmg + D}, {AKV + 1024, A1 + 1024}, SSQ2};
      pg8::gemm_phase<pg8::EpiRes<false, 2, true, true>, pg8::StaticOrder, true, true>(lds, g, S, E, tid); }
    GSYNC();
#if defined(STOP_AFTER) && STOP_AFTER == 7
    return;
#endif
    logf_rows(HKV, (const bf16_t*)(ws + WS_WKV) + (size_t)2048 * D, SSQ2, (const float*)(ws + WS_BIAS2) + B2_KV + 2048, 2 * D + 256, a.fbias, LOGF, lds, tid, lane, wave);
    { pg8::Gemm g{HKV, (const bf16_t*)(ws + WS_WKV), M, 2 * D, D}; pg8::StaticOrder S; S.init(M, 2 * D, G, bx);
      pg8::EpiHeads<0> E{KSH, VSH, a.k_ng, 1.f, LOGF, a.fbias, SSQ2, (const float*)(ws + WS_BIAS2) + B2_KV, 2 * D + 256, wscr};
      pg8::gemm_phase<pg8::EpiHeads<0>, pg8::StaticOrder, true, true>(lds, g, S, E, tid); }
    FENCE();
    { pg8::Gemm g{HN, (const bf16_t*)(ws + WS_WFIN), M, 2 * D, D}; pg8::StaticOrder S; S.init(M, 2 * D, G, bx);
      pg8::EpiHeads<1> E{QY, OG, a.q_ng, QSCALE, nullptr, nullptr, SSQ2, (const float*)(ws + WS_BIAS2) + B2_FOX, 2 * D, wscr};
      pg8::gemm_phase<pg8::EpiHeads<1>, pg8::StaticOrder, true, true>(lds, g, S, E, tid); }
    GSYNC();
#ifndef SKIP_ATTN
#ifndef EXTRA_P10
#define EXTRA_P10 0
#endif
    float qk_bound;
    { float gq = fabsf(a.q_ng[lane]), gk = fabsf(a.k_ng[lane]);
#pragma unroll
      for (int o = 1; o < 64; o <<= 1) { gq = fmaxf(gq, __shfl_xor(gq, o)); gk = fmaxf(gk, __shfl_xor(gk, o)); }
      qk_bound = 64.f * gq * gk * QSCALE * 1.02f; }
    for (int rep = EXTRA_P10; rep >= 0; --rep)
    for (int it = vcu; it < 256; it += G) {
        const int bh = it >> 1;
        fox::prep(LOGF, bh >> 4, bh & 15, lds, tid, lane, wave);
#pragma unroll 1
        for (int i = 0; i < 4; ++i) { const int s = (i >> 1) ? 3 - (it & 1) : (it & 1), qb = (i & 1) ? 7 - s : s;
            fox::unit(QY, KSH, VSH, OG, qk_bound, bh >> 4, bh & 15, qb, lds, tid, lane, wave, rep > 0 && G < 100000); }
    }
#endif
    GSYNC();
    { pg8::Gemm g{QY, (const bf16_t*)(ws + WS_WFOUT), M, D, D}; pg8::StaticOrder S; S.init(M, D, G, bx); pg8::EpiRes<false, 1, true, true> E{XB, XB2, A1 + 2048, ADA_LD, nullptr, {HN, nullptr}, {a.nlg + D, nullptr}, {A1 + 4096, nullptr}, SSQ2};
      pg8::gemm_phase<pg8::EpiRes<false, 1, true, true>, pg8::StaticOrder, true, true>(lds, g, S, E, tid); }
    GSYNC();
#if defined(STOP_AFTER) && STOP_AFTER == 11
    return;
#endif
    MLP_IN(WS_WM1_1, B2_MLP1);
    { pg8::Gemm g{HID, (const bf16_t*)(ws + WS_WM2_1), M, D, FF}; pg8::StaticOrder S; S.init(M, D, G, bx);
      pg8::EpiRes<false, 0, true, false> E{XB2, a.out, A1 + 5120, ADA_LD, nullptr, {nullptr, nullptr}, {nullptr, nullptr}, {nullptr, nullptr}, nullptr};
      pg8::gemm_phase<pg8::EpiRes<false, 0, true, false>, pg8::StaticOrder, true, true>(lds, g, S, E, tid); }
#undef MLP_IN
}

extern "C" void kernel_launch(void* const* d_in, const int* in_sizes, int n_in, void* d_out, int out_size, void* d_ws, size_t ws_size, hipStream_t stream) {
    static int grid = 0;
    if (grid == 0) {
        if (n_in != 21 || in_sizes[0] != M * D || out_size != M * D || ws_size < WS_END) { fprintf(stderr, "kernel_launch: unexpected shapes (n_in %d, x %d, out %d, ws %zu)\n", n_in, n_in > 0 ? in_sizes[0] : -1, out_size, ws_size); grid = -1; return; }
        int dev = 0, cus = 0, per_cu = 0;
        if (hipGetDevice(&dev) != hipSuccess || hipDeviceGetAttribute(&cus, hipDeviceAttributeMultiprocessorCount, dev) != hipSuccess) { grid = -1; return; }
        if (hipFuncSetAttribute((const void*)yoco_fwd, hipFuncAttributeMaxDynamicSharedMemorySize, LDS_BYTES) != hipSuccess) { fprintf(stderr, "kernel_launch: hipFuncSetAttribute failed\n"); grid = -1; return; }
        if (hipOccupancyMaxActiveBlocksPerMultiprocessor(&per_cu, (const void*)yoco_fwd, 512, LDS_BYTES) != hipSuccess || per_cu < 1) per_cu = 1;
        (void)hipGetLastError();
        grid = cus * per_cu; if (grid > 256) grid = 256;
    }
    if (grid < 0) return;
    Args p{};
    p.x = (const float*)d_in[0]; p.c = (const float*)d_in[1]; p.pos = (const int*)d_in[2];
    p.nmg = (const float*)d_in[3]; p.nlg = (const float*)d_in[4]; p.w_ada = (const float*)d_in[5]; p.b_ada = (const float*)d_in[6];
    p.w_mlp_in = (const float*)d_in[7]; p.w_mlp_out = (const float*)d_in[8]; p.ret_w_in = (const float*)d_in[9]; p.ret_ng = (const float*)d_in[10];
    p.ret_w_out = (const float*)d_in[11]; p.kv_ng = (const float*)d_in[12]; p.kv_w_ada = (const float*)d_in[13]; p.kv_b_ada = (const float*)d_in[14];
    p.kv_w = (const float*)d_in[15]; p.fbias = (const float*)d_in[16]; p.k_ng = (const float*)d_in[17]; p.fox_w_in = (const float*)d_in[18];
    p.q_ng = (const float*)d_in[19]; p.fox_w_out = (const float*)d_in[20];
    p.out = (float*)d_out; p.ws = (unsigned char*)d_ws;
    if (hipMemsetAsync((char*)d_ws + WS_CTL, 0, CTL_ZERO_BYTES, stream) != hipSuccess) { fprintf(stderr, "kernel_launch: memset failed\n"); return; }
    void* args[] = {&p};
    const hipError_t e = hipLaunchCooperativeKernel((const void*)yoco_fwd, dim3(grid), dim3(512), args, LDS_BYTES, stream);
    if (e != hipSuccess) fprintf(stderr, "kernel_launch: cooperative launch failed: %s (grid %d)\n", hipGetErrorString(e), grid);
}
```
